# Optimizing an MI355X kernel written in HIP

```python
import math
import jax
import jax.numpy as jnp
from jax import lax
import numpy as np

D_MODEL = 2048
BATCH = 2
SEQ = 4096
DEPTH = 2
DEC_BATCH = 8
DEC_SEQ = 4
PAST_LEN = 16384
PAGE_SIZE = 128

HEAD_DIM = 128
A_WIDTH = D_MODEL // 2
B_WIDTH = D_MODEL // 4
C_WIDTH = D_MODEL - A_WIDTH - B_WIDTH
MIX_WIDTH = A_WIDTH + B_WIDTH + C_WIDTH
A_HEADS = A_WIDTH // HEAD_DIM
A_KV_HEADS = A_HEADS // 4
A_GROUP = A_HEADS // A_KV_HEADS
CMP_LEN = 32
CMP_STRIDE = 16
CMP_HIDDEN = 2 * HEAD_DIM
SLC_LEN = 64
SLC_TOP = 16
WINDOW = 512
FORCE_SCORE = 1e6
POOL_WINDOWS = (2, 4, 8, 16)
B_GROUPS = len(POOL_WINDOWS)
B_GROUP_DIM = B_WIDTH // B_GROUPS
POOL_BUF = max(POOL_WINDOWS) - 1
C_HEADS = C_WIDTH // HEAD_DIM
IDX_HEADS = 4
IDX_DIM = 64
IDX_TOPK_MAX = 256
N_BUCKETS = 32
MAX_DISTANCE = 128
BIAS_HEADS = A_HEADS + C_HEADS
Q_BLOCK = 128
EPS = 1e-6
IN_SIZES = (A_WIDTH, 6 * A_KV_HEADS * HEAD_DIM, 3 * A_HEADS, A_WIDTH,
            B_WIDTH, B_WIDTH,
            C_WIDTH, 2 * HEAD_DIM, IDX_HEADS * IDX_DIM, IDX_DIM, IDX_HEADS, C_WIDTH)
N_IN = sum(IN_SIZES)
N_PAGES = PAST_LEN // PAGE_SIZE
N_POOL_PAGES = (5 * DEC_BATCH * N_PAGES) // 4
WIN_BUF = min(WINDOW, PAST_LEN)

kernel_name = 'hybrid_nsa_pool_dsa_decode_step'


def rms_norm(x, g):
    xf = x.astype(jnp.float32)
    y = xf * lax.rsqrt(jnp.mean(xf * xf, axis=-1, keepdims=True) + EPS)
    return (y * g.astype(jnp.float32)).astype(x.dtype)


def masked_softmax(s, mask):
    s = jnp.where(mask, s.astype(jnp.float32), -jnp.inf)
    m = jnp.max(s, axis=-1, keepdims=True)
    m = jnp.where(jnp.isfinite(m), m, 0.0)
    e = jnp.where(mask, jnp.exp(s - m), 0.0)
    return e / jnp.maximum(jnp.sum(e, axis=-1, keepdims=True), 1e-30)


def t5_bucket(rel):
    rel = jnp.maximum(rel, 0)
    exact = N_BUCKETS // 2
    relf = jnp.maximum(rel, exact).astype(jnp.float32)
    log_b = exact + (jnp.log(relf / exact) / math.log(MAX_DISTANCE / exact) * (N_BUCKETS - exact)).astype(jnp.int32)
    return jnp.where(rel < exact, rel, jnp.minimum(log_b, N_BUCKETS - 1))


def split_columns(z):
    out = []
    off = 0
    for size in IN_SIZES:
        out.append(z[..., off:off + size])
        off += size
    return out


def prepare(x, c, norm_g, w_ada, b_ada, w_in, a_qnorm, a_knorm, c_qnorm, c_knorm):
    mod = jax.nn.silu(c) @ w_ada + b_ada
    shift, scale, gate = jnp.split(mod, 3, axis=-1)
    h = rms_norm(x, norm_g) * (1.0 + scale[:, None]) + shift[:, None]
    (a_q, a_kv, a_gate, a_silu, b_in, b_silu,
     c_q, c_kv, c_iq, c_ik, c_iw, c_silu) = split_columns(h @ w_in)
    B, T = x.shape[:2]
    kv = a_kv.reshape(B, T, 6, A_KV_HEADS, HEAD_DIM)
    a_rows = jnp.stack([kv[:, :, 0], kv[:, :, 1], rms_norm(kv[:, :, 2], a_knorm[1]), kv[:, :, 3]], axis=2)
    win_rows = jnp.stack([rms_norm(kv[:, :, 4], a_knorm[2]), kv[:, :, 5]], axis=2)
    ckv = c_kv.reshape(B, T, 2, HEAD_DIM)
    c_rows = jnp.stack([rms_norm(ckv[:, :, 0], c_knorm), ckv[:, :, 1]], axis=2)
    return {
        'gate': gate,
        'a_q': rms_norm(a_q.reshape(B, T, A_HEADS, HEAD_DIM), a_qnorm),
        'a_gate': a_gate.reshape(B, T, 3, A_HEADS),
        'a_rows': a_rows,
        'win_rows': win_rows,
        'b_in': b_in,
        'c_q': rms_norm(c_q.reshape(B, T, C_HEADS, HEAD_DIM), c_qnorm),
        'c_rows': c_rows,
        'c_iq': c_iq.reshape(B, T, IDX_HEADS, IDX_DIM),
        'c_kidx': c_ik,
        'c_iw': c_iw,
        'silu': (a_silu, b_silu, c_silu),
    }


def finish(x, gate, o_a, o_b, o_c, silu_parts, w_out):
    a_s, b_s, c_s = silu_parts
    mixed = jnp.concatenate([o_a * jax.nn.silu(a_s), o_b * jax.nn.silu(b_s), o_c * jax.nn.silu(c_s)], axis=-1)
    return x + gate[:, None] * (mixed @ w_out)


def compress(x, pe, w1, b1, w2, b2):
    B, L = x.shape[:2]
    r = CMP_LEN // CMP_STRIDE
    n_chunk = L // CMP_STRIDE
    nc = n_chunk - r + 1
    ch = x[:, :n_chunk * CMP_STRIDE].reshape(B, n_chunk, CMP_STRIDE, A_KV_HEADS, HEAD_DIM)
    w1p = w1.reshape(r, CMP_STRIDE, HEAD_DIM, CMP_HIDDEN)
    pep = pe.reshape(r, CMP_STRIDE, HEAD_DIM)
    hid = b1
    for p in range(r):
        part = jnp.einsum('bcskd,sdh->bckh', ch + pep[p][:, None, :], w1p[p])
        hid = hid + part[:, p:p + nc]
    return jax.nn.gelu(hid) @ w2 + b2


def to_blocks(x):
    B, L = x.shape[:2]
    ns = -(-L // SLC_LEN)
    x = jnp.pad(x, ((0, 0), (0, ns * SLC_LEN - L), (0, 0), (0, 0)))
    return x.reshape(B, ns, SLC_LEN, A_KV_HEADS, HEAD_DIM).transpose(0, 3, 1, 2, 4)


def nsa_keyside(a_all, pe, w1, b1, w2, b2, knorm_cmp):
    k_cmp = rms_norm(compress(a_all[:, :, 0], pe[0], w1[0], b1[0], w2[0], b2[0]), knorm_cmp)
    v_cmp = compress(a_all[:, :, 1], pe[1], w1[1], b1[1], w2[1], b2[1])
    e_pos = jnp.arange(k_cmp.shape[1]) * CMP_STRIDE + CMP_LEN - 1
    return k_cmp, v_cmp, e_pos, to_blocks(a_all[:, :, 2]), to_blocks(a_all[:, :, 3])


def slc_importance(p_imp, ns):
    nc = p_imp.shape[-1]
    r1 = SLC_LEN // CMP_STRIDE
    r2 = CMP_LEN // CMP_STRIDE
    pad_r = max(r1 * ns - nc + r1, 0)
    p = jnp.pad(p_imp, [(0, 0)] * (p_imp.ndim - 1) + [(r2 - 1, pad_r)])
    acc = jnp.zeros(p_imp.shape[:-1] + (ns,), jnp.float32)
    for m in range(r1):
        for n in range(r2):
            o = m + n
            acc = acc + p[..., o:o + r1 * ns].reshape(p.shape[:-1] + (ns, r1))[..., 0]
    return acc


def nsa_core(q, gate, q_pos, kc, vc, e_pos, ks_blk, vs_blk, kw, vw, w_pos, rel_a):
    B, Tq = q.shape[:2]
    scale = HEAD_DIM ** -0.5
    qg = q.reshape(B, Tq, A_KV_HEADS, A_GROUP, HEAD_DIM)

    def pair_bias(rel):
        return rel_a[t5_bucket(rel)].reshape(rel.shape + (A_KV_HEADS, A_GROUP)).transpose(0, 2, 3, 1)

    rel_c = q_pos[:, None] - e_pos[None, :]
    s_c = jnp.einsum('btkgd,bnkd->btkgn', qg, kc).astype(jnp.float32) * scale + pair_bias(rel_c)[None]
    p_c = masked_softmax(s_c, (rel_c >= 0)[None, :, None, None, :])
    o_c = jnp.einsum('btkgn,bnkd->btkgd', p_c.astype(vc.dtype), vc)

    ns = ks_blk.shape[2]
    p_slc = slc_importance(p_c.sum(axis=3), ns)
    blk = jnp.arange(ns)[None, :]
    cur = (q_pos // SLC_LEN)[:, None]
    visible = blk <= cur
    forced = (blk == 0) | (blk == cur) | (blk == cur - 1)
    score = jnp.where(visible[None, :, None, :], jnp.where(forced[None, :, None, :], FORCE_SCORE, p_slc), -jnp.inf)
    top_v, top_i = lax.top_k(score, min(SLC_TOP, ns))
    idx = top_i.transpose(0, 2, 1, 3)
    ok_blk = jnp.isfinite(top_v).transpose(0, 2, 1, 3)
    gather = jax.vmap(jax.vmap(lambda a, i: a[i]))
    k_s = gather(ks_blk, idx)
    v_s = gather(vs_blk, idx)
    rel_s = q_pos[None, None, :, None, None] - (idx[..., None] * SLC_LEN + jnp.arange(SLC_LEN))
    ok_s = ok_blk[..., None] & (rel_s >= 0)
    tbl = rel_a.reshape(N_BUCKETS, A_KV_HEADS, A_GROUP).transpose(1, 0, 2)
    bias_s = jax.vmap(lambda t, r: t[r], in_axes=(0, 1), out_axes=1)(tbl, t5_bucket(rel_s))
    qt = qg.transpose(0, 2, 1, 3, 4)
    s_s = jnp.einsum('bktgd,bktnsd->bktgns', qt, k_s).astype(jnp.float32) * scale + bias_s.transpose(0, 1, 2, 5, 3, 4)
    n_sel = idx.shape[-1] * SLC_LEN
    p_s = masked_softmax(s_s.reshape(B, A_KV_HEADS, Tq, A_GROUP, n_sel), ok_s.reshape(B, A_KV_HEADS, Tq, 1, n_sel))
    o_s = jnp.einsum('bktgm,bktmd->btkgd', p_s.astype(vs_blk.dtype), v_s.reshape(B, A_KV_HEADS, Tq, n_sel, HEAD_DIM))

    rel_w = q_pos[:, None] - w_pos[None, :]
    ok_w = (rel_w >= 0) & (rel_w <= WINDOW) & (w_pos >= 0)[None, :]
    s_w = jnp.einsum('btkgd,bskd->btkgs', qg, kw).astype(jnp.float32) * scale + pair_bias(rel_w)[None]
    p_w = masked_softmax(s_w, ok_w[None, :, None, None, :])
    o_w = jnp.einsum('btkgs,bskd->btkgd', p_w.astype(vw.dtype), vw)

    g = jax.nn.sigmoid(gate.astype(jnp.float32)).reshape(B, Tq, 3, A_KV_HEADS, A_GROUP, 1)
    o = g[:, :, 0] * o_c + g[:, :, 1] * o_s + g[:, :, 2] * o_w
    return o.reshape(B, Tq, A_WIDTH).astype(q.dtype)


def dsa_core(q, qi, wi, q_pos, k, v, kidx, rel_c):
    B, Tq = q.shape[:2]
    L = k.shape[1]
    n_keep = min(IDX_TOPK_MAX, L // 4)
    rel = q_pos[:, None] - jnp.arange(L)[None, :]
    dots = jax.nn.relu(jnp.einsum('bthd,bsd->bths', qi, kidx).astype(jnp.float32))
    score = jnp.einsum('bth,bths->bts', wi.astype(jnp.float32), dots)
    score = jnp.where((rel >= 0)[None], score, -jnp.inf)
    top_v, top_i = lax.top_k(score, n_keep)
    take = jax.vmap(lambda a, i: a[i])
    k_g = take(k, top_i)
    v_g = take(v, top_i)
    bias = rel_c[t5_bucket(q_pos[None, :, None] - top_i)]
    s = jnp.einsum('bthd,btkd->bthk', q, k_g).astype(jnp.float32) * HEAD_DIM ** -0.5 + bias.transpose(0, 1, 3, 2)
    p = masked_softmax(s, jnp.isfinite(top_v)[:, :, None, :])
    o = jnp.einsum('bthk,btkd->bthd', p.astype(v.dtype), v_g)
    return o.reshape(B, Tq, C_WIDTH)


def pool_mix(u_ext, pos0, w_pool, scale):
    B = u_ext.shape[0]
    T = u_ext.shape[1] - POOL_BUF
    uf = u_ext.astype(jnp.float32)
    cs = jnp.pad(jnp.cumsum(uf, axis=1), ((0, 0), (1, 0), (0, 0)))
    pos = pos0 + jnp.arange(T)
    cur = uf[:, POOL_BUF:]
    groups = []
    for g, w in enumerate(POOL_WINDOWS):
        c0, c1 = g * B_GROUP_DIM, (g + 1) * B_GROUP_DIM
        win_sum = cs[:, POOL_BUF + 1:POOL_BUF + 1 + T, c0:c1] - cs[:, POOL_BUF + 1 - w:POOL_BUF + 1 - w + T, c0:c1]
        cnt = jnp.minimum(pos + 1, w).astype(jnp.float32)
        groups.append(win_sum / cnt[None, :, None] - cur[:, :, c0:c1])
    d = jnp.stack(groups, axis=2)
    y = jnp.einsum('btgc,gcd->btgd', d, w_pool.astype(jnp.float32)).reshape(B, T, B_WIDTH) * scale.astype(jnp.float32)
    return y.astype(u_ext.dtype)


def prompt_layer(x, c, rel_a, rel_c, lw):
    (norm_g, w_ada, b_ada, w_in, w_out, a_qnorm, a_knorm, cmp_pe, cmp_w1, cmp_b1,
     cmp_w2, cmp_b2, pool_w, pool_scale, c_qnorm, c_knorm) = lw
    P = prepare(x, c, norm_g, w_ada, b_ada, w_in, a_qnorm, a_knorm, c_qnorm, c_knorm)
    B, T = x.shape[:2]
    kc, vc, e_pos, ks_blk, vs_blk = nsa_keyside(P['a_rows'], cmp_pe, cmp_w1, cmp_b1, cmp_w2, cmp_b2, a_knorm[0])
    win_pad = jnp.pad(P['win_rows'], ((0, 0), (WINDOW, 0), (0, 0), (0, 0), (0, 0)))
    c_k, c_v = P['c_rows'][:, :, 0], P['c_rows'][:, :, 1]

    def query_block(b):
        b0 = b * Q_BLOCK
        take = lambda a: lax.dynamic_slice_in_dim(a, b0, Q_BLOCK, axis=1)
        q_pos = b0 + jnp.arange(Q_BLOCK)
        wb = lax.dynamic_slice_in_dim(win_pad, b0, WINDOW + Q_BLOCK, axis=1)
        w_pos = b0 - WINDOW + jnp.arange(WINDOW + Q_BLOCK)
        o_a = nsa_core(take(P['a_q']), take(P['a_gate']), q_pos, kc, vc, e_pos, ks_blk, vs_blk,
                       wb[:, :, 0], wb[:, :, 1], w_pos, rel_a)
        o_c = dsa_core(take(P['c_q']), take(P['c_iq']), take(P['c_iw']), q_pos, c_k, c_v, P['c_kidx'], rel_c)
        return o_a, o_c

    o_a, o_c = lax.map(query_block, jnp.arange(T // Q_BLOCK))
    unblock = lambda o: jnp.swapaxes(o, 0, 1).reshape(B, T, o.shape[-1])
    o_b = pool_mix(jnp.pad(P['b_in'], ((0, 0), (POOL_BUF, 0), (0, 0))), 0, pool_w, pool_scale)
    y = finish(x, P['gate'], unblock(o_a), o_b, unblock(o_c), P['silu'], w_out)
    return y, P['a_rows'], P['c_rows'], P['c_kidx'], P['win_rows'][:, -min(WINDOW, T):], P['b_in'][:, -POOL_BUF:]


def sample_layer(x, c, cache_a, cache_c, cache_ci, win_buf, pool_buf, page_table, rel_a, rel_c, lw):
    (norm_g, w_ada, b_ada, w_in, w_out, a_qnorm, a_knorm, cmp_pe, cmp_w1, cmp_b1,
     cmp_w2, cmp_b2, pool_w, pool_scale, c_qnorm, c_knorm) = lw
    P = prepare(x, c, norm_g, w_ada, b_ada, w_in, a_qnorm, a_knorm, c_qnorm, c_knorm)
    Bd, T = x.shape[:2]
    past = page_table.shape[1] * PAGE_SIZE

    def gather_pages(cache):
        return cache[page_table].reshape((Bd, past) + cache.shape[2:])

    a_all = jnp.concatenate([gather_pages(cache_a), P['a_rows']], axis=1)
    kc, vc, e_pos, ks_blk, vs_blk = nsa_keyside(a_all, cmp_pe, cmp_w1, cmp_b1, cmp_w2, cmp_b2, a_knorm[0])
    w_all = jnp.concatenate([win_buf, P['win_rows']], axis=1)
    n_buf = win_buf.shape[1]
    q_pos = past + jnp.arange(T)
    w_pos = past - n_buf + jnp.arange(n_buf + T)
    o_a = nsa_core(P['a_q'], P['a_gate'], q_pos, kc, vc, e_pos, ks_blk, vs_blk,
                   w_all[:, :, 0], w_all[:, :, 1], w_pos, rel_a)
    c_all = jnp.concatenate([gather_pages(cache_c), P['c_rows']], axis=1)
    ci_all = jnp.concatenate([gather_pages(cache_ci), P['c_kidx']], axis=1)
    o_c = dsa_core(P['c_q'], P['c_iq'], P['c_iw'], q_pos, c_all[:, :, 0], c_all[:, :, 1], ci_all, rel_c)
    u_ext = jnp.concatenate([pool_buf, P['b_in']], axis=1)
    o_b = pool_mix(u_ext, past, pool_w, pool_scale)
    y = finish(x, P['gate'], o_a, o_b, o_c, P['silu'], w_out)
    return y, P['a_rows'], P['c_rows'], P['c_kidx'], w_all[:, -n_buf:], u_ext[:, -POOL_BUF:]


def setup_inputs(seed: int = 0) -> dict:
    key = jax.random.key(seed)
    ks = jax.random.split(key, 32)
    f32 = jnp.float32

    def nrm(k, shape, s=1.0):
        return s * jax.random.normal(k, shape, f32)

    def gain(k, shape):
        return 1.0 + 0.05 * jax.random.normal(k, shape, f32)

    page_table = jax.random.permutation(ks[7], N_POOL_PAGES)[:DEC_BATCH * N_PAGES].reshape(DEC_BATCH, N_PAGES).astype(jnp.int32)
    return {
        'x_prompt': nrm(ks[0], (BATCH, SEQ, D_MODEL)),
        'x_sample': nrm(ks[1], (DEC_BATCH, DEC_SEQ, D_MODEL)),
        'cache_a_kv': nrm(ks[2], (DEPTH, N_POOL_PAGES, PAGE_SIZE, 4, A_KV_HEADS, HEAD_DIM)),
        'cache_c_kv': nrm(ks[3], (DEPTH, N_POOL_PAGES, PAGE_SIZE, 2, HEAD_DIM)),
        'cache_c_kidx': nrm(ks[4], (DEPTH, N_POOL_PAGES, PAGE_SIZE, IDX_DIM)),
        'state_a_win': nrm(ks[5], (DEPTH, DEC_BATCH, WIN_BUF, 2, A_KV_HEADS, HEAD_DIM)),
        'state_b_pool': nrm(ks[6], (DEPTH, DEC_BATCH, POOL_BUF, B_WIDTH)),
        'page_table': page_table,
        'c_prompt': nrm(ks[8], (BATCH, D_MODEL)),
        'c_sample': nrm(ks[9], (DEC_BATCH, D_MODEL)),
        'rel_bias': nrm(ks[10], (N_BUCKETS, BIAS_HEADS), 0.2),
        'norm_g': gain(ks[11], (DEPTH, D_MODEL)),
        'w_ada': nrm(ks[12], (DEPTH, D_MODEL, 3 * D_MODEL), 0.5 * D_MODEL ** -0.5),
        'b_ada': nrm(ks[13], (DEPTH, 3 * D_MODEL), 0.01),
        'w_in': nrm(ks[14], (DEPTH, D_MODEL, N_IN), D_MODEL ** -0.5),
        'w_out': nrm(ks[15], (DEPTH, MIX_WIDTH, D_MODEL), MIX_WIDTH ** -0.5),
        'a_qnorm': gain(ks[16], (DEPTH, HEAD_DIM)),
        'a_knorm': gain(ks[17], (DEPTH, 3, HEAD_DIM)),
        'a_cmp_pe': nrm(ks[18], (DEPTH, 2, CMP_LEN, HEAD_DIM), 0.1),
        'a_cmp_w1': nrm(ks[19], (DEPTH, 2, CMP_LEN * HEAD_DIM, CMP_HIDDEN), (CMP_LEN * HEAD_DIM) ** -0.5),
        'a_cmp_b1': nrm(ks[20], (DEPTH, 2, CMP_HIDDEN), 0.01),
        'a_cmp_w2': nrm(ks[21], (DEPTH, 2, CMP_HIDDEN, HEAD_DIM), CMP_HIDDEN ** -0.5),
        'a_cmp_b2': nrm(ks[22], (DEPTH, 2, HEAD_DIM), 0.01),
        'b_pool_w': nrm(ks[23], (DEPTH, B_GROUPS, B_GROUP_DIM, B_GROUP_DIM), B_GROUP_DIM ** -0.5),
        'b_scale': 1.0 + 0.1 * jax.random.normal(ks[24], (DEPTH, B_WIDTH), f32),
        'c_qnorm': gain(ks[25], (DEPTH, HEAD_DIM)),
        'c_knorm': gain(ks[26], (DEPTH, HEAD_DIM)),
    }


def reference(x_prompt, x_sample, cache_a_kv, cache_c_kv, cache_c_kidx, state_a_win, state_b_pool, page_table,
              c_prompt, c_sample, rel_bias, norm_g, w_ada, b_ada, w_in, w_out, a_qnorm, a_knorm,
              a_cmp_pe, a_cmp_w1, a_cmp_b1, a_cmp_w2, a_cmp_b2, b_pool_w, b_scale, c_qnorm, c_knorm):
    rel_a = rel_bias[:, :A_HEADS]
    rel_c = rel_bias[:, A_HEADS:]
    y_prompt, y_sample = x_prompt, x_sample
    a_kv_p, a_kv_s, c_kv_p, c_kv_s, c_kidx_p, c_kidx_s = [], [], [], [], [], []
    a_win_p, a_win_s, b_pool_p, b_pool_s = [], [], [], []
    for l in range(DEPTH):
        lw = (norm_g[l], w_ada[l], b_ada[l], w_in[l], w_out[l], a_qnorm[l], a_knorm[l],
              a_cmp_pe[l], a_cmp_w1[l], a_cmp_b1[l], a_cmp_w2[l], a_cmp_b2[l],
              b_pool_w[l], b_scale[l], c_qnorm[l], c_knorm[l])
        y_prompt, akv, ckv, cki, awin, bpool = prompt_layer(y_prompt, c_prompt, rel_a, rel_c, lw)
        a_kv_p.append(akv)
        c_kv_p.append(ckv)
        c_kidx_p.append(cki)
        a_win_p.append(awin)
        b_pool_p.append(bpool)
        y_sample, akv, ckv, cki, awin, bpool = sample_layer(
            y_sample, c_sample, cache_a_kv[l], cache_c_kv[l], cache_c_kidx[l], state_a_win[l], state_b_pool[l],
            page_table, rel_a, rel_c, lw)
        a_kv_s.append(akv)
        c_kv_s.append(ckv)
        c_kidx_s.append(cki)
        a_win_s.append(awin)
        b_pool_s.append(bpool)
    return (y_prompt, y_sample,
            jnp.stack(a_kv_p), jnp.stack(a_kv_s),
            jnp.stack(c_kv_p), jnp.stack(c_kv_s),
            jnp.stack(c_kidx_p), jnp.stack(c_kidx_s),
            jnp.stack(a_win_p), jnp.stack(a_win_s),
            jnp.stack(b_pool_p), jnp.stack(b_pool_s))
```

```cpp
#include <hip/hip_runtime.h>
#include <stdint.h>
#include <stdio.h>

#define DI __device__ __forceinline__
#define LAS __attribute__((address_space(3)))
typedef unsigned short bf16_t;
typedef short bf16x8 __attribute__((ext_vector_type(8)));
typedef short s16x4 __attribute__((ext_vector_type(4)));
typedef float f32x4 __attribute__((ext_vector_type(4)));
typedef float f32x2 __attribute__((ext_vector_type(2)));
typedef unsigned u32x4 __attribute__((ext_vector_type(4)));
typedef unsigned u32x2 __attribute__((ext_vector_type(2)));

constexpr int DM = 2048, NB = 2, SEQ = 4096, NL = 2, DB = 8, DS = 4, PAST = 16384, PAGE = 128;
constexpr int HD = 128;
constexpr int NTP = NB * SEQ;
constexpr int NTS = DB * DS;
constexpr int NTOK = NTP + NTS;
constexpr int NPAGES = 128, NPOOL = 1280, WINB = 512, POOLB = 15;
constexpr int NIN = 6236;
constexpr int NC_S = 1023;
constexpr int NC_P = 255;
constexpr int ZLD = 6144;
constexpr int ZQ = 0, ZKV = 1024, ZAS = 2560, ZBI = 3584, ZBS = 4096, ZCQ = 4608, ZCKV = 5120, ZIQ = 5376, ZCS = 5632;
constexpr int ZSLD = 96, ZS_IK = 0, ZS_GATE = 64, ZS_IW = 88;
constexpr int WIN_ROWS = ZLD + ZSLD;
constexpr float LOG2E = 1.4426950408889634f;
constexpr float QK_SCALE2 = 0.08838834764831845f * 1.4426950408889634f;
constexpr float EPS = 1e-6f;
constexpr int SCORE_LD = 16512;
constexpr int LDS_BYTES = 163840, LDS_BAR_OFF = LDS_BYTES - 16, LDS_TICKET_OFF = LDS_BYTES - 32;

constexpr size_t al256(size_t x) { return (x + 255) & ~(size_t)255; }
constexpr size_t WS_CTL = 0, CTL_BYTES = 65536;
constexpr size_t WS_WINT = WS_CTL + CTL_BYTES;
constexpr size_t WS_WOUTT = WS_WINT + al256((size_t)NL * WIN_ROWS * DM * 2);
constexpr size_t WS_W1T = WS_WOUTT + al256((size_t)NL * DM * DM * 2);
constexpr size_t WS_W2T = WS_W1T + al256((size_t)4 * 256 * 4096 * 2);
constexpr size_t WS_PWT = WS_W2T + al256((size_t)4 * 128 * 256 * 2);
constexpr size_t WS_MOD = WS_PWT + al256((size_t)8 * 128 * 128 * 2);
constexpr size_t WS_CBIAS = WS_MOD + al256((size_t)NL * 10 * 6144 * 4);
constexpr size_t WS_BIAS = WS_CBIAS + al256((size_t)4 * 256 * 4);
constexpr size_t WS_H = WS_BIAS + al256((size_t)129 * 12 * 4);
constexpr size_t WS_Z = WS_H + al256((size_t)8448 * DM * 2);
constexpr size_t WS_ZS = WS_Z + al256((size_t)8448 * ZLD * 2);
constexpr size_t WS_KIDXB = WS_ZS + al256((size_t)8448 * ZSLD * 4);
constexpr size_t WS_MIXED = WS_KIDXB + al256((size_t)8448 * 64 * 2);
constexpr size_t WS_Y0 = WS_MIXED + al256((size_t)8448 * DM * 2);
constexpr size_t WS_ACMPS = WS_Y0 + al256((size_t)8448 * DM * 4);
constexpr size_t WS_HIDS = WS_ACMPS + al256((size_t)(65536 + 2) * 2048 * 2);
constexpr size_t WS_KCS = WS_HIDS + al256((size_t)65536 * 256 * 2);
constexpr size_t WS_VCST = WS_KCS + al256((size_t)NL * 16 * 1024 * 128 * 2);
constexpr size_t WS_KCP = WS_VCST + al256((size_t)NL * 16 * 1024 * 128 * 2);
constexpr size_t WS_VCPT = WS_KCP + al256((size_t)4 * 256 * 128 * 2);
constexpr size_t WS_SCORES = WS_VCPT + al256((size_t)4 * 256 * 128 * 2);
constexpr size_t WS_END = WS_SCORES + al256((size_t)NTS * SCORE_LD * 4);

constexpr size_t O_YP = 0;
constexpr size_t O_YS = O_YP + (size_t)NTP * DM;
constexpr size_t O_AKVP = O_YS + (size_t)NTS * DM;
constexpr size_t O_AKVS = O_AKVP + (size_t)NL * NTP * 1024;
constexpr size_t O_CKVP = O_AKVS + (size_t)NL * NTS * 1024;
constexpr size_t O_CKVS = O_CKVP + (size_t)NL * NTP * 256;
constexpr size_t O_KIXP = O_CKVS + (size_t)NL * NTS * 256;
constexpr size_t O_KIXS = O_KIXP + (size_t)NL * NTP * 64;
constexpr size_t O_AWP = O_KIXS + (size_t)NL * NTS * 64;
constexpr size_t O_AWS = O_AWP + (size_t)NL * NB * 512 * 512;
constexpr size_t O_BPP = O_AWS + (size_t)NL * DB * 512 * 512;
constexpr size_t O_BPS = O_BPP + (size_t)NL * NB * 15 * 512;
constexpr size_t O_END = O_BPS + (size_t)NL * DB * 15 * 512;

struct Args {
    const float* in[27];
    const int* page_table;
    float* out;
    unsigned char* ws;
    int ph_lo, ph_hi;
};
enum { I_XP = 0, I_XS, I_CA, I_CC, I_CI, I_SW, I_SB, I_PT, I_CP, I_CSM, I_RB, I_NG, I_WADA, I_BADA, I_WIN, I_WOUT, I_AQN, I_AKN, I_PE, I_W1, I_B1, I_W2, I_B2, I_PW, I_BSC, I_CQN, I_CKN };

typedef const __attribute__((address_space(4))) Args* ArgsP;
DI int ltid() { int t = threadIdx.x; asm volatile("" : "+v"(t)); return t; }
DI ArgsP largs() { ArgsP p = (ArgsP)__builtin_amdgcn_kernarg_segment_ptr(); asm volatile("" : "+s"(p)); return p; }
DI float bf2f(bf16_t b) { return __uint_as_float(((unsigned)b) << 16); }
DI bf16_t f2bf(float f) { unsigned u = __float_as_uint(f); u += 0x7FFFu + ((u >> 16) & 1u); return (bf16_t)(u >> 16); }
DI unsigned pk2(float lo, float hi) { unsigned r; asm("v_cvt_pk_bf16_f32 %0, %1, %2" : "=v"(r) : "v"(lo), "v"(hi)); return r; }
DI float lo2f(unsigned w) { return __uint_as_float(w << 16); }
DI float hi2f(unsigned w) { return __uint_as_float(w & 0xffff0000u); }
DI float fexp2(float x) { return __builtin_amdgcn_exp2f(x); }
DI float frcp(float x) { return __builtin_amdgcn_rcpf(x); }
DI float sigmoidf_(float x) { return frcp(1.0f + fexp2(-x * LOG2E)); }
DI float siluf_(float x) { return x * sigmoidf_(x); }
DI float gelu_tanh(float x) { const float u = x * (1.0f + 0.044715f * x * x); return x * frcp(1.0f + fexp2(-2.302208198f * u)); }
DI f32x4 mfma16(bf16x8 a, bf16x8 b, f32x4 c) { return __builtin_amdgcn_mfma_f32_16x16x32_bf16(a, b, c, 0, 0, 0); }
DI float wave_sum(float v) { for (int o = 32; o >= 1; o >>= 1) v += __shfl_xor(v, o); return v; }
DI bf16x8 pack8(float a0, float a1, float a2, float a3, float a4, float a5, float a6, float a7) {
    u32x4 p; p.x = pk2(a0, a1); p.y = pk2(a2, a3); p.z = pk2(a4, a5); p.w = pk2(a6, a7); return __builtin_bit_cast(bf16x8, p);
}
DI bf16x8 ld8(const bf16_t* p) { return *(const bf16x8*)p; }
DI bf16x8 cvt8(const float* p) { const f32x4 a = *(const f32x4*)p, b = *(const f32x4*)(p + 4); return pack8(a[0], a[1], a[2], a[3], b[0], b[1], b[2], b[3]); }
DI float dpp_xor1(float v) { return __builtin_bit_cast(float, __builtin_amdgcn_update_dpp(0, __builtin_bit_cast(int, v), 0xB1, 0xF, 0xF, true)); }
DI float dpp_xor2(float v) { return __builtin_bit_cast(float, __builtin_amdgcn_update_dpp(0, __builtin_bit_cast(int, v), 0x4E, 0xF, 0xF, true)); }
DI int t5_bucket(int rel) { if (rel < 16) return rel; const int b = 16 + (int)(logf((float)rel * (1.0f / 16.0f)) / logf(8.0f) * 16.0f); return b < 31 ? b : 31; }

#define XB_TMO      128
#define XB_XCNT(j)  (256  + 64 * (j))
#define XB_XSUB(j)  (1280 + 64 * (j))
#define XB_XGEN(j)  (2304 + 64 * (j))
#define XB_TOP      3328
#define XB_TOPGEN   3392
#define XCD_BAR_WORDS 3456
#define XB_SPIN_CAP (1u << 18)

__device__ __forceinline__ unsigned xb_ld(unsigned* p)              { return __hip_atomic_load(p, __ATOMIC_RELAXED, __HIP_MEMORY_SCOPE_AGENT); }
__device__ __forceinline__ unsigned xb_add(unsigned* p, unsigned v) { return __hip_atomic_fetch_add(p, v, __ATOMIC_RELAXED, __HIP_MEMORY_SCOPE_AGENT); }
__device__ __forceinline__ unsigned xb_xcc_id() { return (unsigned)__builtin_amdgcn_s_getreg((3 << 11) | 20) & 0xFu; }
#define XB_SPIN(cond, bar) do { unsigned _sp = 0; while (cond) { __builtin_amdgcn_s_sleep(1); \
    if ((++_sp & 255u) == 0u) { if (xb_ld(&(bar)[XB_TMO])) break; if (_sp > XB_SPIN_CAP) { atomicAdd(&(bar)[XB_TMO], 1u); break; } } } } while (0)

struct XcdBarrier {
    unsigned* bar; unsigned x;
    volatile LAS unsigned* st;
};

__device__ __forceinline__ XcdBarrier xcd_barrier_post(unsigned* bar, volatile LAS unsigned* st) {
    XcdBarrier b; b.bar = bar; b.x = xb_xcc_id(); b.st = st;
    if (threadIdx.x == 0) (void)xb_add(&bar[XB_XCNT(b.x)], 1u);
    return b;
}
__device__ __forceinline__ void xcd_barrier_complete(unsigned* bar, unsigned x, unsigned& nloc, unsigned& nx) {
    const unsigned G = gridDim.x * gridDim.y * gridDim.z;
    unsigned sum, cnt, mine, sp = 0u;
    for (;;) {
        sum = 0u; cnt = 0u; mine = 0u;
#pragma unroll
        for (unsigned j = 0; j < 16; ++j) { const unsigned c = xb_ld(&bar[XB_XCNT(j)]); sum += c; cnt += (c > 0u) ? 1u : 0u; mine = (j == x) ? c : mine; }
        if (sum == G) break;
        __builtin_amdgcn_s_sleep(1);
        if ((++sp & 255u) == 0u) { if (xb_ld(&bar[XB_TMO])) break; if (sp > XB_SPIN_CAP) { atomicAdd(&bar[XB_TMO], 1u); break; } }
    }
    nloc = mine > 0u ? mine : 1u; nx = cnt > 0u ? cnt : 1u;
}

__device__ __forceinline__ void xcd_barrier(const XcdBarrier& b) {
    asm volatile("s_waitcnt vmcnt(0)" ::: "memory");
    __syncthreads();
    if (threadIdx.x == 0) {
        unsigned* bar = b.bar;
        __builtin_amdgcn_s_waitcnt(0);
        unsigned nloc = b.st[0], nx = b.st[1];
        if (nloc == 0u) { xcd_barrier_complete(bar, b.x, nloc, nx); b.st[0] = nloc; b.st[1] = nx; }
        const unsigned old = xb_add(&bar[XB_XSUB(b.x)], 1u);
        const unsigned gen = old / nloc;
        if (old + 1u == (gen + 1u) * nloc) {
            __builtin_amdgcn_fence(__ATOMIC_RELEASE, "agent");
            asm volatile("s_waitcnt vmcnt(0)" ::: "memory");
            const unsigned og = xb_add(&bar[XB_TOP], 1u);
            const unsigned tg = og / nx;
            if (og + 1u == (tg + 1u) * nx) xb_add(&bar[XB_TOPGEN], 1u);
            else XB_SPIN(xb_ld(&bar[XB_TOPGEN]) == tg, bar);
            __builtin_amdgcn_fence(__ATOMIC_ACQUIRE, "agent");
            xb_add(&bar[XB_XGEN(b.x)], 1u);
            asm volatile("s_waitcnt vmcnt(0)" ::: "memory");
        } else {
            XB_SPIN(xb_ld(&bar[XB_XGEN(b.x)]) == gen, bar);
            __builtin_amdgcn_fence(__ATOMIC_ACQUIRE, "agent");
            asm volatile("s_waitcnt vmcnt(0)" ::: "memory");
        }
    }
    __syncthreads();
}

namespace pg8 {
#define PG8_LAS LAS
constexpr int BM = 256, BK = 64, HALF = 128, HTB = HALF * BK * 2  , STAGE_BYTES = 8 * HTB, NXCD = 8, WGM = 8;

__host__ __device__ __forceinline__ int lds_byte(int r, int c) { const int st = (r >> 4) * 2 + (c >> 5), rr = r & 15, cc = c & 31, ob = rr * 64 + cc * 2; return st * 1024 + (ob ^ (((ob >> 9) & 1) << 5)); }
__host__ __device__ __forceinline__ void stage_rc(int b, int& R, int& C) { const int st = b / 1024, sb = b % 1024, swz = sb ^ (((sb >> 9) & 1) << 5); R = (st >> 1) * 16 + swz / 64; C = (st & 1) * 32 + (swz % 64) / 2; }
__host__ __device__ __forceinline__ int perm32(int rho) { const int n = rho >> 4, i = rho & 15; return 8 * (i >> 2) + 4 * n + (i & 3); }

struct Unit { int pm, pn; size_t ka, kb; };
struct Gemm { const bf16_t* A; const bf16_t* Bt; int M, N, K, lda, ldb; };

struct StaticOrder {
    int nM, nN, nwg, G, c;
    __host__ __device__ void init(int M, int N, int G_, int c_) { nM = M / BM; nN = N / BM; nwg = nM * nN; G = G_; c = c_; }
    __host__ __device__ bool next(int i, Unit& u) const {
        const long L = (long)i * G + c; if (L >= nwg) return false;
        int wgid = (int)L; { const int q = nwg / NXCD, r = nwg % NXCD, xcd = wgid % NXCD, off = wgid / NXCD; wgid = (xcd < r ? xcd * (q + 1) : r * (q + 1) + (xcd - r) * q) + off; }
        const int nig = WGM * nN, gid = wgid / nig, fm = gid * WGM, gsz = (nM - fm) < WGM ? (nM - fm) : WGM;
        u.pm = fm + ((wgid % nig) % gsz); u.pn = (wgid % nig) / gsz; u.ka = 0; u.kb = 0; return true;
    }
    __device__ __forceinline__ void a_ready(const Unit&) const {}
    __device__ __forceinline__ void done(const Unit&) const {}
};
template <class Epi, class Sched, bool STAMP = false>
__device__ __forceinline__ void gemm_phase(PG8_LAS unsigned char* lds, const Gemm g, const Sched& S, const Epi& E, unsigned long long* stamps) {
    const int tid = ltid(), wid = __builtin_amdgcn_readfirstlane(tid >> 6), lane = tid & 63, wr = wid >> 2, wc = wid & 3, fr = lane & 15, fq = lane >> 4;
    const int K = g.K, nt = K / BK;
    int ts_lo = 0, ts_hi = 0, nts = 0; const unsigned long long rt_entry = STAMP ? (unsigned long long)wall_clock64() : 0ull;
#define PG8_STAMP() do { if (STAMP && wid == 0 && nts < 64) { const unsigned long long _c = (unsigned long long)clock64(); \
        ts_lo = (lane == nts) ? (int)(unsigned)_c : ts_lo; ts_hi = (lane == nts) ? (int)(unsigned)(_c >> 32) : ts_hi; ++nts; } } while (0)
    PG8_STAMP();
    unsigned voffA[2], voffB[2];
#pragma unroll
    for (int i = 0; i < 2; ++i) { int R, C; stage_rc(tid * 16 + i * 8192, R, C); const int Rb = Epi::PERM ? ((R & ~31) + perm32(R & 31)) : R;
        voffA[i] = (unsigned)(R * g.lda + C) * 2u; voffB[i] = (unsigned)(Rb * g.ldb + C) * 2u; }
    const size_t kstep = (size_t)(BK * 2);
    const size_t hstepA = (size_t)HALF * g.lda * 2, hstepB = (size_t)HALF * g.ldb * 2;
    const size_t tstepA = 2 * hstepA, tstepB = 2 * hstepB;
    const unsigned ldsw = (unsigned)wid * 1024u;
    const int aoff = lds_byte(wr * 64 + fr, fq * 8), boff = lds_byte(wc * 32 + fr, fq * 8);
#define PG8_SA(b, h) (((b) * 2 + (h)) * HTB)
#define PG8_SB(b, h) ((4 + (b) * 2 + (h)) * HTB)
#define PG8_STAGE(bufoff, gbase, voff) do { _Pragma("unroll") for (int _i = 0; _i < 2; ++_i) \
        __builtin_amdgcn_global_load_lds((const unsigned*)((const char*)(gbase) + (voff)[_i]), (PG8_LAS unsigned*)(lds + (bufoff) + ldsw + _i * 8192), 16, 0, 0); } while (0)
#define PG8_LDA(dst, b, h) do { _Pragma("unroll") for (int m = 0; m < 4; ++m) _Pragma("unroll") for (int k = 0; k < 2; ++k) dst[m][k] = *(const PG8_LAS bf16x8*)(lds + PG8_SA(b, h) + aoff + m * 2048 + k * 1024); } while (0)
#define PG8_LDB(dst, b, h) do { _Pragma("unroll") for (int n = 0; n < 2; ++n) _Pragma("unroll") for (int k = 0; k < 2; ++k) dst[n][k] = *(const PG8_LAS bf16x8*)(lds + PG8_SB(b, h) + boff + n * 2048 + k * 1024); } while (0)
#define PG8_MMA(ai, bj, At, Bt) do { __builtin_amdgcn_s_setprio(1); _Pragma("unroll") for (int m = 0; m < 4; ++m) _Pragma("unroll") for (int n = 0; n < 2; ++n) _Pragma("unroll") for (int k = 0; k < 2; ++k) \
        acc[ai][bj][m][n] = __builtin_amdgcn_mfma_f32_16x16x32_bf16(Bt[n][k], At[m][k], acc[ai][bj][m][n], 0, 0, 0); __builtin_amdgcn_s_setprio(0); } while (0)
#define PG8_WAIT_V(n) asm volatile("s_waitcnt vmcnt(" #n ")" ::: "memory")
#define PG8_WAIT_L(n) asm volatile("s_waitcnt lgkmcnt(" #n ")" ::: "memory")
#define PG8_BAR __builtin_amdgcn_s_barrier()
#define PG8_SCHED __builtin_amdgcn_sched_barrier(0)
    Unit cur, nxt; int ui = 0;
    if (!S.next(0, cur)) return;
    f32x4 acc[2][2][4][2];
#pragma unroll
    for (int a = 0; a < 2; ++a)
#pragma unroll
        for (int b = 0; b < 2; ++b)
#pragma unroll
            for (int m = 0; m < 4; ++m)
#pragma unroll
                for (int n = 0; n < 2; ++n) acc[a][b][m][n] = (f32x4){0.f, 0.f, 0.f, 0.f};
    bf16x8 At[4][2], B0[2][2], B1[2][2];
    const char* cA = (const char*)g.A + (size_t)cur.pm * tstepA + cur.ka * 2; const char* cB = (const char*)g.Bt + (size_t)cur.pn * tstepB + cur.kb * 2;
    S.a_ready(cur);
    PG8_STAGE(PG8_SB(0, 0), cB, voffB); PG8_STAGE(PG8_SA(0, 0), cA, voffA); PG8_STAGE(PG8_SB(0, 1), cB + hstepB, voffB); PG8_STAGE(PG8_SA(0, 1), cA + hstepA, voffA);
    if (wr == 1) PG8_BAR;
    PG8_WAIT_V(4); PG8_BAR;
    PG8_STAGE(PG8_SB(1, 0), cB + kstep, voffB); PG8_STAGE(PG8_SA(1, 0), cA + kstep, voffA); PG8_STAGE(PG8_SB(1, 1), cB + hstepB + kstep, voffB);
    PG8_WAIT_V(6); PG8_BAR;
    PG8_STAMP();
    for (;;) {
        const bool has_next = S.next(ui + 1, nxt);
        const char* nA = has_next ? (const char*)g.A + (size_t)nxt.pm * tstepA + nxt.ka * 2 : cA; const char* nB = has_next ? (const char*)g.Bt + (size_t)nxt.pn * tstepB + nxt.kb * 2 : cB;
        for (int t = 0; t < nt; t += 2) {
            const bool last = (t == nt - 2);
            const char* a1 = cA + (size_t)(t + 1) * kstep;
            const char* a2 = last ? nA : cA + (size_t)(t + 2) * kstep; const char* b2 = last ? nB : cB + (size_t)(t + 2) * kstep;
            const char* a3 = a2 + kstep; const char* b3 = b2 + kstep;
            if (last && has_next) S.a_ready(nxt);
            PG8_LDB(B0, 0, 0); PG8_SCHED; PG8_LDA(At, 0, 0); PG8_STAGE(PG8_SA(1, 1), a1 + hstepA, voffA);
            PG8_WAIT_L(8); PG8_BAR; PG8_WAIT_L(0); PG8_MMA(0, 0, At, B0); PG8_BAR; PG8_SCHED;
            PG8_LDB(B1, 0, 1); PG8_STAGE(PG8_SB(0, 0), b2, voffB);
            PG8_BAR; PG8_WAIT_L(0); PG8_MMA(0, 1, At, B1); PG8_BAR;
            PG8_LDA(At, 0, 1); PG8_STAGE(PG8_SA(0, 0), a2, voffA);
            PG8_BAR; PG8_WAIT_L(0); PG8_MMA(1, 0, At, B0); PG8_BAR; PG8_SCHED;
            PG8_STAGE(PG8_SB(0, 1), b2 + hstepB, voffB);
            PG8_WAIT_V(6); PG8_BAR; PG8_MMA(1, 1, At, B1); PG8_BAR;
            PG8_LDB(B0, 1, 0); PG8_SCHED; PG8_LDA(At, 1, 0); PG8_STAGE(PG8_SA(0, 1), a2 + hstepA, voffA);
            PG8_WAIT_L(8); PG8_BAR; PG8_WAIT_L(0); PG8_MMA(0, 0, At, B0); PG8_BAR; PG8_SCHED;
            PG8_LDB(B1, 1, 1); PG8_STAGE(PG8_SB(1, 0), b3, voffB);
            PG8_BAR; PG8_WAIT_L(0); PG8_MMA(0, 1, At, B1); PG8_BAR;
            PG8_LDA(At, 1, 1); PG8_STAGE(PG8_SA(1, 0), a3, voffA);
            PG8_BAR; PG8_WAIT_L(0); PG8_MMA(1, 0, At, B0); PG8_BAR; PG8_SCHED;
            PG8_STAGE(PG8_SB(1, 1), b3 + hstepB, voffB);
            PG8_WAIT_V(6); PG8_BAR; PG8_MMA(1, 1, At, B1); PG8_BAR;
        }
        PG8_STAMP();
        if constexpr (!Epi::AFTER_DRAIN) { E(acc, cur, wr, wc, fr, fq); S.done(cur); }
        PG8_STAMP();
        if (!has_next) break;
#pragma unroll
        for (int a = 0; a < 2; ++a)
#pragma unroll
            for (int b = 0; b < 2; ++b)
#pragma unroll
                for (int m = 0; m < 4; ++m)
#pragma unroll
                    for (int n = 0; n < 2; ++n) acc[a][b][m][n] = (f32x4){0.f, 0.f, 0.f, 0.f};
        cur = nxt; cA = nA; cB = nB; ++ui;
    }
    PG8_WAIT_V(0);
    if (wr == 0) PG8_BAR;
    PG8_BAR;
    if constexpr (Epi::AFTER_DRAIN) { E.fused(acc, cur, wr, wc, fr, fq, lds, wid, lane); S.done(cur); }
    PG8_STAMP();
    if (STAMP && wid == 0) { stamps[lane] = lane < nts ? (((unsigned long long)(unsigned)ts_hi << 32) | (unsigned)ts_lo) : 0ull;
        if (lane == 62) stamps[62] = rt_entry; if (lane == 63) stamps[63] = (unsigned long long)wall_clock64(); }
#undef PG8_STAMP
#undef PG8_SA
#undef PG8_SB
#undef PG8_STAGE
#undef PG8_LDA
#undef PG8_LDB
#undef PG8_MMA
#undef PG8_WAIT_V
#undef PG8_WAIT_L
#undef PG8_BAR
#undef PG8_SCHED
}
}

namespace pg8 {
struct EpiZ {
    static constexpr bool PERM = true, AFTER_DRAIN = false;
    bf16_t* O; int ldc;
    DI void operator()(const f32x4 (&acc)[2][2][4][2], const Unit& u, int wr, int wc, int fr, int fq) const {
        const int row0 = u.pm * BM + wr * 64 + fr, col0 = u.pn * BM + wc * 32 + 8 * fq;
#pragma unroll
        for (int ai = 0; ai < 2; ++ai)
#pragma unroll
            for (int m = 0; m < 4; ++m) { bf16_t* rowp = O + (size_t)(row0 + ai * HALF + m * 16) * ldc + col0;
#pragma unroll
                for (int bj = 0; bj < 2; ++bj) { const f32x4 v0 = acc[ai][bj][m][0], v1 = acc[ai][bj][m][1];
                    u32x4 w; w.x = pk2(v0[0], v0[1]); w.y = pk2(v0[2], v0[3]); w.z = pk2(v1[0], v1[1]); w.w = pk2(v1[2], v1[3]);
                    *(u32x4*)(rowp + bj * HALF) = w; } }
    }
};
struct EpiHid {
    static constexpr bool PERM = true, AFTER_DRAIN = false;
    bf16_t* O; const float* bias;
    DI void operator()(const f32x4 (&acc)[2][2][4][2], const Unit& u, int wr, int wc, int fr, int fq) const {
        const int row0 = u.pm * BM + wr * 64 + fr, col0 = wc * 32 + 8 * fq;
        const float* b = bias + (u.pm >> 6) * 256;
        f32x4 bv[2][2];
#pragma unroll
        for (int bj = 0; bj < 2; ++bj)
#pragma unroll
            for (int n = 0; n < 2; ++n) bv[bj][n] = *(const f32x4*)(b + col0 + bj * HALF + 4 * n);
#pragma unroll
        for (int ai = 0; ai < 2; ++ai)
#pragma unroll
            for (int m = 0; m < 4; ++m) { bf16_t* rowp = O + (size_t)(row0 + ai * HALF + m * 16) * 256 + col0;
#pragma unroll
                for (int bj = 0; bj < 2; ++bj) { f32x4 v0 = acc[ai][bj][m][0] + bv[bj][0], v1 = acc[ai][bj][m][1] + bv[bj][1];
#pragma unroll
                    for (int j = 0; j < 4; ++j) { v0[j] = gelu_tanh(v0[j]); v1[j] = gelu_tanh(v1[j]); }
                    u32x4 w; w.x = pk2(v0[0], v0[1]); w.y = pk2(v0[2], v0[3]); w.z = pk2(v1[0], v1[1]); w.w = pk2(v1[2], v1[3]);
                    *(u32x4*)(rowp + bj * HALF) = w; } }
    }
};
struct EpiY {
    static constexpr bool PERM = false, AFTER_DRAIN = false;
    const float* X; float* Y; const float* gate;
    DI void operator()(const f32x4 (&acc)[2][2][4][2], const Unit& u, int wr, int wc, int fr, int fq) const {
        const int row0 = u.pm * BM + wr * 64 + fr, col0 = u.pn * BM + wc * 32 + 4 * fq;
        const float* g = gate + (size_t)((u.pm * BM) / SEQ) * 6144 + 4096;
        f32x4 gv[2][2];
#pragma unroll
        for (int bj = 0; bj < 2; ++bj)
#pragma unroll
            for (int n = 0; n < 2; ++n) gv[bj][n] = *(const f32x4*)(g + col0 + bj * HALF + n * 16);
#pragma unroll
        for (int ai = 0; ai < 2; ++ai)
#pragma unroll
            for (int m = 0; m < 4; ++m) { const size_t off = (size_t)(row0 + ai * HALF + m * 16) * DM + col0;
#pragma unroll
                for (int bj = 0; bj < 2; ++bj)
#pragma unroll
                    for (int n = 0; n < 2; ++n) { const f32x4 x = *(const f32x4*)(X + off + bj * HALF + n * 16);
                        *(f32x4*)(Y + off + bj * HALF + n * 16) = x + gv[bj][n] * acc[ai][bj][m][n]; }
                asm volatile("" ::: "memory"); }
    }
};
struct OrderCmpS {
    int G, c;
    DI bool next(int i, Unit& u) const { const int L = i * G + c; if (L >= 256) return false; u.pm = L; u.pn = 0; u.ka = 0; u.kb = (size_t)(L >> 6) * 256 * 4096; return true; }
    DI void a_ready(const Unit&) const {}
    DI void done(const Unit&) const {}
};
}

template <int MT, int NT, class AF, class BF, class EP>
DI void thin_gemm_block(LAS unsigned char* lds, int K, AF aptr, BF bptr, EP ep) {
    const int tid = ltid(), w = tid >> 6, lane = tid & 63, li = lane & 15, quad = lane >> 4;
    const int kw = K / 8, kb = w * kw;
    f32x4 acc[MT][NT];
#pragma unroll
    for (int i = 0; i < MT; ++i)
#pragma unroll
        for (int j = 0; j < NT; ++j) acc[i][j] = (f32x4){0.f, 0.f, 0.f, 0.f};
    const bf16_t* ap[MT]; const bf16_t* bp[NT];
#pragma unroll
    for (int i = 0; i < MT; ++i) ap[i] = aptr(i * 16 + li) + kb + quad * 8;
#pragma unroll
    for (int j = 0; j < NT; ++j) bp[j] = bptr(j * 16 + li) + kb + quad * 8;
#pragma unroll 2
    for (int k = 0; k < kw; k += 32) {
        bf16x8 af[MT], bf[NT];
#pragma unroll
        for (int i = 0; i < MT; ++i) af[i] = ld8(ap[i] + k);
#pragma unroll
        for (int j = 0; j < NT; ++j) bf[j] = ld8(bp[j] + k);
#pragma unroll
        for (int i = 0; i < MT; ++i)
#pragma unroll
            for (int j = 0; j < NT; ++j) acc[i][j] = mfma16(af[i], bf[j], acc[i][j]);
    }
    LAS float* part = (LAS float*)lds;
#pragma unroll
    for (int i = 0; i < MT; ++i)
#pragma unroll
        for (int j = 0; j < NT; ++j)
#pragma unroll
            for (int e = 0; e < 4; ++e) part[((w * MT * NT + i * NT + j) * 4 + e) * 64 + lane] = acc[i][j][e];
    __syncthreads();
    for (int x = tid; x < MT * NT * 256; x += 512) {
        const int tile = x >> 8, r = x & 255, e = r >> 6, ln = r & 63;
        float s = 0.f;
#pragma unroll
        for (int ww = 0; ww < 8; ++ww) s += part[((ww * MT * NT + tile) * 4 + e) * 64 + ln];
        ep((tile / NT) * 16 + (ln >> 4) * 4 + e, (tile % NT) * 16 + (ln & 15), s);
    }
    __syncthreads();
}

DI int win_col(int n) {
    if (n < 2560) return n; if (n < 5632) return n + 24; if (n < 6144) return n + 92;
    const int j = n - 6144; if (j < 64) return 5656 + j; if (j < 88) return 2560 + (j - 64); if (j < 92) return 5720 + (j - 88); return -1;
}
template <class CM>
DI void transpose_tile(LAS float* tile, const float* src, size_t src_ld, bf16_t* dst, size_t dst_ld, int k0, int n0, int nmax, CM colmap) {
    const int tid = ltid();
    { const int c = tid & 63, kq = tid >> 6, n = n0 + c; const int sc = (n < nmax) ? colmap(n) : -1;
#pragma unroll
      for (int i = 0; i < 8; ++i) { const int k = kq + 8 * i; tile[k * 65 + c] = (sc >= 0) ? src[(size_t)(k0 + k) * src_ld + sc] : 0.f; } }
    __syncthreads();
    { const int nn = tid >> 3, k8 = tid & 7;
      if (n0 + nn < nmax) { float v[8];
#pragma unroll
          for (int i = 0; i < 8; ++i) v[i] = tile[(k8 * 8 + i) * 65 + nn];
          u32x4 w; w.x = pk2(v[0], v[1]); w.y = pk2(v[2], v[3]); w.z = pk2(v[4], v[5]); w.w = pk2(v[6], v[7]);
          *(u32x4*)(dst + (size_t)(n0 + nn) * dst_ld + k0 + k8 * 8) = w; } }
    __syncthreads();
}

constexpr int PJ_WIN = 2 * 98 * 32, PJ_WOUT = 2 * 32 * 32, PJ_W1 = 4 * 4 * 64, PJ_W2 = 4 * 2 * 4, PJ_PW = 8 * 2 * 2;
constexpr int PJ_T_END = PJ_WIN + PJ_WOUT + PJ_W1 + PJ_W2 + PJ_PW;
constexpr int PJ_MOD = 192, PJ_CB = 16, PJ_ACV = 2048, PJ_BT = 1;
constexpr int PJ_TOTAL = PJ_T_END + PJ_MOD + PJ_CB + PJ_ACV + PJ_BT;

DI void prologue_unit(ArgsP a, LAS unsigned char* lds, int u) {
    const int tid = ltid();
    LAS float* tile = (LAS float*)lds;
    auto ident = [](int n) { return n; };
    if (u < PJ_WIN) { const int l = u / 3136, r = u % 3136, nt = r / 32, kt = r % 32;
        transpose_tile(tile, a->in[I_WIN] + (size_t)l * DM * NIN, NIN, (bf16_t*)(a->ws + WS_WINT) + (size_t)l * WIN_ROWS * DM, DM, kt * 64, nt * 64, WIN_ROWS, [](int n) { return win_col(n); });
        return; }
    u -= PJ_WIN;
    if (u < PJ_WOUT) { const int l = u / 1024, r = u % 1024, nt = r / 32, kt = r % 32;
        transpose_tile(tile, a->in[I_WOUT] + (size_t)l * DM * DM, DM, (bf16_t*)(a->ws + WS_WOUTT) + (size_t)l * DM * DM, DM, kt * 64, nt * 64, DM, ident);
        return; }
    u -= PJ_WOUT;
    if (u < PJ_W1) { const int g = u / 256, r = u % 256, nt = r / 64, kt = r % 64;
        transpose_tile(tile, a->in[I_W1] + (size_t)g * 4096 * 256, 256, (bf16_t*)(a->ws + WS_W1T) + (size_t)g * 256 * 4096, 4096, kt * 64, nt * 64, 256, ident);
        return; }
    u -= PJ_W1;
    if (u < PJ_W2) { const int g = u / 8, r = u % 8, nt = r / 4, kt = r % 4;
        transpose_tile(tile, a->in[I_W2] + (size_t)g * 256 * 128, 128, (bf16_t*)(a->ws + WS_W2T) + (size_t)g * 128 * 256, 256, kt * 64, nt * 64, 128, ident);
        return; }
    u -= PJ_W2;
    if (u < PJ_PW) { const int g = u / 4, r = u % 4, nt = r / 2, kt = r % 2;
        transpose_tile(tile, a->in[I_PW] + (size_t)g * 128 * 128, 128, (bf16_t*)(a->ws + WS_PWT) + (size_t)g * 128 * 128, 128, kt * 64, nt * 64, 128, ident);
        return; }
    u -= PJ_PW;
    if (u < PJ_MOD) {
        const int l = u / 96, cg = u % 96;
        LAS float* sil = (LAS float*)lds; LAS float* red = sil + 10 * 2048;
        for (int i = tid; i < 10 * 2048; i += 512) { const int r = i >> 11, k = i & 2047; const float c = (r < 2) ? a->in[I_CP][r * DM + k] : a->in[I_CSM][(r - 2) * DM + k]; sil[i] = siluf_(c); }
        __syncthreads();
        const int ks = tid >> 6, cc = tid & 63, col = cg * 64 + cc;
        float acc[10];
#pragma unroll
        for (int r = 0; r < 10; ++r) acc[r] = 0.f;
        const float* wp = a->in[I_WADA] + (size_t)l * DM * 6144 + col;
        for (int k = ks * 256; k < ks * 256 + 256; ++k) { const float w = wp[(size_t)k * 6144];
#pragma unroll
            for (int r = 0; r < 10; ++r) acc[r] += sil[r * 2048 + k] * w; }
#pragma unroll
        for (int r = 0; r < 10; ++r) red[(ks * 10 + r) * 64 + cc] = acc[r];
        __syncthreads();
        for (int i = tid; i < 640; i += 512) { const int r = i >> 6, c2 = i & 63; float s = 0.f;
#pragma unroll
            for (int k2 = 0; k2 < 8; ++k2) s += red[(k2 * 10 + r) * 64 + c2];
            ((float*)(a->ws + WS_MOD))[(size_t)(l * 10 + r) * 6144 + cg * 64 + c2] = s + a->in[I_BADA][l * 6144 + cg * 64 + c2]; }
        __syncthreads();
        return; }
    u -= PJ_MOD;
    if (u < PJ_CB) {
        const int g = u / 4, cg = u % 4;
        LAS float* pe = (LAS float*)lds; LAS float* red = pe + 4096;
        for (int i = tid; i < 4096; i += 512) pe[i] = a->in[I_PE][(size_t)g * 4096 + i];
        __syncthreads();
        const int ks = tid >> 6, cc = tid & 63, col = cg * 64 + cc;
        const float* wp = a->in[I_W1] + (size_t)g * 4096 * 256 + col;
        float acc = 0.f;
        for (int k = ks * 512; k < ks * 512 + 512; ++k) acc += pe[k] * wp[(size_t)k * 256];
        red[ks * 64 + cc] = acc;
        __syncthreads();
        if (tid < 64) { float s = 0.f;
#pragma unroll
            for (int k2 = 0; k2 < 8; ++k2) s += red[k2 * 64 + tid];
            ((float*)(a->ws + WS_CBIAS))[g * 256 + cg * 64 + tid] = s + a->in[I_B1][g * 256 + cg * 64 + tid]; }
        __syncthreads();
        return; }
    u -= PJ_CB;
    if (u < PJ_ACV) {
        const int l = u / 1024, r = u % 1024, b = r / 128, pi = r % 128;
        const int page = a->page_table[b * NPAGES + pi];
        const float* src = a->in[I_CA] + ((size_t)(l * NPOOL + page) * PAGE) * 1024;
        bf16_t* dst = (bf16_t*)(a->ws + WS_ACMPS);
        const int f4 = tid & 127, rq = tid >> 7;
        const int kv = f4 >> 6, kvh = (f4 >> 5) & 1, d = (f4 & 31) * 4;
        for (int rr = rq; rr < 128; rr += 4) {
            const f32x4 v = *(const f32x4*)(src + (size_t)rr * 1024 + f4 * 4);
            const size_t m = ((size_t)((l * 2 + kv) * 16 + b * 2 + kvh)) * 1024 + pi * 8 + (rr >> 4);
            u32x2 w; w.x = pk2(v[0], v[1]); w.y = pk2(v[2], v[3]);
            *(u32x2*)(dst + m * 2048 + (rr & 15) * 128 + d) = w;
        }
        return; }
    u -= PJ_ACV;
    {
        float* bt = (float*)(a->ws + WS_BIAS);
        if (tid < 129) { const int bk = t5_bucket(tid);
            for (int h = 0; h < 8; ++h) bt[tid * 8 + h] = a->in[I_RB][bk * 12 + h] * LOG2E;
            for (int h = 0; h < 4; ++h) bt[129 * 8 + tid * 4 + h] = a->in[I_RB][bk * 12 + 8 + h] * LOG2E; }
    }
}

DI void cmp2_sample_unit(ArgsP a, int u) {
    const int tid = ltid(), w = tid >> 6, lane = tid & 63, li = lane & 15, quad = lane >> 4;
    const int m0 = (u * 8 + w) * 16;
    const int grp = m0 >> 14, l = grp >> 1, kv = grp & 1, g = (m0 >> 10) & 15, i0 = m0 & 1023;
    const bf16_t* hid = (const bf16_t*)(a->ws + WS_HIDS) + (size_t)(m0 + li) * 256 + quad * 8;
    const bf16_t* w2 = (const bf16_t*)(a->ws + WS_W2T) + (size_t)grp * 128 * 256 + (size_t)li * 256 + quad * 8;
    f32x4 acc[8];
#pragma unroll
    for (int nt = 0; nt < 8; ++nt) acc[nt] = (f32x4){0.f, 0.f, 0.f, 0.f};
#pragma unroll
    for (int kk = 0; kk < 8; ++kk) { const bf16x8 af = ld8(hid + kk * 32);
#pragma unroll
        for (int nt = 0; nt < 8; ++nt) acc[nt] = mfma16(af, ld8(w2 + (size_t)nt * 16 * 256 + kk * 32), acc[nt]); }
    const float* b2 = a->in[I_B2] + grp * 128;
#pragma unroll
    for (int nt = 0; nt < 8; ++nt) { const float bb = b2[nt * 16 + li];
#pragma unroll
        for (int e = 0; e < 4; ++e) acc[nt][e] += bb; }
    if (kv == 0) {
        const float* gn = a->in[I_AKN] + (size_t)l * 3 * 128;
        float ss[4];
#pragma unroll
        for (int e = 0; e < 4; ++e) { float s = 0.f;
#pragma unroll
            for (int nt = 0; nt < 8; ++nt) s += acc[nt][e] * acc[nt][e];
            s += __shfl_xor(s, 1); s += __shfl_xor(s, 2); s += __shfl_xor(s, 4); s += __shfl_xor(s, 8);
            ss[e] = rsqrtf(s * (1.0f / 128.0f) + EPS); }
        bf16_t* kc = (bf16_t*)(a->ws + WS_KCS) + ((size_t)(l * 16 + g) * 1024 + i0) * 128;
#pragma unroll
        for (int nt = 0; nt < 8; ++nt) { const float gg = gn[nt * 16 + li];
#pragma unroll
            for (int e = 0; e < 4; ++e) { const int i = quad * 4 + e; kc[(size_t)i * 128 + nt * 16 + li] = (i0 + i < NC_S) ? f2bf(acc[nt][e] * ss[e] * gg) : (bf16_t)0; } }
    } else {
        bf16_t* vt = (bf16_t*)(a->ws + WS_VCST) + (size_t)(l * 16 + g) * 128 * 1024;
#pragma unroll
        for (int nt = 0; nt < 8; ++nt) { float v[4];
#pragma unroll
            for (int e = 0; e < 4; ++e) v[e] = (i0 + quad * 4 + e < NC_S) ? acc[nt][e] : 0.f;
            u32x2 wv; wv.x = pk2(v[0], v[1]); wv.y = pk2(v[2], v[3]);
            *(u32x2*)(vt + (size_t)(nt * 16 + li) * 1024 + i0 + quad * 4) = wv; }
    }
}

DI void l1_rows(ArgsP a, int l) {
    const int lane = ltid() & 63, gw = blockIdx.x * 8 + (ltid() >> 6), nw = gridDim.x * 8;
    const float* ng = a->in[I_NG] + l * DM; const float* modl = (const float*)(a->ws + WS_MOD) + (size_t)l * 10 * 6144;
    bf16_t* H = (bf16_t*)(a->ws + WS_H);
    for (int r = gw; r < NTOK; r += nw) {
        const float* x = (l == 0) ? (r < NTP ? a->in[I_XP] + (size_t)r * DM : a->in[I_XS] + (size_t)(r - NTP) * DM) : (const float*)(a->ws + WS_Y0) + (size_t)r * DM;
        const float* md = modl + (size_t)(r < NTP ? r / SEQ : 2 + (r - NTP) / DS) * 6144;
        f32x4 v[8]; float ss = 0.f;
#pragma unroll
        for (int i = 0; i < 8; ++i) { v[i] = *(const f32x4*)(x + (i * 64 + lane) * 4); ss += v[i][0] * v[i][0] + v[i][1] * v[i][1] + v[i][2] * v[i][2] + v[i][3] * v[i][3]; }
        ss = wave_sum(ss);
        const float inv = rsqrtf(ss * (1.0f / DM) + EPS);
#pragma unroll
        for (int i = 0; i < 8; ++i) { const int c = (i * 64 + lane) * 4;
            const f32x4 g4 = *(const f32x4*)(ng + c), sh = *(const f32x4*)(md + c), sc = *(const f32x4*)(md + 2048 + c);
            const f32x4 y = v[i] * inv * g4 * (sc + 1.0f) + sh;
            u32x2 w; w.x = pk2(y[0], y[1]); w.y = pk2(y[2], y[3]);
            *(u32x2*)(H + (size_t)r * DM + c) = w; }
    }
}

DI void l2_thin_task(ArgsP a, LAS unsigned char* lds, int l, int t) {
    const bf16_t* H = (const bf16_t*)(a->ws + WS_H); const bf16_t* W = (const bf16_t*)(a->ws + WS_WINT) + (size_t)l * WIN_ROWS * DM;
    if (t < 256) {
        float* zs = (float*)(a->ws + WS_ZS) + (size_t)t * 32 * ZSLD;
        thin_gemm_block<2, 6>(lds, DM, [&](int row) { return H + (size_t)(t * 32 + row) * DM; }, [&](int col) { return W + (size_t)(ZLD + col) * DM; },
                              [&](int row, int col, float v) { zs[row * ZSLD + col] = v; });
    } else {
        const int j = t - 256;
        bf16_t* z = (bf16_t*)(a->ws + WS_Z) + (size_t)NTP * ZLD; float* zs = (float*)(a->ws + WS_ZS) + (size_t)NTP * ZSLD;
        thin_gemm_block<2, 2>(lds, DM, [&](int row) { return H + (size_t)(NTP + row) * DM; }, [&](int col) { return W + (size_t)(j * 32 + col) * DM; },
                              [&](int row, int col, float v) { const int n = j * 32 + col; if (n < ZLD) z[(size_t)row * ZLD + n] = f2bf(v); else zs[row * ZSLD + n - ZLD] = v; });
    }
}
constexpr int L2_THIN_TASKS = 256 + 195;

DI void l5_thin_task(ArgsP a, LAS unsigned char* lds, int l, int j) {
    const bf16_t* Mx = (const bf16_t*)(a->ws + WS_MIXED) + (size_t)NTP * DM; const bf16_t* W = (const bf16_t*)(a->ws + WS_WOUTT) + (size_t)l * DM * DM;
    const float* X = (l == 0) ? a->in[I_XS] : (const float*)(a->ws + WS_Y0) + (size_t)NTP * DM;
    float* Y = (l == 0) ? (float*)(a->ws + WS_Y0) + (size_t)NTP * DM : a->out + O_YS;
    const float* modl = (const float*)(a->ws + WS_MOD) + (size_t)l * 10 * 6144;
    thin_gemm_block<2, 2>(lds, DM, [&](int row) { return Mx + (size_t)row * DM; }, [&](int col) { return W + (size_t)(j * 32 + col) * DM; },
                          [&](int row, int col, float v) { const int n = j * 32 + col; Y[(size_t)row * DM + n] = X[(size_t)row * DM + n] + modl[(size_t)(2 + row / DS) * 6144 + 4096 + n] * v; });
}

DI void unpack8(const u32x4 w, float* v) { v[0] = lo2f(w.x); v[1] = hi2f(w.x); v[2] = lo2f(w.y); v[3] = hi2f(w.y); v[4] = lo2f(w.z); v[5] = hi2f(w.z); v[6] = lo2f(w.w); v[7] = hi2f(w.w); }
DI u32x4 repack8(const float* v) { u32x4 w; w.x = pk2(v[0], v[1]); w.y = pk2(v[2], v[3]); w.z = pk2(v[4], v[5]); w.w = pk2(v[6], v[7]); return w; }

DI void l3_row(ArgsP a, int l, int r, int lane) {
    bf16_t* zr = (bf16_t*)(a->ws + WS_Z) + (size_t)r * ZLD;
    const float* zs = (const float*)(a->ws + WS_ZS) + (size_t)r * ZSLD;
    const bool smp = r >= NTP; const int rs = r - NTP;
    const int b = smp ? rs / DS : r / SEQ, t = smp ? rs % DS : r % SEQ;
    float* out = a->out;
    {
        float v[16];
        unpack8(*(const u32x4*)(zr + ZQ + lane * 16), v); unpack8(*(const u32x4*)(zr + ZQ + lane * 16 + 8), v + 8);
        float ss = 0.f;
#pragma unroll
        for (int i = 0; i < 16; ++i) ss += v[i] * v[i];
        ss += __shfl_xor(ss, 1); ss += __shfl_xor(ss, 2); ss += __shfl_xor(ss, 4);
        const float inv = rsqrtf(ss * (1.0f / 128.0f) + EPS);
        const float* gq = a->in[I_AQN] + l * 128 + (lane & 7) * 16;
#pragma unroll
        for (int i = 0; i < 16; ++i) v[i] *= inv * gq[i];
        *(u32x4*)(zr + ZQ + lane * 16) = repack8(v); *(u32x4*)(zr + ZQ + lane * 16 + 8) = repack8(v + 8);
    }
    {
        float* dkv = smp ? out + O_AKVS + (size_t)(l * NTS + rs) * 1024 : out + O_AKVP + (size_t)(l * NTP + r) * 1024;
        float* dwin = smp ? out + O_AWS + (size_t)((l * DB + b) * 512 + 508 + t) * 512 : (t >= SEQ - 512 ? out + O_AWP + (size_t)((l * NB + b) * 512 + t - (SEQ - 512)) * 512 : nullptr);
#pragma unroll
        for (int which = 0; which < 6; ++which) {
            bf16_t* p = zr + ZKV + which * 256 + lane * 4;
            const u32x2 w = *(const u32x2*)p;
            f32x4 v = {lo2f(w.x), hi2f(w.x), lo2f(w.y), hi2f(w.y)};
            if (which == 2 || which == 4) {
                float ss = v[0] * v[0] + v[1] * v[1] + v[2] * v[2] + v[3] * v[3];
                ss += __shfl_xor(ss, 1); ss += __shfl_xor(ss, 2); ss += __shfl_xor(ss, 4); ss += __shfl_xor(ss, 8); ss += __shfl_xor(ss, 16);
                const float inv = rsqrtf(ss * (1.0f / 128.0f) + EPS);
                const f32x4 gk = *(const f32x4*)(a->in[I_AKN] + (size_t)(l * 3 + (which == 2 ? 1 : 2)) * 128 + (lane & 31) * 4);
                v = v * inv * gk;
                u32x2 wo; wo.x = pk2(v[0], v[1]); wo.y = pk2(v[2], v[3]); *(u32x2*)p = wo;
            }
            if (which < 4) *(f32x4*)(dkv + which * 256 + lane * 4) = v;
            else if (dwin) *(f32x4*)(dwin + (which - 4) * 256 + lane * 4) = v;
        }
    }
    {
        float v[8]; unpack8(*(const u32x4*)(zr + ZCQ + lane * 8), v);
        float ss = 0.f;
#pragma unroll
        for (int i = 0; i < 8; ++i) ss += v[i] * v[i];
        ss += __shfl_xor(ss, 1); ss += __shfl_xor(ss, 2); ss += __shfl_xor(ss, 4); ss += __shfl_xor(ss, 8);
        const float inv = rsqrtf(ss * (1.0f / 128.0f) + EPS);
        const float* gq = a->in[I_CQN] + l * 128 + (lane & 15) * 8;
#pragma unroll
        for (int i = 0; i < 8; ++i) v[i] *= inv * gq[i];
        *(u32x4*)(zr + ZCQ + lane * 8) = repack8(v);
    }
    {
        bf16_t* p = zr + ZCKV + lane * 4;
        const u32x2 w = *(const u32x2*)p;
        f32x4 v = {lo2f(w.x), hi2f(w.x), lo2f(w.y), hi2f(w.y)};
        float ss = v[0] * v[0] + v[1] * v[1] + v[2] * v[2] + v[3] * v[3];
        ss += __shfl_xor(ss, 1); ss += __shfl_xor(ss, 2); ss += __shfl_xor(ss, 4); ss += __shfl_xor(ss, 8); ss += __shfl_xor(ss, 16);
        if (lane < 32) { const float inv = rsqrtf(ss * (1.0f / 128.0f) + EPS);
            const f32x4 gk = *(const f32x4*)(a->in[I_CKN] + l * 128 + lane * 4);
            v = v * inv * gk;
            u32x2 wo; wo.x = pk2(v[0], v[1]); wo.y = pk2(v[2], v[3]); *(u32x2*)p = wo; }
        float* d = smp ? out + O_CKVS + (size_t)(l * NTS + rs) * 256 : out + O_CKVP + (size_t)(l * NTP + r) * 256;
        *(f32x4*)(d + lane * 4) = v;
    }
    {
        const float kx = zs[ZS_IK + lane];
        float* d = smp ? out + O_KIXS + (size_t)(l * NTS + rs) * 64 : out + O_KIXP + (size_t)(l * NTP + r) * 64;
        d[lane] = kx;
        ((bf16_t*)(a->ws + WS_KIDXB))[(size_t)r * 64 + lane] = f2bf(kx);
    }
    {
        float* d = smp ? out + O_BPS + (size_t)((l * DB + b) * 15 + 11 + t) * 512 : (t >= SEQ - 15 ? out + O_BPP + (size_t)((l * NB + b) * 15 + t - (SEQ - 15)) * 512 : nullptr);
        if (d) { float v[8]; unpack8(*(const u32x4*)(zr + ZBI + lane * 8), v);
            *(f32x4*)(d + lane * 8) = (f32x4){v[0], v[1], v[2], v[3]}; *(f32x4*)(d + lane * 8 + 4) = (f32x4){v[4], v[5], v[6], v[7]}; }
    }
}

DI void pool_unit(ArgsP a, int l, int pu) {
    const int tid = ltid(), w = tid >> 6, lane = tid & 63, li = lane & 15, quad = lane >> 4;
    const bool smp = pu == 128; const int ntask = smp ? 8 : 16;
    const bf16_t* Z = (const bf16_t*)(a->ws + WS_Z);
    bf16_t* Mx = (bf16_t*)(a->ws + WS_MIXED);
    for (int task = w; task < ntask; task += 8) {
        const int mt = task >> 2, g = task & 3, wlen = 2 << g;
        const int rbase = (smp ? NTP : pu * 64) + mt * 16;
        const int r = rbase + li;
        const int t = smp ? (r - NTP) % DS : r % SEQ, bs = smp ? (r - NTP) / DS : 0;
        f32x4 acc[8];
#pragma unroll
        for (int nt = 0; nt < 8; ++nt) acc[nt] = (f32x4){0.f, 0.f, 0.f, 0.f};
        const float rc = 1.0f / (float)(smp ? wlen : (t + 1 < wlen ? t + 1 : wlen));
        const bf16_t* pw = (const bf16_t*)(a->ws + WS_PWT) + (size_t)(l * 4 + g) * 128 * 128 + (size_t)li * 128 + quad * 8;
#pragma unroll 1
        for (int kk = 0; kk < 4; ++kk) {
            const int c0 = g * 128 + kk * 32 + quad * 8;
            float s[8], cur[8];
#pragma unroll
            for (int e = 0; e < 8; ++e) { s[e] = 0.f; cur[e] = 0.f; }
            for (int i = 0; i < wlen; ++i) {
                float x[8];
                if (t - i >= 0) unpack8(*(const u32x4*)(Z + (size_t)(r - i) * ZLD + ZBI + c0), x);
                else if (smp) { const float* sp = a->in[I_SB] + (size_t)((l * DB + bs) * 15 + 15 + (t - i)) * 512 + c0;
                    const f32x4 x0 = *(const f32x4*)sp, x1 = *(const f32x4*)(sp + 4);
                    x[0] = x0[0]; x[1] = x0[1]; x[2] = x0[2]; x[3] = x0[3]; x[4] = x1[0]; x[5] = x1[1]; x[6] = x1[2]; x[7] = x1[3]; }
                else {
#pragma unroll
                    for (int e = 0; e < 8; ++e) x[e] = 0.f; }
#pragma unroll
                for (int e = 0; e < 8; ++e) { s[e] += x[e]; if (i == 0) cur[e] = x[e]; }
            }
            const bf16x8 af = pack8(s[0] * rc - cur[0], s[1] * rc - cur[1], s[2] * rc - cur[2], s[3] * rc - cur[3], s[4] * rc - cur[4], s[5] * rc - cur[5], s[6] * rc - cur[6], s[7] * rc - cur[7]);
#pragma unroll
            for (int nt = 0; nt < 8; ++nt) acc[nt] = mfma16(af, ld8(pw + (size_t)nt * 16 * 128 + kk * 32), acc[nt]);
        }
        const float* bsc = a->in[I_BSC] + l * 512 + g * 128;
#pragma unroll
        for (int nt = 0; nt < 8; ++nt) { const int col = nt * 16 + li; const float sc = bsc[col];
#pragma unroll
            for (int e = 0; e < 4; ++e) { const size_t row = (size_t)(rbase + quad * 4 + e);
                const float gate = siluf_(bf2f(Z[row * ZLD + ZBS + g * 128 + col]));
                Mx[row * DM + 1024 + g * 128 + col] = f2bf(acc[nt][e] * sc * gate); } }
    }
}

DI void cmp_prompt_unit(ArgsP a, LAS unsigned char* lds, int l, int u) {
    const int tid = ltid(), w = tid >> 6, lane = tid & 63, li = lane & 15, quad = lane >> 4;
    const int kv = u >> 6, g = (u >> 4) & 3, b = g >> 1, kvh = g & 1, i0 = (u & 15) * 16, grp = l * 2 + kv;
    LAS float* part = (LAS float*)lds; LAS bf16_t* hid = (LAS bf16_t*)(lds + 131072); LAS float* ssq = (LAS float*)(lds + 131072 + 16 * 264 * 2);
    {
        const bf16_t* zp = (const bf16_t*)(a->ws + WS_Z) + (size_t)(b * SEQ + 16 * (i0 + li) + 4 * w) * ZLD + ZKV + kv * 256 + kvh * 128 + quad * 8;
        const bf16_t* w1 = (const bf16_t*)(a->ws + WS_W1T) + (size_t)grp * 256 * 4096 + (size_t)li * 4096 + 512 * w + quad * 8;
        f32x4 acc[16];
#pragma unroll
        for (int nt = 0; nt < 16; ++nt) acc[nt] = (f32x4){0.f, 0.f, 0.f, 0.f};
#pragma unroll 2
        for (int kk = 0; kk < 16; ++kk) { const bf16x8 af = ld8(zp + (size_t)(kk >> 2) * ZLD + (kk & 3) * 32);
#pragma unroll
            for (int nt = 0; nt < 16; ++nt) acc[nt] = mfma16(af, ld8(w1 + (size_t)nt * 16 * 4096 + kk * 32), acc[nt]); }
#pragma unroll
        for (int nt = 0; nt < 16; ++nt)
#pragma unroll
            for (int e = 0; e < 4; ++e) part[(w * 16 + quad * 4 + e) * 256 + nt * 16 + li] = acc[nt][e];
    }
    __syncthreads();
    { const float* cb = (const float*)(a->ws + WS_CBIAS) + grp * 256;
      for (int x = tid; x < 4096; x += 512) { const int row = x >> 8, h = x & 255; float s = cb[h];
#pragma unroll
          for (int ww = 0; ww < 8; ++ww) s += part[(ww * 16 + row) * 256 + h];
          hid[row * 264 + h] = f2bf(gelu_tanh(s)); } }
    __syncthreads();
    f32x4 acc2 = {0.f, 0.f, 0.f, 0.f};
    { const bf16_t* w2 = (const bf16_t*)(a->ws + WS_W2T) + (size_t)grp * 128 * 256 + (size_t)(w * 16 + li) * 256 + quad * 8;
#pragma unroll
      for (int kk = 0; kk < 8; ++kk) acc2 = mfma16(*(const LAS bf16x8*)(hid + li * 264 + kk * 32 + quad * 8), ld8(w2 + kk * 32), acc2); }
    const int n = w * 16 + li;
    { const float bb = a->in[I_B2][grp * 128 + n];
#pragma unroll
      for (int e = 0; e < 4; ++e) acc2[e] += bb; }
    if (kv == 0) {
#pragma unroll
        for (int e = 0; e < 4; ++e) { float s = acc2[e] * acc2[e]; s += __shfl_xor(s, 1); s += __shfl_xor(s, 2); s += __shfl_xor(s, 4); s += __shfl_xor(s, 8);
            if (li == 0) ssq[w * 16 + quad * 4 + e] = s; }
        __syncthreads();
        const float gg = a->in[I_AKN][(size_t)l * 3 * 128 + n];
        bf16_t* kc = (bf16_t*)(a->ws + WS_KCP) + (size_t)(g * 256 + i0) * 128;
#pragma unroll
        for (int e = 0; e < 4; ++e) { const int row = quad * 4 + e; float tot = 0.f;
#pragma unroll
            for (int ww = 0; ww < 8; ++ww) tot += ssq[ww * 16 + row];
            const float inv = rsqrtf(tot * (1.0f / 128.0f) + EPS);
            kc[(size_t)row * 128 + n] = (i0 + row < NC_P) ? f2bf(acc2[e] * inv * gg) : (bf16_t)0; }
    } else {
        bf16_t* vt = (bf16_t*)(a->ws + WS_VCPT) + (size_t)(g * 128 + n) * 256 + i0 + quad * 4;
        float v[4];
#pragma unroll
        for (int e = 0; e < 4; ++e) v[e] = (i0 + quad * 4 + e < NC_P) ? acc2[e] : 0.f;
        u32x2 wv; wv.x = pk2(v[0], v[1]); wv.y = pk2(v[2], v[3]); *(u32x2*)vt = wv;
    }
    __syncthreads();
}

DI void score_sample_unit(ArgsP a, LAS unsigned char* lds, int l, int u) {
    const int tid = ltid(), b = u / 33, ch = u % 33;
    LAS float* qi = (LAS float*)lds; LAS float* wi = qi + 1024;
    const bf16_t* Z = (const bf16_t*)(a->ws + WS_Z); const float* Zs = (const float*)(a->ws + WS_ZS);
    for (int i = tid; i < 1024; i += 512) qi[i] = bf2f(Z[(size_t)(NTP + b * DS + (i >> 8)) * ZLD + ZIQ + (i & 255)]);
    if (tid < 16) wi[tid] = Zs[(size_t)(NTP + b * DS + (tid >> 2)) * ZSLD + ZS_IW + (tid & 3)];
    __syncthreads();
    const int s = ch * 512 + tid;
    if (s < PAST + DS) {
        const float* kp = (s < PAST) ? a->in[I_CI] + ((size_t)(l * NPOOL + a->page_table[b * NPAGES + (s >> 7)]) * PAGE + (s & 127)) * 64
                                     : Zs + (size_t)(NTP + b * DS + (s - PAST)) * ZSLD + ZS_IK;
        f32x4 k[16];
#pragma unroll
        for (int i = 0; i < 16; ++i) k[i] = *(const f32x4*)(kp + i * 4);
        float* sc = (float*)(a->ws + WS_SCORES);
#pragma unroll 1
        for (int tt = 0; tt < 4; ++tt) {
            float tot = 0.f;
#pragma unroll
            for (int hh = 0; hh < 4; ++hh) { float d = 0.f;
#pragma unroll
                for (int i = 0; i < 16; ++i) { const f32x4 q = *(const LAS f32x4*)(qi + (tt * 4 + hh) * 64 + i * 4); d += q[0] * k[i][0] + q[1] * k[i][1] + q[2] * k[i][2] + q[3] * k[i][3]; }
                tot += wi[tt * 4 + hh] * fmaxf(d, 0.f); }
            if (tot == 0.f) tot = 0.f;
            if (s >= PAST && s - PAST > tt) tot = -INFINITY;
            sc[(size_t)(b * DS + tt) * SCORE_LD + s] = tot;
        }
    }
    __syncthreads();
}

DI void copy_unit(ArgsP a, int l, int cu) {
    const int tid = ltid(), b = cu >> 3, part = cu & 7;
    { const f32x4* src = (const f32x4*)(a->in[I_SW] + (size_t)((l * DB + b) * 512 + 4) * 512); f32x4* dst = (f32x4*)(a->out + O_AWS + (size_t)((l * DB + b) * 512) * 512);
      for (int i = part * 8128 + tid; i < (part + 1) * 8128; i += 512) dst[i] = src[i]; }
    if (part == 0) { const f32x4* src = (const f32x4*)(a->in[I_SB] + (size_t)((l * DB + b) * 15 + 4) * 512); f32x4* dst = (f32x4*)(a->out + O_BPS + (size_t)((l * DB + b) * 15) * 512);
      for (int i = tid; i < 1408; i += 512) dst[i] = src[i]; }
}

constexpr int L3_CMP = 128, L3_SC = 8 * 33, L3_POOL = 129, L3_CP = 64, L3_ROWS = NTOK / 8;
constexpr int L3_TOTAL = L3_CMP + L3_SC + L3_POOL + L3_CP + L3_ROWS;
DI void l3_unit(ArgsP a, LAS unsigned char* lds, int l, int u) {
    if (u < L3_CMP) { cmp_prompt_unit(a, lds, l, u); return; } u -= L3_CMP;
    if (u < L3_SC) { score_sample_unit(a, lds, l, u); return; } u -= L3_SC;
    if (u < L3_POOL) { pool_unit(a, l, u); return; } u -= L3_POOL;
    if (u < L3_CP) { copy_unit(a, l, u); return; } u -= L3_CP;
    l3_row(a, l, u * 8 + (ltid() >> 6), ltid() & 63);
}

struct AttnState { float m, l; f32x4 o[8]; };
DI void attn_init(AttnState& s) { s.m = -INFINITY; s.l = 0.f;
#pragma unroll
    for (int dt = 0; dt < 8; ++dt) s.o[dt] = (f32x4){0.f, 0.f, 0.f, 0.f}; }
template <class KF, class VF, class MB>
DI void attn_tile32(AttnState& st, const bf16x8 (&qf)[4], KF kf, VF vf, MB mb) {
    f32x4 s0 = {0.f, 0.f, 0.f, 0.f}, s1 = {0.f, 0.f, 0.f, 0.f};
#pragma unroll
    for (int kk = 0; kk < 4; ++kk) { s0 = mfma16(kf(0, kk), qf[kk], s0); s1 = mfma16(kf(1, kk), qf[kk], s1); }
    float v[8];
#pragma unroll
    for (int e = 0; e < 4; ++e) { v[e] = mb(0, e, s0[e]); v[4 + e] = mb(1, e, s1[e]); }
    float mx = fmaxf(fmaxf(fmaxf(v[0], v[1]), fmaxf(v[2], v[3])), fmaxf(fmaxf(v[4], v[5]), fmaxf(v[6], v[7])));
    mx = fmaxf(mx, __shfl_xor(mx, 16)); mx = fmaxf(mx, __shfl_xor(mx, 32));
    const float mn = fmaxf(st.m, mx);
    const float mu = (mn == -INFINITY) ? 0.f : mn;
    const float alpha = fexp2(st.m - mu);
    float p[8], ps = 0.f;
#pragma unroll
    for (int e = 0; e < 8; ++e) { p[e] = fexp2(v[e] - mu); ps += p[e]; }
    st.l = st.l * alpha + ps; st.m = mn;
#pragma unroll
    for (int dt = 0; dt < 8; ++dt) st.o[dt] *= alpha;
    const bf16x8 pb = pack8(p[0], p[1], p[2], p[3], p[4], p[5], p[6], p[7]);
#pragma unroll
    for (int dt = 0; dt < 8; ++dt) { const s16x4 a0 = vf(dt, 0), a1 = vf(dt, 1);
        st.o[dt] = mfma16(__builtin_shufflevector(a0, a1, 0, 1, 2, 3, 4, 5, 6, 7), pb, st.o[dt]); }
}
DI void attn_finish(AttnState& st) {
    float l = st.l; l += __shfl_xor(l, 16); l += __shfl_xor(l, 32);
    const float inv = 1.0f / fmaxf(l, 1e-30f);
#pragma unroll
    for (int dt = 0; dt < 8; ++dt) st.o[dt] *= inv;
}
DI s16x4 lds_tr(const LAS bf16_t* p) { return __builtin_amdgcn_ds_read_tr16_b64_v4i16((LAS s16x4*)p); }
constexpr int KVP = 136;

constexpr int NSA_KS = 0, NSA_VS = 2 * 64 * KVP * 2, NSA_PSUM = 2 * NSA_VS, NSA_BIAS = NSA_PSUM + 32 * 256 * 4, NSA_WN = NSA_BIAS + 2304;
template <class NEED, class HALFOK, class MB>
DI void nsa_run_blocks(LAS unsigned char* lds, unsigned long long blockmask, const bf16_t* kbase, const bf16_t* vbase, AttnState& st, const bf16x8 (&qf)[4], int tid, NEED need, HALFOK halfok, MB mb) {
    const int lane = tid & 63, li = lane & 15, quad = lane >> 4;
    LAS bf16_t* Ks = (LAS bf16_t*)(lds + NSA_KS); LAS bf16_t* Vs = (LAS bf16_t*)(lds + NSA_VS);
    u32x4 kr[2], vr[2];
    const int r0 = tid >> 4, ch = tid & 15;
    int buf = 0;
    if (blockmask) { const int j = __builtin_ctzll(blockmask);
#pragma unroll
        for (int i = 0; i < 2; ++i) { const size_t ro = (size_t)(j * 64 + r0 + i * 32) * ZLD + ch * 8; kr[i] = *(const u32x4*)(kbase + ro); vr[i] = *(const u32x4*)(vbase + ro); } }
    while (blockmask) {
        const int j = __builtin_ctzll(blockmask); blockmask &= blockmask - 1;
#pragma unroll
        for (int i = 0; i < 2; ++i) { *(LAS u32x4*)(Ks + (buf * 64 + r0 + i * 32) * KVP + ch * 8) = kr[i]; *(LAS u32x4*)(Vs + (buf * 64 + r0 + i * 32) * KVP + ch * 8) = vr[i]; }
        __syncthreads();
        if (blockmask) { const int jn = __builtin_ctzll(blockmask);
#pragma unroll
            for (int i = 0; i < 2; ++i) { const size_t ro = (size_t)(jn * 64 + r0 + i * 32) * ZLD + ch * 8; kr[i] = *(const u32x4*)(kbase + ro); vr[i] = *(const u32x4*)(vbase + ro); } }
        if (need(j)) {
#pragma unroll
            for (int half = 0; half < 2; ++half) {
                if (halfok(j, half)) {
                    const LAS bf16_t* kt = Ks + (buf * 64 + half * 32) * KVP; const LAS bf16_t* vt = Vs + (buf * 64 + half * 32) * KVP;
                    attn_tile32(st, qf,
                        [&](int sub, int kk) { return *(const LAS bf16x8*)(kt + (sub * 16 + li) * KVP + kk * 32 + quad * 8); },
                        [&](int dt, int sub) { return lds_tr(vt + (sub * 16 + quad * 4 + (li >> 2)) * KVP + dt * 16 + (li & 3) * 4); },
                        [&](int sub, int e, float raw) { return mb(j * 64 + half * 32 + sub * 16 + quad * 4 + e, j, raw); });
                }
            }
        }
        buf ^= 1;
    }
    __syncthreads();
}

DI void nsa_prompt_unit(ArgsP a, LAS unsigned char* lds, int l, int u) {
    const int tid = ltid(), w = tid >> 6, lane = tid & 63, li = lane & 15, quad = lane >> 4;
    const int b = u >> 8, kvh = (u >> 7) & 1, qt = u & 127, t0 = qt * 32;
    const int qi = li >> 2, g = li & 3, h = kvh * 4 + g;
    const int tq0 = t0 + 4 * w, t = tq0 + qi;
    const size_t row = (size_t)b * SEQ + t;
    const bf16_t* Z = (const bf16_t*)(a->ws + WS_Z);
    LAS float* biasL = (LAS float*)(lds + NSA_BIAS); LAS float* psum = (LAS float*)(lds + NSA_PSUM); LAS unsigned long long* wn = (LAS unsigned long long*)(lds + NSA_WN);
    { const float* bt = (const float*)(a->ws + WS_BIAS);
      for (int i = tid; i < 129 * 4; i += 512) biasL[i] = bt[(i >> 2) * 8 + kvh * 4 + (i & 3)]; }
    __syncthreads();
    bf16x8 qf[4];
#pragma unroll
    for (int kk = 0; kk < 4; ++kk) qf[kk] = ld8(Z + row * ZLD + ZQ + h * 128 + kk * 32 + quad * 8);
    const float* zg = (const float*)(a->ws + WS_ZS) + row * ZSLD + ZS_GATE;
    const float gate0 = sigmoidf_(zg[h]), gate1 = sigmoidf_(zg[8 + h]), gate2 = sigmoidf_(zg[16 + h]);
    f32x4 otot[8];
    {
        const int nvw = (tq0 + 3 >= 31) ? ((tq0 + 3 - 31) >> 4) + 1 : 0;
        const bf16_t* Kc = (const bf16_t*)(a->ws + WS_KCP) + (size_t)((b * 2 + kvh) * 256) * 128;
        const bf16_t* VcT = (const bf16_t*)(a->ws + WS_VCPT) + (size_t)((b * 2 + kvh) * 128) * 256;
        float sc[16][4];
        float mx = -INFINITY;
#pragma unroll
        for (int sub = 0; sub < 16; ++sub) {
            if (sub * 16 < nvw) {
                f32x4 s = {0.f, 0.f, 0.f, 0.f};
#pragma unroll
                for (int kk = 0; kk < 4; ++kk) s = mfma16(ld8(Kc + (size_t)(sub * 16 + li) * 128 + kk * 32 + quad * 8), qf[kk], s);
#pragma unroll
                for (int e = 0; e < 4; ++e) { const int rel = t - (16 * (sub * 16 + quad * 4 + e) + 31);
                    sc[sub][e] = rel >= 0 ? s[e] * QK_SCALE2 + biasL[(rel < 128 ? rel : 128) * 4 + g] : -INFINITY; mx = fmaxf(mx, sc[sub][e]); }
            } else {
#pragma unroll
                for (int e = 0; e < 4; ++e) sc[sub][e] = -INFINITY;
            }
        }
        mx = fmaxf(mx, __shfl_xor(mx, 16)); mx = fmaxf(mx, __shfl_xor(mx, 32));
        const float mu = (mx == -INFINITY) ? 0.f : mx;
        float ls = 0.f;
#pragma unroll
        for (int sub = 0; sub < 16; ++sub)
#pragma unroll
            for (int e = 0; e < 4; ++e) { sc[sub][e] = fexp2(sc[sub][e] - mu); ls += sc[sub][e]; }
        ls += __shfl_xor(ls, 16); ls += __shfl_xor(ls, 32);
        const float inv = 1.0f / fmaxf(ls, 1e-30f);
#pragma unroll
        for (int sub = 0; sub < 16; ++sub) {
            f32x4 hs;
#pragma unroll
            for (int e = 0; e < 4; ++e) { sc[sub][e] *= inv; float x = sc[sub][e]; x += dpp_xor1(x); x += dpp_xor2(x); hs[e] = x; }
            if (g == 0) *(LAS f32x4*)(psum + (w * 4 + qi) * 256 + sub * 16 + quad * 4) = hs;
        }
        f32x4 oc[8];
#pragma unroll
        for (int dt = 0; dt < 8; ++dt) oc[dt] = (f32x4){0.f, 0.f, 0.f, 0.f};
#pragma unroll
        for (int tp = 0; tp < 8; ++tp) {
            if (tp * 32 < nvw) {
                const bf16x8 pb = pack8(sc[2 * tp][0], sc[2 * tp][1], sc[2 * tp][2], sc[2 * tp][3], sc[2 * tp + 1][0], sc[2 * tp + 1][1], sc[2 * tp + 1][2], sc[2 * tp + 1][3]);
#pragma unroll
                for (int dt = 0; dt < 8; ++dt) { const bf16_t* vp = VcT + (size_t)(dt * 16 + li) * 256 + tp * 32 + quad * 4;
                    const s16x4 a0 = *(const s16x4*)vp, a1 = *(const s16x4*)(vp + 16);
                    oc[dt] = mfma16(__builtin_shufflevector(a0, a1, 0, 1, 2, 3, 4, 5, 6, 7), pb, oc[dt]); }
            }
        }
#pragma unroll
        for (int dt = 0; dt < 8; ++dt) otot[dt] = oc[dt] * gate0;
    }
    unsigned long long mymask = 0ull, need = 0ull;
#pragma unroll
    for (int qq = 0; qq < 4; ++qq) {
        const int tq = tq0 + qq, cur = tq >> 6, j = lane;
        const LAS float* ps = psum + (w * 4 + qq) * 256;
        const f32x4 v4 = *(const LAS f32x4*)(ps + 4 * j);
        const float pm1 = j > 0 ? ps[4 * j - 1] : 0.f;
        const float imp = pm1 + 2.0f * (v4[0] + v4[1] + v4[2]) + v4[3];
        const bool vis = j <= cur, forced = (j == 0) || (j == cur) || (j == cur - 1);
        const float val = vis ? (forced ? 1e6f : imp) : -INFINITY;
        int rank = 0;
        for (int jj = 0; jj < 64; ++jj) { const float vj = __builtin_bit_cast(float, __builtin_amdgcn_readlane(__builtin_bit_cast(int, val), jj)); rank += (vj > val || (vj == val && jj < j)) ? 1 : 0; }
        const unsigned long long mk = __ballot(vis && rank < 16);
        need |= mk; if (qi == qq) mymask = mk;
    }
    if (lane == 0) wn[w] = need;
    __syncthreads();
    unsigned long long bm = 0ull;
#pragma unroll
    for (int i = 0; i < 8; ++i) bm |= wn[i];
    {
        AttnState st; attn_init(st);
        const bf16_t* kb = Z + (size_t)b * SEQ * ZLD + ZKV + 2 * 256 + kvh * 128;
        nsa_run_blocks(lds, bm, kb, kb + 256, st, qf, tid,
            [&](int j) { return ((need >> j) & 1ull) != 0ull; },
            [&](int j, int half) { return j * 64 + half * 32 <= tq0 + 3; },
            [&](int kp, int j, float raw) { const int rel = t - kp; return (((mymask >> j) & 1ull) && rel >= 0) ? raw * QK_SCALE2 + biasL[(rel < 128 ? rel : 128) * 4 + g] : -INFINITY; });
        attn_finish(st);
#pragma unroll
        for (int dt = 0; dt < 8; ++dt) otot[dt] += st.o[dt] * gate1;
    }
    {
        AttnState st; attn_init(st);
        const int jlo = (t0 >= 512 ? t0 - 512 : 0) >> 6, jhi = (t0 + 31) >> 6;
        const unsigned long long wm = (jhi >= 63 ? ~0ull : ((1ull << (jhi + 1)) - 1ull)) & ~((1ull << jlo) - 1ull);
        const bf16_t* kb = Z + (size_t)b * SEQ * ZLD + ZKV + 4 * 256 + kvh * 128;
        nsa_run_blocks(lds, wm, kb, kb + 256, st, qf, tid,
            [&](int j) { return j * 64 + 63 >= tq0 - 512 && j * 64 <= tq0 + 3; },
            [&](int j, int half) { const int k0 = j * 64 + half * 32; return k0 + 31 >= tq0 - 512 && k0 <= tq0 + 3; },
            [&](int kp, int j, float raw) { const int rel = t - kp; return (rel >= 0 && rel <= 512) ? raw * QK_SCALE2 + biasL[(rel < 128 ? rel : 128) * 4 + g] : -INFINITY; });
        attn_finish(st);
#pragma unroll
        for (int dt = 0; dt < 8; ++dt) otot[dt] += st.o[dt] * gate2;
    }
    { bf16_t* mx = (bf16_t*)(a->ws + WS_MIXED) + row * DM + h * 128; const bf16_t* sg = Z + row * ZLD + ZAS + h * 128;
#pragma unroll
      for (int dt = 0; dt < 8; ++dt) { const int d = dt * 16 + quad * 4; const u32x2 sw = *(const u32x2*)(sg + d);
          u32x2 o; o.x = pk2(otot[dt][0] * siluf_(lo2f(sw.x)), otot[dt][1] * siluf_(hi2f(sw.x))); o.y = pk2(otot[dt][2] * siluf_(lo2f(sw.y)), otot[dt][3] * siluf_(hi2f(sw.y)));
          *(u32x2*)(mx + d) = o; } }
    __syncthreads();
}

DI unsigned fkey(float f) { const unsigned u = __float_as_uint(f); return (u & 0x80000000u) ? ~u : (u | 0x80000000u); }
DI void wave_topk256(const LAS float* sc, int n, LAS unsigned* hist, LAS int* idx, int lane) {
    unsigned prefix = 0u; int kth = 256;
#pragma unroll 1
    for (int pass = 3; pass >= 0; --pass) {
        const int shift = pass * 8;
        *(LAS u32x4*)(hist + lane * 4) = (u32x4){0u, 0u, 0u, 0u};
        for (int i = lane; i < n; i += 64) { const unsigned u = fkey(sc[i]);
            if (pass == 3 || (u >> (shift + 8)) == prefix) (void)__hip_atomic_fetch_add(hist + ((u >> shift) & 255u), 1u, __ATOMIC_RELAXED, __HIP_MEMORY_SCOPE_WORKGROUP); }
        const u32x4 c = *(const LAS u32x4*)(hist + lane * 4);
        const int tot = (int)(c.x + c.y + c.z + c.w);
        int incl = tot;
#pragma unroll
        for (int o = 1; o < 64; o <<= 1) { const int t2 = __shfl_down(incl, o); if (lane + o < 64) incl += t2; }
        const int a3 = incl - tot, a2 = a3 + (int)c.w, a1 = a2 + (int)c.z, a0 = a1 + (int)c.y;
        int which = -1, ab = 0;
        if (a3 < kth && kth <= a3 + (int)c.w) { which = 3; ab = a3; }
        else if (a2 < kth && kth <= a2 + (int)c.z) { which = 2; ab = a2; }
        else if (a1 < kth && kth <= a1 + (int)c.y) { which = 1; ab = a1; }
        else if (a0 < kth && kth <= a0 + (int)c.x) { which = 0; ab = a0; }
        const unsigned long long hb = __ballot(which >= 0);
        const int src = hb ? __builtin_ctzll(hb) : 0;
        const int dg = __shfl(lane * 4 + which, src), nk = __shfl(kth - ab, src);
        prefix = (prefix << 8) | (unsigned)dg; kth = nk;
    }
    int cnt = 0, ce = 0;
    for (int base = 0; base < n; base += 64) {
        const int i = base + lane; const bool valid = i < n;
        const unsigned u = valid ? fkey(sc[i]) : 0u;
        const bool gt = valid && u > prefix, eq = valid && u == prefix;
        const unsigned long long eqb = __ballot(eq);
        const int eqrank = ce + __builtin_popcountll(eqb & ((1ull << lane) - 1ull));
        const bool take = gt || (eq && eqrank < kth);
        const unsigned long long tb = __ballot(take);
        if (take) idx[cnt + __builtin_popcountll(tb & ((1ull << lane) - 1ull))] = i;
        cnt += __builtin_popcountll(tb); ce += __builtin_popcountll(eqb);
    }
}

constexpr int DSA_SC = 0, DSA_IDX = 8 * 4096 * 4, DSA_HIST = DSA_IDX + 8 * 256 * 4, DSA_BIAS = DSA_HIST + 8 * 256 * 4;
DI void dsa_prompt_unit(ArgsP a, LAS unsigned char* lds, int l, int u) {
    const int tid = ltid(), w = tid >> 6, lane = tid & 63, li = lane & 15, quad = lane >> 4;
    const int b = u & 1, q8 = u >> 1, t0 = q8 * 8;
    const bf16_t* Z = (const bf16_t*)(a->ws + WS_Z); const float* Zs = (const float*)(a->ws + WS_ZS);
    LAS float* scores = (LAS float*)(lds + DSA_SC); LAS float* biasC = (LAS float*)(lds + DSA_BIAS);
    { const float* bt = (const float*)(a->ws + WS_BIAS) + 129 * 8;
      for (int i = tid; i < 129 * 4; i += 512) biasC[i] = bt[i]; }
    {
        const int qi = li >> 2, ih = li & 3;
        bf16x8 qfi[2][2]; float wi[2];
#pragma unroll
        for (int ct = 0; ct < 2; ++ct) { const size_t row = (size_t)b * SEQ + t0 + ct * 4 + qi;
#pragma unroll
            for (int kk = 0; kk < 2; ++kk) qfi[ct][kk] = ld8(Z + row * ZLD + ZIQ + ih * 64 + kk * 32 + quad * 8);
            wi[ct] = Zs[row * ZSLD + ZS_IW + ih]; }
        const bf16_t* kx = (const bf16_t*)(a->ws + WS_KIDXB) + (size_t)b * SEQ * 64;
        const int nsub = ((t0 + 7) >> 4) + 1;
        for (int sub = w; sub < nsub; sub += 8) {
            const bf16x8 k0 = ld8(kx + (size_t)(sub * 16 + li) * 64 + quad * 8), k1 = ld8(kx + (size_t)(sub * 16 + li) * 64 + 32 + quad * 8);
#pragma unroll
            for (int ct = 0; ct < 2; ++ct) {
                f32x4 s = {0.f, 0.f, 0.f, 0.f};
                s = mfma16(k0, qfi[ct][0], s); s = mfma16(k1, qfi[ct][1], s);
                const int tq = t0 + ct * 4 + qi;
                f32x4 o;
#pragma unroll
                for (int e = 0; e < 4; ++e) { float x = fmaxf(s[e], 0.f) * wi[ct]; x += dpp_xor1(x); x += dpp_xor2(x); if (x == 0.f) x = 0.f;
                    o[e] = (sub * 16 + quad * 4 + e <= tq) ? x : -INFINITY; }
                if (ih == 0) *(LAS f32x4*)(scores + (ct * 4 + qi) * 4096 + sub * 16 + quad * 4) = o;
            }
        }
    }
    __syncthreads();
    const int t = t0 + w, n = t + 1;
    const size_t row = (size_t)b * SEQ + t;
    LAS int* idx = (LAS int*)(lds + DSA_IDX) + w * 256;
    int cnt;
    if (n <= 256) { for (int i = lane; i < 256; i += 64) idx[i] = i < n ? i : 0; cnt = n; }
    else { wave_topk256(scores + w * 4096, n, (LAS unsigned*)(lds + DSA_HIST) + w * 256, idx, lane); cnt = 256; }
    {
        const int head = li & 3;
        bf16x8 qf[4];
#pragma unroll
        for (int kk = 0; kk < 4; ++kk) qf[kk] = ld8(Z + row * ZLD + ZCQ + head * 128 + kk * 32 + quad * 8);
        LAS bf16_t* vst = (LAS bf16_t*)(lds + DSA_SC + w * 16384);
        const bf16_t* kvb = Z + (size_t)b * SEQ * ZLD + ZCKV;
        AttnState st; attn_init(st);
        const int ntile = (cnt + 31) >> 5;
#pragma unroll 1
        for (int tp = 0; tp < ntile; ++tp) {
            const LAS int* ix = idx + tp * 32;
#pragma unroll
            for (int i = 0; i < 8; ++i) { const int rr = i * 4 + quad; *(LAS u32x4*)(vst + rr * KVP + li * 8) = *(const u32x4*)(kvb + (size_t)ix[rr] * ZLD + 128 + li * 8); }
            const bf16_t* kr0 = kvb + (size_t)ix[li] * ZLD + quad * 8; const bf16_t* kr1 = kvb + (size_t)ix[16 + li] * ZLD + quad * 8;
            const u32x4 ip0 = *(const LAS u32x4*)(ix + quad * 4), ip1 = *(const LAS u32x4*)(ix + 16 + quad * 4);
            attn_tile32(st, qf,
                [&](int sub, int kk) { return ld8((sub ? kr1 : kr0) + kk * 32); },
                [&](int dt, int sub) { return lds_tr(vst + (sub * 16 + quad * 4 + (li >> 2)) * KVP + dt * 16 + (li & 3) * 4); },
                [&](int sub, int e, float raw) { const int pos = tp * 32 + sub * 16 + quad * 4 + e; const int kp = (int)(sub ? ip1[e] : ip0[e]); const int rel = t - kp;
                    return pos < cnt ? raw * QK_SCALE2 + biasC[(rel < 128 ? rel : 128) * 4 + head] : -INFINITY; });
        }
        attn_finish(st);
        if (li < 4) { bf16_t* mx = (bf16_t*)(a->ws + WS_MIXED) + row * DM + 1536 + head * 128; const bf16_t* sg = Z + row * ZLD + ZCS + head * 128;
#pragma unroll
            for (int dt = 0; dt < 8; ++dt) { const int d = dt * 16 + quad * 4; const u32x2 sw = *(const u32x2*)(sg + d);
                u32x2 o; o.x = pk2(st.o[dt][0] * siluf_(lo2f(sw.x)), st.o[dt][1] * siluf_(hi2f(sw.x))); o.y = pk2(st.o[dt][2] * siluf_(lo2f(sw.y)), st.o[dt][3] * siluf_(hi2f(sw.y)));
                *(u32x2*)(mx + d) = o; } }
    }
    __syncthreads();
}

struct RowSrc { const float* f; const bf16_t* h; };
DI bf16x8 row8(const RowSrc r, int off) {
    if (r.f) return cvt8(r.f + off);
    if (r.h) return ld8(r.h + off);
    return (bf16x8){0, 0, 0, 0, 0, 0, 0, 0};
}
template <class RS> DI void stage_v32(LAS bf16_t* vst, RS rs, int li, int quad) {
#pragma unroll
    for (int i = 0; i < 8; ++i) { const int rr = i * 4 + quad; *(LAS bf16x8*)(vst + rr * KVP + li * 8) = row8(rs(rr), li * 8); }
}
DI float merge_part(const LAS float* ml, const LAS float* opart, int w0, int nw, int ncol, int col, int d) {
    float M = -INFINITY;
    for (int w = w0; w < w0 + nw; ++w) M = fmaxf(M, ml[(w * 16 + col) * 2]);
    if (M == -INFINITY) return 0.f;
    float L = 0.f, o = 0.f;
    for (int w = w0; w < w0 + nw; ++w) { const float f = fexp2(ml[(w * 16 + col) * 2] - M); L += ml[(w * 16 + col) * 2 + 1] * f; o += opart[(size_t)(w * ncol + col) * 128 + d] * f; }
    return o / fmaxf(L, 1e-30f);
}
DI void put_part(const AttnState& st, LAS float* ml, LAS float* opart, int w, int ncol, int li, int quad) {
    float l = st.l; l += __shfl_xor(l, 16); l += __shfl_xor(l, 32);
    if (li < ncol) { if (quad == 0) { ml[(w * 16 + li) * 2] = st.m; ml[(w * 16 + li) * 2 + 1] = l; }
#pragma unroll
        for (int dt = 0; dt < 8; ++dt) *(LAS f32x4*)(opart + (size_t)(w * ncol + li) * 128 + dt * 16 + quad * 4) = st.o[dt]; }
}

constexpr int SN_BIAS = 0, SN_ML = 2304, SN_PSUM = 4096, SN_PLD = 1040, SN_ST = 24576, SN_SEL = SN_ST + 8 * 32 * KVP * 2;
DI void nsa_sample_unit(ArgsP a, LAS unsigned char* lds, int l, int u) {
    const int tid = ltid(), w = tid >> 6, lane = tid & 63, li = lane & 15, quad = lane >> 4;
    const int b = u >> 1, kvh = u & 1;
    const bf16_t* Z = (const bf16_t*)(a->ws + WS_Z); const float* Zs = (const float*)(a->ws + WS_ZS);
    LAS float* biasL = (LAS float*)(lds + SN_BIAS); LAS float* ml = (LAS float*)(lds + SN_ML); LAS float* psum = (LAS float*)(lds + SN_PSUM);
    LAS float* opart = (LAS float*)(lds + SN_ST); LAS bf16_t* vst = (LAS bf16_t*)(lds + SN_ST) + w * 32 * KVP; LAS int* sel = (LAS int*)(lds + SN_SEL);
    { const float* bt = (const float*)(a->ws + WS_BIAS);
      for (int i = tid; i < 129 * 4; i += 512) biasL[i] = bt[(i >> 2) * 8 + kvh * 4 + (i & 3)];
      for (int i = tid; i < 4 * SN_PLD; i += 512) psum[i] = 0.f; }
    __syncthreads();
    const int tt = li >> 2, g = li & 3, h = kvh * 4 + g, t = PAST + tt;
    const size_t row = (size_t)NTP + b * DS + tt;
    const int fc = tid >> 5, fd = (tid & 31) * 4;
    f32x4 fin = {0.f, 0.f, 0.f, 0.f};
    const float* fzg = Zs + ((size_t)NTP + b * DS + (fc >> 2)) * ZSLD + ZS_GATE + kvh * 4 + (fc & 3);
    const float fg0 = sigmoidf_(fzg[0]), fg1 = sigmoidf_(fzg[8]), fg2 = sigmoidf_(fzg[16]);
    bf16x8 qf[4];
#pragma unroll
    for (int kk = 0; kk < 4; ++kk) qf[kk] = ld8(Z + row * ZLD + ZQ + h * 128 + kk * 32 + quad * 8);
    {
        const bf16_t* Kc = (const bf16_t*)(a->ws + WS_KCS) + (size_t)((l * 16 + b * 2 + kvh) * 1024) * 128;
        const bf16_t* VcT = (const bf16_t*)(a->ws + WS_VCST) + (size_t)((l * 16 + b * 2 + kvh) * 128) * 1024;
        float sc[8][4]; float mx = -INFINITY;
#pragma unroll
        for (int sub = 0; sub < 8; ++sub) {
            f32x4 s = {0.f, 0.f, 0.f, 0.f};
            const int n0 = w * 128 + sub * 16;
#pragma unroll
            for (int kk = 0; kk < 4; ++kk) s = mfma16(ld8(Kc + (size_t)(n0 + li) * 128 + kk * 32 + quad * 8), qf[kk], s);
#pragma unroll
            for (int e = 0; e < 4; ++e) { const int n = n0 + quad * 4 + e; const int rel = t - (16 * n + 31);
                sc[sub][e] = (n < NC_S) ? s[e] * QK_SCALE2 + biasL[(rel < 128 ? rel : 128) * 4 + g] : -INFINITY; mx = fmaxf(mx, sc[sub][e]); }
        }
        mx = fmaxf(mx, __shfl_xor(mx, 16)); mx = fmaxf(mx, __shfl_xor(mx, 32));
        if (quad == 0) ml[(w * 16 + li) * 2] = mx;
        __syncthreads();
        float M = -INFINITY;
#pragma unroll
        for (int ww = 0; ww < 8; ++ww) M = fmaxf(M, ml[(ww * 16 + li) * 2]);
        float ls = 0.f;
#pragma unroll
        for (int sub = 0; sub < 8; ++sub)
#pragma unroll
            for (int e = 0; e < 4; ++e) { sc[sub][e] = fexp2(sc[sub][e] - M); ls += sc[sub][e]; }
        ls += __shfl_xor(ls, 16); ls += __shfl_xor(ls, 32);
        if (quad == 0) ml[(w * 16 + li) * 2 + 1] = ls;
        __syncthreads();
        float L = 0.f;
#pragma unroll
        for (int ww = 0; ww < 8; ++ww) L += ml[(ww * 16 + li) * 2 + 1];
        const float inv = 1.0f / fmaxf(L, 1e-30f);
#pragma unroll
        for (int sub = 0; sub < 8; ++sub) { f32x4 hs;
#pragma unroll
            for (int e = 0; e < 4; ++e) { sc[sub][e] *= inv; float x = sc[sub][e]; x += dpp_xor1(x); x += dpp_xor2(x); hs[e] = x; }
            if (g == 0) *(LAS f32x4*)(psum + tt * SN_PLD + w * 128 + sub * 16 + quad * 4) = hs; }
        f32x4 oc[8];
#pragma unroll
        for (int dt = 0; dt < 8; ++dt) oc[dt] = (f32x4){0.f, 0.f, 0.f, 0.f};
#pragma unroll
        for (int tp = 0; tp < 4; ++tp) {
            const bf16x8 pb = pack8(sc[2 * tp][0], sc[2 * tp][1], sc[2 * tp][2], sc[2 * tp][3], sc[2 * tp + 1][0], sc[2 * tp + 1][1], sc[2 * tp + 1][2], sc[2 * tp + 1][3]);
#pragma unroll
            for (int dt = 0; dt < 8; ++dt) { const bf16_t* vp = VcT + (size_t)(dt * 16 + li) * 1024 + w * 128 + tp * 32 + quad * 4;
                const s16x4 a0 = *(const s16x4*)vp, a1 = *(const s16x4*)(vp + 16);
                oc[dt] = mfma16(__builtin_shufflevector(a0, a1, 0, 1, 2, 3, 4, 5, 6, 7), pb, oc[dt]); }
        }
#pragma unroll
        for (int dt = 0; dt < 8; ++dt) *(LAS f32x4*)(opart + (size_t)(w * 16 + li) * 128 + dt * 16 + quad * 4) = oc[dt];
        __syncthreads();
#pragma unroll
        for (int ww = 0; ww < 8; ++ww) fin += *(const LAS f32x4*)(opart + (size_t)(ww * 16 + fc) * 128 + fd) * fg0;
    }
    if (w < 4) {
        const LAS float* ps = psum + w * SN_PLD;
        float val[4];
#pragma unroll
        for (int k = 0; k < 4; ++k) { const int j = lane + 64 * k;
            const f32x4 v4 = *(const LAS f32x4*)(ps + 4 * j); const float pm1 = j > 0 ? ps[4 * j - 1] : 0.f;
            val[k] = (j == 0 || j == 255) ? -INFINITY : pm1 + 2.0f * (v4[0] + v4[1] + v4[2]) + v4[3]; }
        if (lane == 0) { sel[w * 16 + 0] = 0; sel[w * 16 + 1] = 255; sel[w * 16 + 2] = 256; }
#pragma unroll 1
        for (int it = 0; it < 13; ++it) {
            float bv = val[0]; int bj = lane;
#pragma unroll
            for (int k = 1; k < 4; ++k) if (val[k] > bv) { bv = val[k]; bj = lane + 64 * k; }
#pragma unroll
            for (int o = 1; o < 64; o <<= 1) { const float ov = __shfl_xor(bv, o); const int oj = __shfl_xor(bj, o); if (ov > bv || (ov == bv && oj < bj)) { bv = ov; bj = oj; } }
            if (lane == 0) sel[w * 16 + 3 + it] = bj;
#pragma unroll
            for (int k = 0; k < 4; ++k) if (bj == lane + 64 * k) val[k] = -INFINITY;
        }
    }
    __syncthreads();
    {
        const int tq = w >> 1, tpos = PAST + tq;
        const size_t rq = (size_t)NTP + b * DS + tq;
        bf16x8 q2[4];
#pragma unroll
        for (int kk = 0; kk < 4; ++kk) q2[kk] = ld8(Z + rq * ZLD + ZQ + h * 128 + kk * 32 + quad * 8);
        AttnState st; attn_init(st);
        const float* ca = a->in[I_CA];
#pragma unroll 1
        for (int bi = 0; bi < 8; ++bi) {
            const int j = sel[tq * 16 + (w & 1) * 8 + bi];
            const int ntile = (j == 256) ? 1 : 2;
            const size_t pbase = (j < 256) ? ((size_t)(l * NPOOL + a->page_table[b * NPAGES + (j >> 1)]) * PAGE + (j & 1) * 64) * 1024 : 0;
#pragma unroll 1
            for (int tl = 0; tl < ntile; ++tl) {
                auto src = [&](int i, int which) { RowSrc r; r.f = nullptr; r.h = nullptr; const int ii = tl * 32 + i;
                    if (j < 256) r.f = ca + pbase + (size_t)ii * 1024 + which * 256 + kvh * 128;
                    else if (ii < DS) r.h = Z + ((size_t)NTP + b * DS + ii) * ZLD + ZKV + which * 256 + kvh * 128;
                    return r; };
                stage_v32(vst, [&](int i) { return src(i, 3); }, li, quad);
                const RowSrc k0 = src(li, 2), k1 = src(16 + li, 2);
                attn_tile32(st, q2,
                    [&](int sub, int kk) { return row8(sub ? k1 : k0, kk * 32 + quad * 8); },
                    [&](int dt, int sub) { return lds_tr(vst + (sub * 16 + quad * 4 + (li >> 2)) * KVP + dt * 16 + (li & 3) * 4); },
                    [&](int sub, int e, float raw) { const int rel = tpos - (j * 64 + tl * 32 + sub * 16 + quad * 4 + e);
                        return rel >= 0 ? raw * QK_SCALE2 + biasL[(rel < 128 ? rel : 128) * 4 + g] : -INFINITY; });
            }
        }
        __syncthreads();
        put_part(st, ml, opart, w, 4, li, quad);
        __syncthreads();
        { const int ftq = fc >> 2, fgc = fc & 3;
#pragma unroll
          for (int e = 0; e < 4; ++e) fin[e] += fg1 * merge_part(ml, opart, 2 * ftq, 2, 4, fgc, fd + e); }
        __syncthreads();
    }
    {
        AttnState st; attn_init(st);
        const float* sw = a->in[I_SW] + (size_t)((l * DB + b) * 512) * 512;
#pragma unroll 1
        for (int tl = w; tl < 17; tl += 8) {
            auto src = [&](int i, int which) { RowSrc r; r.f = nullptr; r.h = nullptr; const int ii = tl * 32 + i;
                if (ii < 512) r.f = sw + (size_t)ii * 512 + which * 256 + kvh * 128;
                else if (ii < 512 + DS) r.h = Z + ((size_t)NTP + b * DS + ii - 512) * ZLD + ZKV + (4 + which) * 256 + kvh * 128;
                return r; };
            stage_v32(vst, [&](int i) { return src(i, 1); }, li, quad);
            const RowSrc k0 = src(li, 0), k1 = src(16 + li, 0);
            attn_tile32(st, qf,
                [&](int sub, int kk) { return row8(sub ? k1 : k0, kk * 32 + quad * 8); },
                [&](int dt, int sub) { return lds_tr(vst + (sub * 16 + quad * 4 + (li >> 2)) * KVP + dt * 16 + (li & 3) * 4); },
                [&](int sub, int e, float raw) { const int rel = 512 + tt - (tl * 32 + sub * 16 + quad * 4 + e);
                    return (rel >= 0 && rel <= 512) ? raw * QK_SCALE2 + biasL[(rel < 128 ? rel : 128) * 4 + g] : -INFINITY; });
        }
        __syncthreads();
        put_part(st, ml, opart, w, 16, li, quad);
        __syncthreads();
#pragma unroll
        for (int e = 0; e < 4; ++e) fin[e] += fg2 * merge_part(ml, opart, 0, 8, 16, fc, fd + e);
    }
    { const size_t frow = (size_t)NTP + b * DS + (fc >> 2); const int fh = kvh * 4 + (fc & 3);
      const u32x2 sw2 = *(const u32x2*)(Z + frow * ZLD + ZAS + fh * 128 + fd);
      u32x2 o; o.x = pk2(fin[0] * siluf_(lo2f(sw2.x)), fin[1] * siluf_(hi2f(sw2.x))); o.y = pk2(fin[2] * siluf_(lo2f(sw2.y)), fin[3] * siluf_(hi2f(sw2.y)));
      *(u32x2*)((bf16_t*)(a->ws + WS_MIXED) + frow * DM + fh * 128 + fd) = o; }
    __syncthreads();
}

constexpr int SD_SC = 0, SD_HIST = 65792, SD_IDX = SD_HIST + 1024, SD_BIAS = SD_IDX + 1024, SD_CTL = SD_BIAS + 2304, SD_ML = SD_CTL + 256, SD_ST = 71680, SD_OP = SD_ST + 8 * 32 * KVP * 2;
DI void dsa_sample_unit(ArgsP a, LAS unsigned char* lds, int l, int q) {
    const int tid = ltid(), w = tid >> 6, lane = tid & 63, li = lane & 15, quad = lane >> 4;
    const int b = q >> 2, tt = q & 3, t = PAST + tt, n = t + 1;
    const bf16_t* Z = (const bf16_t*)(a->ws + WS_Z);
    LAS float* sc = (LAS float*)(lds + SD_SC); LAS unsigned* hist = (LAS unsigned*)(lds + SD_HIST); LAS int* idx = (LAS int*)(lds + SD_IDX);
    LAS float* biasC = (LAS float*)(lds + SD_BIAS); LAS int* ctl = (LAS int*)(lds + SD_CTL); LAS float* ml = (LAS float*)(lds + SD_ML);
    LAS bf16_t* vst = (LAS bf16_t*)(lds + SD_ST) + w * 32 * KVP; LAS float* opart = (LAS float*)(lds + SD_OP);
    { const float* bt = (const float*)(a->ws + WS_BIAS) + 129 * 8;
      for (int i = tid; i < 129 * 4; i += 512) biasC[i] = bt[i];
      const float* gs = (const float*)(a->ws + WS_SCORES) + (size_t)q * SCORE_LD;
      for (int i = tid; i < n; i += 512) sc[i] = gs[i]; }
    unsigned prefix = 0u; int kth = 256;
#pragma unroll 1
    for (int pass = 3; pass >= 0; --pass) {
        const int shift = pass * 8;
        if (tid < 256) hist[tid] = 0u;
        __syncthreads();
        for (int i = tid; i < n; i += 512) { const unsigned uu = fkey(sc[i]);
            if (pass == 3 || (uu >> (shift + 8)) == prefix) (void)__hip_atomic_fetch_add(hist + ((uu >> shift) & 255u), 1u, __ATOMIC_RELAXED, __HIP_MEMORY_SCOPE_WORKGROUP); }
        __syncthreads();
        if (w == 0) {
            const u32x4 c = *(const LAS u32x4*)(hist + lane * 4);
            const int tot = (int)(c.x + c.y + c.z + c.w);
            int incl = tot;
#pragma unroll
            for (int o = 1; o < 64; o <<= 1) { const int t2 = __shfl_down(incl, o); if (lane + o < 64) incl += t2; }
            const int a3 = incl - tot, a2 = a3 + (int)c.w, a1 = a2 + (int)c.z, a0 = a1 + (int)c.y;
            int which = -1, ab = 0;
            if (a3 < kth && kth <= a3 + (int)c.w) { which = 3; ab = a3; }
            else if (a2 < kth && kth <= a2 + (int)c.z) { which = 2; ab = a2; }
            else if (a1 < kth && kth <= a1 + (int)c.y) { which = 1; ab = a1; }
            else if (a0 < kth && kth <= a0 + (int)c.x) { which = 0; ab = a0; }
            if (which >= 0) { ctl[0] = lane * 4 + which; ctl[1] = kth - ab; }
        }
        __syncthreads();
        prefix = (prefix << 8) | (unsigned)ctl[0]; kth = ctl[1];
    }
    {
        const int chunk = (((n + 7) >> 3) + 63) & ~63, lo = w * chunk, hi = (lo + chunk < n) ? lo + chunk : n;
        int cg = 0, ce = 0;
        for (int base = lo; base < hi; base += 64) { const int i = base + lane; const bool valid = i < hi; const unsigned uu = valid ? fkey(sc[i]) : 0u;
            cg += __builtin_popcountll(__ballot(valid && uu > prefix)); ce += __builtin_popcountll(__ballot(valid && uu == prefix)); }
        if (lane == 0) { ctl[8 + w * 2] = cg; ctl[9 + w * 2] = ce; }
        __syncthreads();
        int ebase = 0, tbase = 0;
        for (int ww = 0; ww < w; ++ww) { const int eg = ctl[8 + ww * 2], ee = ctl[9 + ww * 2]; const int room = kth - ebase; tbase += eg + (ee < room ? ee : (room > 0 ? room : 0)); ebase += ee; }
        int cnt = tbase, cee = ebase;
        for (int base = lo; base < hi; base += 64) {
            const int i = base + lane; const bool valid = i < hi; const unsigned uu = valid ? fkey(sc[i]) : 0u;
            const bool gt = valid && uu > prefix, eq = valid && uu == prefix;
            const unsigned long long eqb = __ballot(eq);
            const int eqrank = cee + __builtin_popcountll(eqb & ((1ull << lane) - 1ull));
            const bool take = gt || (eq && eqrank < kth);
            const unsigned long long tb = __ballot(take);
            if (take) idx[cnt + __builtin_popcountll(tb & ((1ull << lane) - 1ull))] = i;
            cnt += __builtin_popcountll(tb); cee += __builtin_popcountll(eqb);
        }
    }
    __syncthreads();
    {
        const int head = li & 3;
        const size_t row = (size_t)NTP + q;
        bf16x8 qf[4];
#pragma unroll
        for (int kk = 0; kk < 4; ++kk) qf[kk] = ld8(Z + row * ZLD + ZCQ + head * 128 + kk * 32 + quad * 8);
        const float* cc = a->in[I_CC];
        const LAS int* ix = idx + w * 32;
        auto src = [&](int i, int which) { RowSrc r; r.f = nullptr; r.h = nullptr; const int s = ix[i];
            if (s < PAST) r.f = cc + ((size_t)(l * NPOOL + a->page_table[b * NPAGES + (s >> 7)]) * PAGE + (s & 127)) * 256 + which * 128;
            else r.h = Z + ((size_t)NTP + b * DS + (s - PAST)) * ZLD + ZCKV + which * 128;
            return r; };
        AttnState st; attn_init(st);
        stage_v32(vst, [&](int i) { return src(i, 1); }, li, quad);
        const RowSrc k0 = src(li, 0), k1 = src(16 + li, 0);
        const u32x4 ip0 = *(const LAS u32x4*)(ix + quad * 4), ip1 = *(const LAS u32x4*)(ix + 16 + quad * 4);
        attn_tile32(st, qf,
            [&](int sub, int kk) { return row8(sub ? k1 : k0, kk * 32 + quad * 8); },
            [&](int dt, int sub) { return lds_tr(vst + (sub * 16 + quad * 4 + (li >> 2)) * KVP + dt * 16 + (li & 3) * 4); },
            [&](int sub, int e, float raw) { const int rel = t - (int)(sub ? ip1[e] : ip0[e]); return raw * QK_SCALE2 + biasC[(rel < 128 ? rel : 128) * 4 + head]; });
        put_part(st, ml, opart, w, 4, li, quad);
        __syncthreads();
        { const int fh = tid >> 7, fd = tid & 127;
          const float o = merge_part(ml, opart, 0, 8, 4, fh, fd);
          ((bf16_t*)(a->ws + WS_MIXED))[row * DM + 1536 + fh * 128 + fd] = f2bf(o * siluf_(bf2f(Z[row * ZLD + ZCS + fh * 128 + fd]))); }
    }
    __syncthreads();
}

constexpr int L4_SN = 16, L4_SD = 32, L4_NSA = 512, L4_DSA = 1024, L4_TOTAL = L4_SN + L4_SD + L4_NSA + L4_DSA;
DI void l4_phase(ArgsP a, LAS unsigned char* lds, int l) {
    unsigned* qhead = (unsigned*)(a->ws + WS_CTL) + 4096 + 64 * l;
    LAS int* tk = (LAS int*)(lds + LDS_TICKET_OFF);
    for (;;) {
        if (threadIdx.x == 0) *tk = (int)__hip_atomic_fetch_add(qhead, 1u, __ATOMIC_RELAXED, __HIP_MEMORY_SCOPE_AGENT);
        __syncthreads();
        const int u = *tk;
        __syncthreads();
        if (u >= L4_TOTAL) break;
        if (u < L4_SN) nsa_sample_unit(a, lds, l, u);
        else if (u < L4_SN + L4_SD) dsa_sample_unit(a, lds, l, u - L4_SN);
        else if (u < L4_SN + L4_SD + L4_NSA) { const int m = u - L4_SN - L4_SD; nsa_prompt_unit(a, lds, l, ((m & 3) << 7) | (127 - (m >> 2))); }
        else { const int m = u - L4_SN - L4_SD - L4_NSA; dsa_prompt_unit(a, lds, l, ((511 - (m >> 1)) << 1) | (m & 1)); }
    }
}

constexpr int N_PHASES = 12;
#ifndef MK_LAUNCHES
#define MK_LAUNCHES 1
#endif

__global__ void __launch_bounds__(512, 2) fwd(Args a_) {
    extern __shared__ __attribute__((aligned(16))) unsigned char shm[];
    LAS unsigned char* lds = (LAS unsigned char*)shm;
    if (threadIdx.x == 0) *(LAS u32x4*)(lds + LDS_BAR_OFF) = (u32x4){0u, 0u, 0u, 0u};
    __syncthreads();
    unsigned* ctl = (unsigned*)(a_.ws + WS_CTL);
    XcdBarrier bar = xcd_barrier_post(ctl, (volatile LAS unsigned*)(lds + LDS_BAR_OFF));
    const int G = gridDim.x, bid = blockIdx.x;
#define IN(ph) ((ph) >= a_.ph_lo && (ph) < a_.ph_hi)
#define SEAM(ph) do { if (IN(ph) && IN((ph) + 1)) xcd_barrier(bar); } while (0)

    if (IN(0)) { ArgsP a = largs(); for (int u = bid; u < PJ_TOTAL; u += G) prologue_unit(a, lds, u); }
    SEAM(0);
    if (IN(1)) { ArgsP a = largs();
        pg8::Gemm g{(const bf16_t*)(a->ws + WS_ACMPS), (const bf16_t*)(a->ws + WS_W1T), 65536, 256, 4096, 2048, 4096};
        pg8::OrderCmpS S{G, bid};
        pg8::EpiHid E{(bf16_t*)(a->ws + WS_HIDS), (const float*)(a->ws + WS_CBIAS)};
        pg8::gemm_phase<pg8::EpiHid, pg8::OrderCmpS, false>(lds, g, S, E, nullptr);
    }
    SEAM(1);
#pragma unroll 1
    for (int l = 0; l < NL; ++l) {
        const int p0 = 2 + 5 * l;
        if (IN(p0)) { ArgsP a = largs();
            if (l == 0) { for (int u = bid; u < 512; u += G) cmp2_sample_unit(a, u); }
            l1_rows(a, l);
        }
        SEAM(p0);
        if (IN(p0 + 1)) { ArgsP a = largs();
            pg8::Gemm g{(const bf16_t*)(a->ws + WS_H), (const bf16_t*)(a->ws + WS_WINT) + (size_t)l * WIN_ROWS * DM, NTP, ZLD, DM, DM, DM};
            pg8::StaticOrder S; S.init(NTP, ZLD, G, bid);
            pg8::EpiZ E{(bf16_t*)(a->ws + WS_Z), ZLD};
            pg8::gemm_phase<pg8::EpiZ, pg8::StaticOrder, false>(lds, g, S, E, nullptr);
            __syncthreads();
            for (int t = bid; t < L2_THIN_TASKS; t += G) l2_thin_task(a, lds, l, t);
        }
        SEAM(p0 + 1);
        if (IN(p0 + 2)) { ArgsP a = largs(); for (int u = bid; u < L3_TOTAL; u += G) l3_unit(a, lds, l, u); }
        SEAM(p0 + 2);
        if (IN(p0 + 3)) { ArgsP a = largs(); l4_phase(a, lds, l); }
        SEAM(p0 + 3);
        if (IN(p0 + 4)) { ArgsP a = largs();
            pg8::Gemm g{(const bf16_t*)(a->ws + WS_MIXED), (const bf16_t*)(a->ws + WS_WOUTT) + (size_t)l * DM * DM, NTP, DM, DM, DM, DM};
            pg8::StaticOrder S; S.init(NTP, DM, G, bid);
            pg8::EpiY E{l == 0 ? a->in[I_XP] : (const float*)(a->ws + WS_Y0), l == 0 ? (float*)(a->ws + WS_Y0) : a->out + O_YP, (const float*)(a->ws + WS_MOD) + (size_t)l * 10 * 6144};
            pg8::gemm_phase<pg8::EpiY, pg8::StaticOrder, false>(lds, g, S, E, nullptr);
            __syncthreads();
            for (int t = bid; t < 64; t += G) l5_thin_task(a, lds, l, t);
        }
        if (l + 1 < NL) SEAM(p0 + 4);
    }
#undef IN
#undef SEAM
}

extern "C" void kernel_launch(void* const* d_in, const int* in_sizes, int n_in, void* d_out, int out_size, void* d_ws, size_t ws_size, hipStream_t stream) {
    static int grid = 0;
    if (grid == 0) {
        if (n_in != 27 || (size_t)out_size != O_END || ws_size < WS_END) { fprintf(stderr, "kernel_launch: unexpected shapes (n_in %d, out %d, ws %zu; need 27, %zu, >= %zu)\n", n_in, out_size, ws_size, (size_t)O_END, (size_t)WS_END); grid = -1; return; }
        int dev = 0, cus = 0, per_cu = 0;
        if (hipGetDevice(&dev) != hipSuccess || hipDeviceGetAttribute(&cus, hipDeviceAttributeMultiprocessorCount, dev) != hipSuccess) { grid = -1; return; }
        if (hipFuncSetAttribute((const void*)fwd, hipFuncAttributeMaxDynamicSharedMemorySize, LDS_BYTES) != hipSuccess) { fprintf(stderr, "kernel_launch: hipFuncSetAttribute failed\n"); grid = -1; return; }
        if (hipOccupancyMaxActiveBlocksPerMultiprocessor(&per_cu, (const void*)fwd, 512, LDS_BYTES) != hipSuccess || per_cu < 1) { fprintf(stderr, "kernel_launch: occupancy query says %d blocks per CU\n", per_cu); per_cu = 1; }
        (void)hipGetLastError();
        grid = cus;
    }
    if (grid < 0) return;
    (void)hipMemsetAsync((char*)d_ws + WS_CTL, 0, CTL_BYTES, stream);
    Args a{};
    for (int i = 0; i < 27; ++i) a.in[i] = (const float*)d_in[i];
    a.page_table = (const int*)d_in[I_PT];
    a.out = (float*)d_out; a.ws = (unsigned char*)d_ws;
#if MK_LAUNCHES == 1
    a.ph_lo = 0; a.ph_hi = N_PHASES;
    hipLaunchKernelGGL(fwd, dim3(grid), dim3(512), LDS_BYTES, stream, a);
#else
    for (int ph = 0; ph < N_PHASES; ++ph) { a.ph_lo = ph; a.ph_hi = ph + 1; hipLaunchKernelGGL(fwd, dim3(grid), dim3(512), LDS_BYTES, stream, a); }
#endif
}
```

```cpp
#include <hip/hip_runtime.h>
#include <stdint.h>
#include <stdio.h>

#define DI __device__ __forceinline__
#define LAS __attribute__((address_space(3)))
typedef unsigned short bf16_t;
typedef short bf16x8 __attribute__((ext_vector_type(8)));
typedef short s16x4 __attribute__((ext_vector_type(4)));
typedef float f32x4 __attribute__((ext_vector_type(4)));
typedef float f32x2 __attribute__((ext_vector_type(2)));
typedef unsigned u32x4 __attribute__((ext_vector_type(4)));
typedef unsigned u32x2 __attribute__((ext_vector_type(2)));

constexpr int DM = 2048, NB = 2, SEQ = 4096, NL = 2, DB = 8, DS = 4, PAST = 16384, PAGE = 128;
constexpr int HD = 128;
constexpr int NTP = NB * SEQ;
constexpr int NTS = DB * DS;
constexpr int NTOK = NTP + NTS;
constexpr int NPAGES = 128, NPOOL = 1280, WINB = 512, POOLB = 15;
constexpr int NIN = 6236;
constexpr int NC_S = 1023;
constexpr int NC_P = 255;
constexpr int ZLD = 6144;
constexpr int ZQ = 0, ZKV = 1024, ZAS = 2560, ZBI = 3584, ZBS = 4096, ZCQ = 4608, ZCKV = 5120, ZIQ = 5376, ZCS = 5632;
constexpr int ZSLD = 96, ZS_IK = 0, ZS_GATE = 64, ZS_IW = 88;
constexpr int WIN_ROWS = ZLD + ZSLD;
constexpr float LOG2E = 1.4426950408889634f;
constexpr float QK_SCALE2 = 0.08838834764831845f * 1.4426950408889634f;
constexpr float EPS = 1e-6f;
constexpr int SCORE_LD = 16512;
constexpr int LDS_BYTES = 163840, LDS_BAR_OFF = LDS_BYTES - 16, LDS_TICKET_OFF = LDS_BYTES - 32;

constexpr size_t al256(size_t x) { return (x + 255) & ~(size_t)255; }
constexpr size_t WS_CTL = 0, CTL_BYTES = 65536;
constexpr size_t WS_WINT = WS_CTL + CTL_BYTES;
constexpr size_t WS_WOUTT = WS_WINT + al256((size_t)NL * WIN_ROWS * DM * 2);
constexpr size_t WS_W1T = WS_WOUTT + al256((size_t)NL * DM * DM * 2);
constexpr size_t WS_W2T = WS_W1T + al256((size_t)4 * 256 * 4096 * 2);
constexpr size_t WS_PWT = WS_W2T + al256((size_t)4 * 128 * 256 * 2);
constexpr size_t WS_MOD = WS_PWT + al256((size_t)8 * 128 * 128 * 2);
constexpr size_t WS_CBIAS = WS_MOD + al256((size_t)NL * 10 * 6144 * 4);
constexpr size_t WS_BIAS = WS_CBIAS + al256((size_t)4 * 256 * 4);
constexpr size_t WS_H = WS_BIAS + 8192;
constexpr size_t WS_Z = WS_H + al256((size_t)8448 * DM * 2);
constexpr size_t WS_ZS = WS_Z + al256((size_t)8448 * ZLD * 2);
constexpr size_t WS_KIDXB = WS_ZS + al256((size_t)8448 * ZSLD * 4);
constexpr size_t WS_MIXED = WS_KIDXB + al256((size_t)8448 * 64 * 2);
constexpr size_t WS_Y0 = WS_MIXED + al256((size_t)8448 * DM * 2);
constexpr size_t WS_ACMPS = WS_Y0 + al256((size_t)8448 * DM * 4);
constexpr size_t WS_HIDS = WS_ACMPS + al256((size_t)(65536 + 2) * 2048 * 2);
constexpr size_t WS_KCS = WS_HIDS + al256((size_t)65536 * 256 * 2);
constexpr size_t WS_VCST = WS_KCS + al256((size_t)NL * 16 * 1024 * 128 * 2);
constexpr size_t WS_KCP = WS_VCST + al256((size_t)NL * 16 * 1024 * 128 * 2);
constexpr size_t WS_VCPT = WS_KCP + al256((size_t)4 * 256 * 128 * 2);
constexpr size_t WS_SCORES = WS_VCPT + al256((size_t)4 * 256 * 128 * 2);
constexpr size_t WS_CKV = WS_SCORES + al256((size_t)NTS * SCORE_LD * 4);
constexpr size_t WS_W1G = WS_CKV + al256((size_t)8448 * 256 * 2);
constexpr size_t WS_END = WS_W1G + al256((size_t)4 * 512 * 2048 * 2);
constexpr size_t WS_NKV = WS_END;
constexpr size_t WS_END2 = WS_NKV + al256((size_t)NB * 2 * 4 * SEQ * 128 * 2);
constexpr size_t WS_G = WS_ACMPS;

constexpr size_t O_YP = 0;
constexpr size_t O_YS = O_YP + (size_t)NTP * DM;
constexpr size_t O_AKVP = O_YS + (size_t)NTS * DM;
constexpr size_t O_AKVS = O_AKVP + (size_t)NL * NTP * 1024;
constexpr size_t O_CKVP = O_AKVS + (size_t)NL * NTS * 1024;
constexpr size_t O_CKVS = O_CKVP + (size_t)NL * NTP * 256;
constexpr size_t O_KIXP = O_CKVS + (size_t)NL * NTS * 256;
constexpr size_t O_KIXS = O_KIXP + (size_t)NL * NTP * 64;
constexpr size_t O_AWP = O_KIXS + (size_t)NL * NTS * 64;
constexpr size_t O_AWS = O_AWP + (size_t)NL * NB * 512 * 512;
constexpr size_t O_BPP = O_AWS + (size_t)NL * DB * 512 * 512;
constexpr size_t O_BPS = O_BPP + (size_t)NL * NB * 15 * 512;
constexpr size_t O_END = O_BPS + (size_t)NL * DB * 15 * 512;

struct Args {
    const float* in[27];
    const int* page_table;
    float* out;
    unsigned char* ws;
    int ph_lo, ph_hi;
};
enum { I_XP = 0, I_XS, I_CA, I_CC, I_CI, I_SW, I_SB, I_PT, I_CP, I_CSM, I_RB, I_NG, I_WADA, I_BADA, I_WIN, I_WOUT, I_AQN, I_AKN, I_PE, I_W1, I_B1, I_W2, I_B2, I_PW, I_BSC, I_CQN, I_CKN };

typedef const __attribute__((address_space(4))) Args* ArgsP;
DI int ltid() { int t = threadIdx.x; asm volatile("" : "+v"(t)); return t; }
DI ArgsP largs() { ArgsP p = (ArgsP)__builtin_amdgcn_kernarg_segment_ptr(); asm volatile("" : "+s"(p)); return p; }
DI float bf2f(bf16_t b) { return __uint_as_float(((unsigned)b) << 16); }
DI bf16_t f2bf(float f) { unsigned u = __float_as_uint(f); u += 0x7FFFu + ((u >> 16) & 1u); return (bf16_t)(u >> 16); }
typedef __bf16 bf16x2_t __attribute__((ext_vector_type(2)));
DI unsigned pk2(float lo, float hi) { const f32x2 v = {lo, hi}; return __builtin_bit_cast(unsigned, __builtin_convertvector(v, bf16x2_t)); }
DI float lo2f(unsigned w) { return __uint_as_float(w << 16); }
DI float hi2f(unsigned w) { return __uint_as_float(w & 0xffff0000u); }
DI float ldu(const float* p) { return __hip_atomic_load(p, __ATOMIC_RELAXED, __HIP_MEMORY_SCOPE_AGENT); }
DI float fexp2(float x) { return __builtin_amdgcn_exp2f(x); }
DI float frcp(float x) { return __builtin_amdgcn_rcpf(x); }
DI float sigmoidf_(float x) { return frcp(1.0f + fexp2(-x * LOG2E)); }
DI float siluf_(float x) { return x * sigmoidf_(x); }
DI float gelu_tanh(float x) { const float u = x * (1.0f + 0.044715f * x * x); return x * frcp(1.0f + fexp2(-2.302208198f * u)); }
DI f32x4 mfma16(bf16x8 a, bf16x8 b, f32x4 c) { return __builtin_amdgcn_mfma_f32_16x16x32_bf16(a, b, c, 0, 0, 0); }
DI float wave_sum(float v) { for (int o = 32; o >= 1; o >>= 1) v += __shfl_xor(v, o); return v; }
DI bf16x8 pack8(float a0, float a1, float a2, float a3, float a4, float a5, float a6, float a7) {
    u32x4 p; p.x = pk2(a0, a1); p.y = pk2(a2, a3); p.z = pk2(a4, a5); p.w = pk2(a6, a7); return __builtin_bit_cast(bf16x8, p);
}
DI void unpack8(const u32x4 w, float* v) { v[0] = lo2f(w.x); v[1] = hi2f(w.x); v[2] = lo2f(w.y); v[3] = hi2f(w.y); v[4] = lo2f(w.z); v[5] = hi2f(w.z); v[6] = lo2f(w.w); v[7] = hi2f(w.w); }
DI bf16x8 ld8(const bf16_t* p) { return *(const bf16x8*)p; }
DI bf16x8 cvt8(const float* p) { const f32x4 a = *(const f32x4*)p, b = *(const f32x4*)(p + 4); return pack8(a[0], a[1], a[2], a[3], b[0], b[1], b[2], b[3]); }
DI float dpp_xor1(float v) { return __builtin_bit_cast(float, __builtin_amdgcn_update_dpp(0, __builtin_bit_cast(int, v), 0xB1, 0xF, 0xF, true)); }
DI float dpp_xor2(float v) { return __builtin_bit_cast(float, __builtin_amdgcn_update_dpp(0, __builtin_bit_cast(int, v), 0x4E, 0xF, 0xF, true)); }
template <int CTRL> DI float dppf(float v) { return __builtin_bit_cast(float, __builtin_amdgcn_update_dpp(__builtin_bit_cast(int, v), __builtin_bit_cast(int, v), CTRL, 0xF, 0xF, false)); }
template <int CTRL> DI int dppi(int v) { return __builtin_amdgcn_update_dpp(v, v, CTRL, 0xF, 0xF, false); }
template <int CTRL> DI int dppi0(int v) { return __builtin_amdgcn_update_dpp(0, v, CTRL, 0xF, 0xF, true); }
DI float rlanef(float v, int l) { return __builtin_bit_cast(float, __builtin_amdgcn_readlane(__builtin_bit_cast(int, v), l)); }
DI float wave_max_dpp(float v) {
    v = fmaxf(v, dppf<0xB1>(v)); v = fmaxf(v, dppf<0x4E>(v)); v = fmaxf(v, dppf<0x141>(v)); v = fmaxf(v, dppf<0x140>(v));
    return fmaxf(fmaxf(rlanef(v, 0), rlanef(v, 16)), fmaxf(rlanef(v, 32), rlanef(v, 48)));
}
DI float wave_min_dpp(float v) {
    v = fminf(v, dppf<0xB1>(v)); v = fminf(v, dppf<0x4E>(v)); v = fminf(v, dppf<0x141>(v)); v = fminf(v, dppf<0x140>(v));
    return fminf(fminf(rlanef(v, 0), rlanef(v, 16)), fminf(rlanef(v, 32), rlanef(v, 48)));
}
DI int wave_sum_dpp(int v) {
    v += dppi<0xB1>(v); v += dppi<0x4E>(v); v += dppi<0x141>(v); v += dppi<0x140>(v);
    return __builtin_amdgcn_readlane(v, 0) + __builtin_amdgcn_readlane(v, 16) + __builtin_amdgcn_readlane(v, 32) + __builtin_amdgcn_readlane(v, 48);
}
DI int wave_incl_scan_dpp(int v, int lane) {
    v += dppi0<0x111>(v); v += dppi0<0x112>(v); v += dppi0<0x114>(v); v += dppi0<0x118>(v);
    const int r0 = __builtin_amdgcn_readlane(v, 15), r1 = __builtin_amdgcn_readlane(v, 31), r2 = __builtin_amdgcn_readlane(v, 47);
    return v + (lane >= 16 ? r0 : 0) + (lane >= 32 ? r1 : 0) + (lane >= 48 ? r2 : 0);
}
DI void lds_barrier() { asm volatile("s_waitcnt lgkmcnt(0)" ::: "memory"); __builtin_amdgcn_s_barrier(); asm volatile("" ::: "memory"); }
DI int t5_bucket(int rel) { if (rel < 16) return rel; const int b = 16 + (int)(logf((float)rel * (1.0f / 16.0f)) / logf(8.0f) * 16.0f); return b < 31 ? b : 31; }

#define XB_TMO      128
#define XB_XCNT(j)  (256  + 64 * (j))
#define XB_XSUB(j)  (1280 + 64 * (j))
#define XB_XGEN(j)  (2304 + 64 * (j))
#define XB_TOP      3328
#define XB_TOPGEN   3392
#define XCD_BAR_WORDS 3456
#define XB_SPIN_CAP (1u << 18)

__device__ __forceinline__ unsigned xb_ld(unsigned* p)              { return __hip_atomic_load(p, __ATOMIC_RELAXED, __HIP_MEMORY_SCOPE_AGENT); }
__device__ __forceinline__ unsigned xb_add(unsigned* p, unsigned v) { return __hip_atomic_fetch_add(p, v, __ATOMIC_RELAXED, __HIP_MEMORY_SCOPE_AGENT); }
__device__ __forceinline__ unsigned xb_xcc_id() { return (unsigned)__builtin_amdgcn_s_getreg((3 << 11) | 20) & 0xFu; }
#define XB_SPIN(cond, bar) do { unsigned _sp = 0; while (cond) { __builtin_amdgcn_s_sleep(1); \
    if ((++_sp & 255u) == 0u) { if (xb_ld(&(bar)[XB_TMO])) break; if (_sp > XB_SPIN_CAP) { atomicAdd(&(bar)[XB_TMO], 1u); break; } } } } while (0)

struct XcdBarrier {
    unsigned* bar; unsigned x;
    volatile LAS unsigned* st;
};

__device__ __forceinline__ XcdBarrier xcd_barrier_post(unsigned* bar, volatile LAS unsigned* st) {
    XcdBarrier b; b.bar = bar; b.x = xb_xcc_id(); b.st = st;
    if (threadIdx.x == 0) (void)xb_add(&bar[XB_XCNT(b.x)], 1u);
    return b;
}
__device__ __forceinline__ void xcd_barrier_complete(unsigned* bar, unsigned x, unsigned& nloc, unsigned& nx) {
    const unsigned G = gridDim.x * gridDim.y * gridDim.z;
    unsigned sum, cnt, mine, sp = 0u;
    for (;;) {
        sum = 0u; cnt = 0u; mine = 0u;
#pragma unroll
        for (unsigned j = 0; j < 16; ++j) { const unsigned c = xb_ld(&bar[XB_XCNT(j)]); sum += c; cnt += (c > 0u) ? 1u : 0u; mine = (j == x) ? c : mine; }
        if (sum == G) break;
        __builtin_amdgcn_s_sleep(1);
        if ((++sp & 255u) == 0u) { if (xb_ld(&bar[XB_TMO])) break; if (sp > XB_SPIN_CAP) { atomicAdd(&bar[XB_TMO], 1u); break; } }
    }
    nloc = mine > 0u ? mine : 1u; nx = cnt > 0u ? cnt : 1u;
}

__device__ __forceinline__ void xcd_barrier(const XcdBarrier& b) {
    asm volatile("s_waitcnt vmcnt(0)" ::: "memory");
    __syncthreads();
    if (threadIdx.x == 0) {
        unsigned* bar = b.bar;
        __builtin_amdgcn_s_waitcnt(0);
        unsigned nloc = b.st[0], nx = b.st[1];
        if (nloc == 0u) { xcd_barrier_complete(bar, b.x, nloc, nx); b.st[0] = nloc; b.st[1] = nx; }
        const unsigned old = xb_add(&bar[XB_XSUB(b.x)], 1u);
        const unsigned gen = old / nloc;
        if (old + 1u == (gen + 1u) * nloc) {
            __builtin_amdgcn_fence(__ATOMIC_RELEASE, "agent");
            asm volatile("s_waitcnt vmcnt(0)" ::: "memory");
            const unsigned og = xb_add(&bar[XB_TOP], 1u);
            const unsigned tg = og / nx;
            if (og + 1u == (tg + 1u) * nx) xb_add(&bar[XB_TOPGEN], 1u);
            else XB_SPIN(xb_ld(&bar[XB_TOPGEN]) == tg, bar);
            __builtin_amdgcn_fence(__ATOMIC_ACQUIRE, "agent");
            xb_add(&bar[XB_XGEN(b.x)], 1u);
            asm volatile("s_waitcnt vmcnt(0)" ::: "memory");
        } else {
            XB_SPIN(xb_ld(&bar[XB_XGEN(b.x)]) == gen, bar);
            __builtin_amdgcn_fence(__ATOMIC_ACQUIRE, "agent");
            asm volatile("s_waitcnt vmcnt(0)" ::: "memory");
        }
    }
    __syncthreads();
}

namespace pg8 {
#define PG8_LAS LAS
constexpr int BM = 256, BK = 64, HALF = 128, HTB = HALF * BK * 2  , STAGE_BYTES = 8 * HTB, NXCD = 8, WGM = 8;

__host__ __device__ __forceinline__ int lds_byte(int r, int c) { const int st = (r >> 4) * 2 + (c >> 5), rr = r & 15, cc = c & 31, ob = rr * 64 + cc * 2; return st * 1024 + (ob ^ (((ob >> 9) & 1) << 5)); }
__host__ __device__ __forceinline__ void stage_rc(int b, int& R, int& C) { const int st = b / 1024, sb = b % 1024, swz = sb ^ (((sb >> 9) & 1) << 5); R = (st >> 1) * 16 + swz / 64; C = (st & 1) * 32 + (swz % 64) / 2; }
__host__ __device__ __forceinline__ int perm32(int rho) { const int n = rho >> 4, i = rho & 15; return 8 * (i >> 2) + 4 * n + (i & 3); }

struct Unit { int pm, pn; size_t ka, kb; };
struct Gemm { const bf16_t* A; const bf16_t* Bt; int M, N, K, lda, ldb; };

struct StaticOrder {
    int nM, nN, nwg, G, c;
    __host__ __device__ void init(int M, int N, int G_, int c_) { nM = M / BM; nN = N / BM; nwg = nM * nN; G = G_; c = c_; }
    __host__ __device__ bool next(int i, Unit& u) const {
        const long L = (long)i * G + c; if (L >= nwg) return false;
        int wgid = (int)L; { const int q = nwg / NXCD, r = nwg % NXCD, xcd = wgid % NXCD, off = wgid / NXCD; wgid = (xcd < r ? xcd * (q + 1) : r * (q + 1) + (xcd - r) * q) + off; }
        const int nig = WGM * nN, gid = wgid / nig, fm = gid * WGM, gsz = (nM - fm) < WGM ? (nM - fm) : WGM;
        u.pm = fm + ((wgid % nig) % gsz); u.pn = (wgid % nig) / gsz; u.ka = 0; u.kb = 0; return true;
    }
    __device__ __forceinline__ void a_ready(const Unit&) const {}
    __device__ __forceinline__ void done(const Unit&) const {}
};
template <class Epi, class Sched, bool STAMP = false>
__device__ __forceinline__ void gemm_phase(PG8_LAS unsigned char* lds, const Gemm g, const Sched& S, const Epi& E, unsigned long long* stamps) {
    const int tid = ltid(), wid = __builtin_amdgcn_readfirstlane(tid >> 6), lane = tid & 63, wr = wid >> 2, wc = wid & 3, fr = lane & 15, fq = lane >> 4;
    const int K = g.K, nt = K / BK;
    int ts_lo = 0, ts_hi = 0, nts = 0; const unsigned long long rt_entry = STAMP ? (unsigned long long)wall_clock64() : 0ull;
#define PG8_STAMP() do { if (STAMP && wid == 0 && nts < 64) { const unsigned long long _c = (unsigned long long)clock64(); \
        ts_lo = (lane == nts) ? (int)(unsigned)_c : ts_lo; ts_hi = (lane == nts) ? (int)(unsigned)(_c >> 32) : ts_hi; ++nts; } } while (0)
    PG8_STAMP();
    unsigned voffA[2], voffB[2];
#pragma unroll
    for (int i = 0; i < 2; ++i) { int R, C; stage_rc(tid * 16 + i * 8192, R, C); const int Rb = Epi::PERM ? ((R & ~31) + perm32(R & 31)) : R;
        voffA[i] = (unsigned)(R * g.lda + C) * 2u; voffB[i] = (unsigned)(Rb * g.ldb + C) * 2u; }
    const size_t kstep = (size_t)(BK * 2);
    const size_t hstepA = (size_t)HALF * g.lda * 2, hstepB = (size_t)HALF * g.ldb * 2;
    const size_t tstepA = 2 * hstepA, tstepB = 2 * hstepB;
    const unsigned ldsw = (unsigned)wid * 1024u;
    const int aoff = lds_byte(wr * 64 + fr, fq * 8), boff = lds_byte(wc * 32 + fr, fq * 8);
#define PG8_SA(b, h) (((b) * 2 + (h)) * HTB)
#define PG8_SB(b, h) ((4 + (b) * 2 + (h)) * HTB)
#define PG8_STAGE(bufoff, gbase, voff) do { _Pragma("unroll") for (int _i = 0; _i < 2; ++_i) \
        __builtin_amdgcn_global_load_lds((const unsigned*)((const char*)(gbase) + (voff)[_i]), (PG8_LAS unsigned*)(lds + (bufoff) + ldsw + _i * 8192), 16, 0, 0); } while (0)
#define PG8_LDA(dst, b, h) do { _Pragma("unroll") for (int m = 0; m < 4; ++m) _Pragma("unroll") for (int k = 0; k < 2; ++k) dst[m][k] = *(const PG8_LAS bf16x8*)(lds + PG8_SA(b, h) + aoff + m * 2048 + k * 1024); } while (0)
#define PG8_LDB(dst, b, h) do { _Pragma("unroll") for (int n = 0; n < 2; ++n) _Pragma("unroll") for (int k = 0; k < 2; ++k) dst[n][k] = *(const PG8_LAS bf16x8*)(lds + PG8_SB(b, h) + boff + n * 2048 + k * 1024); } while (0)
#define PG8_MMA(ai, bj, At, Bt) do { __builtin_amdgcn_s_setprio(1); _Pragma("unroll") for (int m = 0; m < 4; ++m) _Pragma("unroll") for (int n = 0; n < 2; ++n) _Pragma("unroll") for (int k = 0; k < 2; ++k) \
        acc[ai][bj][m][n] = __builtin_amdgcn_mfma_f32_16x16x32_bf16(Bt[n][k], At[m][k], acc[ai][bj][m][n], 0, 0, 0); __builtin_amdgcn_s_setprio(0); } while (0)
#define PG8_WAIT_V(n) asm volatile("s_waitcnt vmcnt(" #n ")" ::: "memory")
#define PG8_WAIT_L(n) asm volatile("s_waitcnt lgkmcnt(" #n ")" ::: "memory")
#define PG8_BAR __builtin_amdgcn_s_barrier()
#define PG8_SCHED __builtin_amdgcn_sched_barrier(0)
    Unit cur, nxt; int ui = 0;
    if (!S.next(0, cur)) return;
    f32x4 acc[2][2][4][2];
#pragma unroll
    for (int a = 0; a < 2; ++a)
#pragma unroll
        for (int b = 0; b < 2; ++b)
#pragma unroll
            for (int m = 0; m < 4; ++m)
#pragma unroll
                for (int n = 0; n < 2; ++n) acc[a][b][m][n] = (f32x4){0.f, 0.f, 0.f, 0.f};
    bf16x8 At[4][2], B0[2][2], B1[2][2];
    const char* cA = (const char*)g.A + (size_t)cur.pm * tstepA + cur.ka * 2; const char* cB = (const char*)g.Bt + (size_t)cur.pn * tstepB + cur.kb * 2;
    S.a_ready(cur);
    PG8_STAGE(PG8_SB(0, 0), cB, voffB); PG8_STAGE(PG8_SA(0, 0), cA, voffA); PG8_STAGE(PG8_SB(0, 1), cB + hstepB, voffB); PG8_STAGE(PG8_SA(0, 1), cA + hstepA, voffA);
    if (wr == 1) PG8_BAR;
    PG8_WAIT_V(4); PG8_BAR;
    PG8_STAGE(PG8_SB(1, 0), cB + kstep, voffB); PG8_STAGE(PG8_SA(1, 0), cA + kstep, voffA); PG8_STAGE(PG8_SB(1, 1), cB + hstepB + kstep, voffB);
    PG8_WAIT_V(6); PG8_BAR;
    PG8_STAMP();
    for (;;) {
        const bool has_next = S.next(ui + 1, nxt);
        const char* nA = has_next ? (const char*)g.A + (size_t)nxt.pm * tstepA + nxt.ka * 2 : cA; const char* nB = has_next ? (const char*)g.Bt + (size_t)nxt.pn * tstepB + nxt.kb * 2 : cB;
        for (int t = 0; t < nt; t += 2) {
            const bool last = (t == nt - 2);
            const char* a1 = cA + (size_t)(t + 1) * kstep;
            const char* a2 = last ? nA : cA + (size_t)(t + 2) * kstep; const char* b2 = last ? nB : cB + (size_t)(t + 2) * kstep;
            const char* a3 = a2 + kstep; const char* b3 = b2 + kstep;
            if (last && has_next) S.a_ready(nxt);
            PG8_LDB(B0, 0, 0); PG8_SCHED; PG8_LDA(At, 0, 0); PG8_STAGE(PG8_SA(1, 1), a1 + hstepA, voffA);
            PG8_WAIT_L(8); PG8_BAR; PG8_WAIT_L(0); PG8_MMA(0, 0, At, B0); PG8_BAR; PG8_SCHED;
            PG8_LDB(B1, 0, 1); PG8_STAGE(PG8_SB(0, 0), b2, voffB);
            PG8_BAR; PG8_WAIT_L(0); PG8_MMA(0, 1, At, B1); PG8_BAR;
            PG8_LDA(At, 0, 1); PG8_STAGE(PG8_SA(0, 0), a2, voffA);
            PG8_BAR; PG8_WAIT_L(0); PG8_MMA(1, 0, At, B0); PG8_BAR; PG8_SCHED;
            PG8_STAGE(PG8_SB(0, 1), b2 + hstepB, voffB);
            PG8_WAIT_V(6); PG8_BAR; PG8_MMA(1, 1, At, B1); PG8_BAR;
            PG8_LDB(B0, 1, 0); PG8_SCHED; PG8_LDA(At, 1, 0); PG8_STAGE(PG8_SA(0, 1), a2 + hstepA, voffA);
            PG8_WAIT_L(8); PG8_BAR; PG8_WAIT_L(0); PG8_MMA(0, 0, At, B0); PG8_BAR; PG8_SCHED;
            PG8_LDB(B1, 1, 1); PG8_STAGE(PG8_SB(1, 0), b3, voffB);
            PG8_BAR; PG8_WAIT_L(0); PG8_MMA(0, 1, At, B1); PG8_BAR;
            PG8_LDA(At, 1, 1); PG8_STAGE(PG8_SA(1, 0), a3, voffA);
            PG8_BAR; PG8_WAIT_L(0); PG8_MMA(1, 0, At, B0); PG8_BAR; PG8_SCHED;
            PG8_STAGE(PG8_SB(1, 1), b3 + hstepB, voffB);
            PG8_WAIT_V(6); PG8_BAR; PG8_MMA(1, 1, At, B1); PG8_BAR;
        }
        PG8_STAMP();
        if constexpr (!Epi::AFTER_DRAIN) { E(acc, cur, wr, wc, fr, fq); S.done(cur); }
        PG8_STAMP();
        if (!has_next) break;
#pragma unroll
        for (int a = 0; a < 2; ++a)
#pragma unroll
            for (int b = 0; b < 2; ++b)
#pragma unroll
                for (int m = 0; m < 4; ++m)
#pragma unroll
                    for (int n = 0; n < 2; ++n) acc[a][b][m][n] = (f32x4){0.f, 0.f, 0.f, 0.f};
        cur = nxt; cA = nA; cB = nB; ++ui;
    }
    PG8_WAIT_V(0);
    if (wr == 0) PG8_BAR;
    PG8_BAR;
    if constexpr (Epi::AFTER_DRAIN) { E.fused(acc, cur, wr, wc, fr, fq, lds, wid, lane); S.done(cur); }
    PG8_STAMP();
    if (STAMP && wid == 0) { stamps[lane] = lane < nts ? (((unsigned long long)(unsigned)ts_hi << 32) | (unsigned)ts_lo) : 0ull;
        if (lane == 62) stamps[62] = rt_entry; if (lane == 63) stamps[63] = (unsigned long long)wall_clock64(); }
#undef PG8_STAMP
#undef PG8_SA
#undef PG8_SB
#undef PG8_STAGE
#undef PG8_LDA
#undef PG8_LDB
#undef PG8_MMA
#undef PG8_WAIT_V
#undef PG8_WAIT_L
#undef PG8_BAR
#undef PG8_SCHED
}
}

namespace pg8 {
struct EpiZ {
    static constexpr bool PERM = true, AFTER_DRAIN = false;
    bf16_t* O; int ldc;
    DI void operator()(const f32x4 (&acc)[2][2][4][2], const Unit& u, int wr, int wc, int fr, int fq) const {
        const int row0 = u.pm * BM + wr * 64 + fr, col0 = u.pn * BM + wc * 32 + 8 * fq;
#pragma unroll
        for (int ai = 0; ai < 2; ++ai)
#pragma unroll
            for (int m = 0; m < 4; ++m) { bf16_t* rowp = O + (size_t)(row0 + ai * HALF + m * 16) * ldc + col0;
#pragma unroll
                for (int bj = 0; bj < 2; ++bj) { const f32x4 v0 = acc[ai][bj][m][0], v1 = acc[ai][bj][m][1];
                    u32x4 w; w.x = pk2(v0[0], v0[1]); w.y = pk2(v0[2], v0[3]); w.z = pk2(v1[0], v1[1]); w.w = pk2(v1[2], v1[3]);
                    *(u32x4*)(rowp + bj * HALF) = w; } }
    }
};
struct EpiHid {
    static constexpr bool PERM = true, AFTER_DRAIN = false;
    bf16_t* O; const float* bias;
    DI void operator()(const f32x4 (&acc)[2][2][4][2], const Unit& u, int wr, int wc, int fr, int fq) const {
        const int row0 = u.pm * BM + wr * 64 + fr, col0 = wc * 32 + 8 * fq;
        const float* b = bias + (u.pm >> 6) * 256;
        f32x4 bv[2][2];
#pragma unroll
        for (int bj = 0; bj < 2; ++bj)
#pragma unroll
            for (int n = 0; n < 2; ++n) bv[bj][n] = *(const f32x4*)(b + col0 + bj * HALF + 4 * n);
#pragma unroll
        for (int ai = 0; ai < 2; ++ai)
#pragma unroll
            for (int m = 0; m < 4; ++m) { bf16_t* rowp = O + (size_t)(row0 + ai * HALF + m * 16) * 256 + col0;
#pragma unroll
                for (int bj = 0; bj < 2; ++bj) { f32x4 v0 = acc[ai][bj][m][0] + bv[bj][0], v1 = acc[ai][bj][m][1] + bv[bj][1];
#pragma unroll
                    for (int j = 0; j < 4; ++j) { v0[j] = gelu_tanh(v0[j]); v1[j] = gelu_tanh(v1[j]); }
                    u32x4 w; w.x = pk2(v0[0], v0[1]); w.y = pk2(v0[2], v0[3]); w.z = pk2(v1[0], v1[1]); w.w = pk2(v1[2], v1[3]);
                    *(u32x4*)(rowp + bj * HALF) = w; } }
    }
};
struct EpiY {
    static constexpr bool PERM = false, AFTER_DRAIN = false;
    const float* X; float* Y; const float* gate;
    DI void operator()(const f32x4 (&acc)[2][2][4][2], const Unit& u, int wr, int wc, int fr, int fq) const {
        const int row0 = u.pm * BM + wr * 64 + fr, col0 = u.pn * BM + wc * 32 + 4 * fq;
        const float* g = gate + (size_t)((u.pm * BM) / SEQ) * 6144 + 4096;
        f32x4 gv[2][2];
#pragma unroll
        for (int bj = 0; bj < 2; ++bj)
#pragma unroll
            for (int n = 0; n < 2; ++n) gv[bj][n] = *(const f32x4*)(g + col0 + bj * HALF + n * 16);
#pragma unroll
        for (int ai = 0; ai < 2; ++ai)
#pragma unroll
            for (int m = 0; m < 4; ++m) { const size_t off = (size_t)(row0 + ai * HALF + m * 16) * DM + col0;
#pragma unroll
                for (int bj = 0; bj < 2; ++bj)
#pragma unroll
                    for (int n = 0; n < 2; ++n) { const f32x4 x = *(const f32x4*)(X + off + bj * HALF + n * 16);
                        *(f32x4*)(Y + off + bj * HALF + n * 16) = x + gv[bj][n] * acc[ai][bj][m][n]; }
                asm volatile("" ::: "memory"); }
    }
};
struct OrderCmpS {
    int G, c;
    DI bool next(int i, Unit& u) const { const int L = i * G + c; if (L >= 256) return false; u.pm = L; u.pn = 0; u.ka = 0; u.kb = (size_t)(L >> 6) * 256 * 4096; return true; }
    DI void a_ready(const Unit&) const {}
    DI void done(const Unit&) const {}
};
}

template <int MT, int NT, class AF, class BF, class EP>
DI void thin_gemm_block(LAS unsigned char* lds, int K, AF aptr, BF bptr, EP ep) {
    const int tid = ltid(), w = tid >> 6, lane = tid & 63, li = lane & 15, quad = lane >> 4;
    const int kw = K / 8, kb = w * kw;
    f32x4 acc[MT][NT];
#pragma unroll
    for (int i = 0; i < MT; ++i)
#pragma unroll
        for (int j = 0; j < NT; ++j) acc[i][j] = (f32x4){0.f, 0.f, 0.f, 0.f};
    const bf16_t* ap[MT]; const bf16_t* bp[NT];
#pragma unroll
    for (int i = 0; i < MT; ++i) ap[i] = aptr(i * 16 + li) + kb + quad * 8;
#pragma unroll
    for (int j = 0; j < NT; ++j) bp[j] = bptr(j * 16 + li) + kb + quad * 8;
#pragma unroll 2
    for (int k = 0; k < kw; k += 32) {
        bf16x8 af[MT], bf[NT];
#pragma unroll
        for (int i = 0; i < MT; ++i) af[i] = ld8(ap[i] + k);
#pragma unroll
        for (int j = 0; j < NT; ++j) bf[j] = ld8(bp[j] + k);
#pragma unroll
        for (int i = 0; i < MT; ++i)
#pragma unroll
            for (int j = 0; j < NT; ++j) acc[i][j] = mfma16(af[i], bf[j], acc[i][j]);
    }
    LAS float* part = (LAS float*)lds;
#pragma unroll
    for (int i = 0; i < MT; ++i)
#pragma unroll
        for (int j = 0; j < NT; ++j)
#pragma unroll
            for (int e = 0; e < 4; ++e) part[((w * MT * NT + i * NT + j) * 4 + e) * 64 + lane] = acc[i][j][e];
    __syncthreads();
    for (int x = tid; x < MT * NT * 256; x += 512) {
        const int tile = x >> 8, r = x & 255, e = r >> 6, ln = r & 63;
        float s = 0.f;
#pragma unroll
        for (int ww = 0; ww < 8; ++ww) s += part[((ww * MT * NT + tile) * 4 + e) * 64 + ln];
        ep((tile / NT) * 16 + (ln >> 4) * 4 + e, (tile % NT) * 16 + (ln & 15), s);
    }
    __syncthreads();
}

DI int win_col(int n) {
    if (n < 2560) return n; if (n < 5632) return n + 24; if (n < 6144) return n + 92;
    const int j = n - 6144; if (j < 64) return 5656 + j; if (j < 88) return 2560 + (j - 64); if (j < 92) return 5720 + (j - 88); return -1;
}
template <class CM>
DI void transpose_tile(LAS float* tile, const float* src, size_t src_ld, bf16_t* dst, size_t dst_ld, int k0, int n0, int nmax, int KT, CM colmap) {
    const int tid = ltid();
    { const int c = tid & 63, kq = tid >> 6, n = n0 + c; const int sc = (n < nmax) ? colmap(n) : -1;
      float v[32];
#pragma unroll
      for (int i = 0; i < 32; ++i) v[i] = (sc >= 0 && i < KT * 8) ? src[(size_t)(k0 + kq + 8 * i) * src_ld + sc] : 0.f;
#pragma unroll
      for (int i = 0; i < 32; ++i) if (i < KT * 8) tile[(kq + 8 * i) * 65 + c] = v[i]; }
    __syncthreads();
    { const int nn = tid >> 3, k8 = tid & 7;
      if (n0 + nn < nmax) {
          for (int kt = 0; kt < KT; ++kt) { float v[8];
#pragma unroll
              for (int i = 0; i < 8; ++i) v[i] = tile[(kt * 64 + k8 * 8 + i) * 65 + nn];
              u32x4 w; w.x = pk2(v[0], v[1]); w.y = pk2(v[2], v[3]); w.z = pk2(v[4], v[5]); w.w = pk2(v[6], v[7]);
              *(u32x4*)(dst + (size_t)(n0 + nn) * dst_ld + k0 + kt * 64 + k8 * 8) = w; } } }
    __syncthreads();
}

DI void transpose_tile_w1g(LAS float* tile, const float* src, bf16_t* dstg, int k0, int n0, int prow) {
    const int tid = ltid();
    { const int c = tid & 63, kq = tid >> 6;
      float v[32];
#pragma unroll
      for (int i = 0; i < 32; ++i) v[i] = src[(size_t)(k0 + kq + 8 * i) * 256 + n0 + c];
#pragma unroll
      for (int i = 0; i < 32; ++i) tile[(kq + 8 * i) * 65 + c] = v[i]; }
    __syncthreads();
    { const int nn = tid >> 3, k8 = tid & 7;
      for (int kt = 0; kt < 4; ++kt) { float v[8];
#pragma unroll
          for (int i = 0; i < 8; ++i) v[i] = tile[(kt * 64 + k8 * 8 + i) * 65 + nn];
          u32x4 w; w.x = pk2(v[0], v[1]); w.y = pk2(v[2], v[3]); w.z = pk2(v[4], v[5]); w.w = pk2(v[6], v[7]);
          const int k = k0 + kt * 64 + k8 * 8;
          *(u32x4*)(dstg + ((size_t)(k >> 5) * 512 + prow + n0 + nn) * 32 + (k & 31)) = w; } }
    __syncthreads();
}

constexpr int PJ_WIN = 2 * 98 * 8, PJ_WOUT = 2 * 32 * 8, PJ_W1 = 4 * 4 * 16, PJ_W2 = 4 * 2, PJ_PW = 8 * 2;
constexpr int PJ_T_END = PJ_WIN + PJ_WOUT + PJ_W1 + PJ_W2 + PJ_PW;
#ifndef CMP_DIRECT
#define CMP_DIRECT 1
#endif
#if CMP_DIRECT
constexpr int PJ_MOD = 96, PJ_CB = 16, PJ_ACV = 256, PJ_BT = 1;
#else
constexpr int PJ_MOD = 96, PJ_CB = 16, PJ_ACV = 2048, PJ_BT = 1;
#endif
constexpr int PJ_TOTAL = PJ_T_END + PJ_MOD + PJ_CB + PJ_ACV + PJ_BT;

DI void prologue_unit(ArgsP a, LAS unsigned char* lds, int u) {
    const int tid = ltid();
    LAS float* tile = (LAS float*)lds;
    auto ident = [](int n) { return n; };
    if (u < PJ_WIN) { const int l = u / 784, r = u % 784, nt = r / 8, kt = r % 8;
        transpose_tile(tile, a->in[I_WIN] + (size_t)l * DM * NIN, NIN, (bf16_t*)(a->ws + WS_WINT) + (size_t)l * WIN_ROWS * DM, DM, kt * 256, nt * 64, WIN_ROWS, 4, [](int n) { return win_col(n); });
        return; }
    u -= PJ_WIN;
    if (u < PJ_WOUT) { const int l = u / 256, r = u % 256, nt = r / 8, kt = r % 8;
        transpose_tile(tile, a->in[I_WOUT] + (size_t)l * DM * DM, DM, (bf16_t*)(a->ws + WS_WOUTT) + (size_t)l * DM * DM, DM, kt * 256, nt * 64, DM, 4, ident);
        return; }
    u -= PJ_WOUT;
    if (u < PJ_W1) { const int g = u / 64, r = u % 64, nt = r / 16, kt = r % 16;
        transpose_tile(tile, a->in[I_W1] + (size_t)g * 4096 * 256, 256, (bf16_t*)(a->ws + WS_W1T) + (size_t)g * 256 * 4096, 4096, kt * 256, nt * 64, 256, 4, ident);
        return; }
    u -= PJ_W1;
    if (u < PJ_W2) { const int g = u / 2, nt = u % 2;
        transpose_tile(tile, a->in[I_W2] + (size_t)g * 256 * 128, 128, (bf16_t*)(a->ws + WS_W2T) + (size_t)g * 128 * 256, 256, 0, nt * 64, 128, 4, ident);
        return; }
    u -= PJ_W2;
    if (u < PJ_PW) { const int g = u / 2, nt = u % 2;
        transpose_tile(tile, a->in[I_PW] + (size_t)g * 128 * 128, 128, (bf16_t*)(a->ws + WS_PWT) + (size_t)g * 128 * 128, 128, 0, nt * 64, 128, 2, ident);
        return; }
    u -= PJ_PW;
    if (u < PJ_MOD) {
        const int l = u / 48, cg = u % 48;
        LAS float* sil = (LAS float*)lds; LAS float* red = sil + 10 * 2048;
        for (int i = tid; i < 10 * 2048; i += 512) { const int r = i >> 11, k = i & 2047; const float c = (r < 2) ? a->in[I_CP][r * DM + k] : a->in[I_CSM][(r - 2) * DM + k]; sil[i] = siluf_(c); }
        __syncthreads();
        const int ks = tid >> 6, ln = tid & 63;
        f32x2 acc[10];
#pragma unroll
        for (int r = 0; r < 10; ++r) acc[r] = (f32x2){0.f, 0.f};
        const float* wp = a->in[I_WADA] + (size_t)l * DM * 6144 + cg * 128 + ln * 2;
#pragma unroll 1
        for (int k0 = ks * 256; k0 < ks * 256 + 256; k0 += 16) {
            f32x2 wv[16];
#pragma unroll
            for (int j = 0; j < 16; ++j) wv[j] = __builtin_nontemporal_load((const f32x2*)(wp + (size_t)(k0 + j) * 6144));
#pragma unroll
            for (int j4 = 0; j4 < 4; ++j4)
#pragma unroll
                for (int r = 0; r < 10; ++r) { const f32x4 sv = *(const LAS f32x4*)(sil + r * 2048 + k0 + j4 * 4);
#pragma unroll
                    for (int j = 0; j < 4; ++j) acc[r] += wv[j4 * 4 + j] * sv[j]; }
        }
#pragma unroll
        for (int r = 0; r < 10; ++r) *(LAS f32x2*)(red + (ks * 10 + r) * 128 + ln * 2) = acc[r];
        __syncthreads();
        for (int i = tid; i < 1280; i += 512) { const int r = i >> 7, c2 = i & 127; float s = 0.f;
#pragma unroll
            for (int k2 = 0; k2 < 8; ++k2) s += red[(k2 * 10 + r) * 128 + c2];
            ((float*)(a->ws + WS_MOD))[(size_t)(l * 10 + r) * 6144 + cg * 128 + c2] = s + a->in[I_BADA][l * 6144 + cg * 128 + c2]; }
        __syncthreads();
        return; }
    u -= PJ_MOD;
    if (u < PJ_CB) {
        const int g = u / 4, cg = u % 4;
        LAS float* pe = (LAS float*)lds; LAS float* red = pe + 4096;
        for (int i = tid; i < 4096; i += 512) pe[i] = a->in[I_PE][(size_t)g * 4096 + i];
        __syncthreads();
        const int ks = tid >> 6, cc = tid & 63, col = cg * 64 + cc;
        const float* wp = a->in[I_W1] + (size_t)g * 4096 * 256 + col;
        float acc = 0.f;
#pragma unroll 8
        for (int k = ks * 512; k < ks * 512 + 512; ++k) acc += pe[k] * wp[(size_t)k * 256];
        red[ks * 64 + cc] = acc;
        __syncthreads();
        if (tid < 64) { float s = 0.f;
#pragma unroll
            for (int k2 = 0; k2 < 8; ++k2) s += red[k2 * 64 + tid];
            ((float*)(a->ws + WS_CBIAS))[g * 256 + cg * 64 + tid] = s + a->in[I_B1][g * 256 + cg * 64 + tid]; }
        __syncthreads();
        return; }
    u -= PJ_CB;
#if CMP_DIRECT
    if (u < PJ_ACV) {
        const int g = u >> 6, r = u & 63, pp = r >> 5, nt = (r >> 3) & 3, kt = r & 7;
        transpose_tile_w1g(tile, a->in[I_W1] + (size_t)g * 4096 * 256 + (size_t)pp * 2048 * 256, (bf16_t*)(a->ws + WS_W1G) + (size_t)g * 512 * 2048, kt * 256, nt * 64, pp * 256);
        return; }
#else
    if (u < PJ_ACV) {
        const int l = u / 1024, r = u % 1024, b = r / 128, pi = r % 128;
        const int page = a->page_table[b * NPAGES + pi];
        const float* src = a->in[I_CA] + ((size_t)(l * NPOOL + page) * PAGE) * 1024;
        bf16_t* dst = (bf16_t*)(a->ws + WS_ACMPS);
        const int f4 = tid & 127, rq = tid >> 7;
        const int kv = f4 >> 6, kvh = (f4 >> 5) & 1, d = (f4 & 31) * 4;
        for (int r0 = rq; r0 < 128; r0 += 32) {
            f32x4 v[8];
#pragma unroll
            for (int i = 0; i < 8; ++i) v[i] = __builtin_nontemporal_load((const f32x4*)(src + (size_t)(r0 + 4 * i) * 1024 + f4 * 4));
#pragma unroll
            for (int i = 0; i < 8; ++i) { const int rr = r0 + 4 * i;
                const size_t m = ((size_t)((l * 2 + kv) * 16 + b * 2 + kvh)) * 1024 + pi * 8 + (rr >> 4);
                u32x2 w; w.x = pk2(v[i][0], v[i][1]); w.y = pk2(v[i][2], v[i][3]);
                *(u32x2*)(dst + m * 2048 + (rr & 15) * 128 + d) = w; }
        }
        return; }
#endif
    u -= PJ_ACV;
    {
        float* bt = (float*)(a->ws + WS_BIAS);
        if (tid < 129) { const int bk = t5_bucket(tid);
            for (int h = 0; h < 8; ++h) bt[tid * 8 + h] = a->in[I_RB][bk * 12 + h] * LOG2E;
            for (int h = 0; h < 4; ++h) bt[129 * 8 + tid * 4 + h] = a->in[I_RB][bk * 12 + 8 + h] * LOG2E; }
        if (tid >= 192 && tid < 200) { const int l = (tid - 192) >> 2, j = (tid - 192) & 3; const float* gp = j < 3 ? a->in[I_AKN] + (size_t)(l * 3 + j) * 128 : a->in[I_CKN] + l * 128;
            float m = 0.f; for (int d = 0; d < 128; ++d) m = fmaxf(m, fabsf(gp[d])); bt[1600 + l * 4 + j] = m; }
        if (tid == 256 || tid == 257) { float m = 0.f; const int h0 = tid == 256 ? 0 : 8, h1 = tid == 256 ? 8 : 12;
            for (int bk = 0; bk < 32; ++bk) for (int h = h0; h < h1; ++h) m = fmaxf(m, fabsf(a->in[I_RB][bk * 12 + h])); bt[1608 + (tid - 256)] = m * LOG2E; }
    }
}

constexpr int CG_ROWS = 64, CG_UNITS = 65536 / CG_ROWS;
constexpr int CG_AP = 80;
constexpr int CG_A = 0, CG_B = 2 * CG_ROWS * CG_AP * 2;
DI void cmp_gemm_direct(ArgsP a, LAS unsigned char* lds, int u) {
    const int tid = ltid(), w = __builtin_amdgcn_readfirstlane(tid >> 6), lane = tid & 63, li = lane & 15, quad = lane >> 4;
    const int grp = u >> 8, ub = (u >> 5) & 7, c0u = (u & 31) * 32, l = grp >> 1, kv = grp & 1;
    LAS bf16_t* As = (LAS bf16_t*)(lds + CG_A);
    if (w >= 4) {
        const int tl = tid - 256, ar = tl >> 3, aq = tl & 7;
        const int c = c0u + ar;
        const float* arow = a->in[I_CA] + ((size_t)(l * NPOOL + a->page_table[ub * NPAGES + (c >> 3)]) * PAGE + (c & 7) * 16) * 1024 + kv * 256 + aq * 4;
        f32x4 st[6][4];
        auto req = [&](int s, f32x4 (&v)[4]) { if (s < 32) { const float* p = arow + (size_t)(s >> 1) * 1024 + (s & 1) * 64;
#pragma unroll
            for (int i = 0; i < 4; ++i) v[i] = __builtin_nontemporal_load((const f32x4*)(p + (i >> 1) * 128 + (i & 1) * 32)); } };
        auto put = [&](int s, const f32x4 (&v)[4]) { if (s < 32) {
#pragma unroll
            for (int i = 0; i < 4; ++i) { u32x2 wv; wv.x = pk2(v[i][0], v[i][1]); wv.y = pk2(v[i][2], v[i][3]);
                *(LAS u32x2*)(As + ((s & 1) * CG_ROWS + (i >> 1) * 32 + ar) * CG_AP + ((i & 1) * 8 + aq) * 4) = wv; } } };
#pragma unroll
        for (int s = 0; s < 6; ++s) req(s, st[s]);
        put(0, st[0]); req(6, st[0]);
        lds_barrier();
#pragma unroll
        for (int s = 0; s < 32; ++s) { put(s + 1, st[(s + 1) % 6]); req(s + 7, st[(s + 1) % 6]); lds_barrier(); }
    } else {
        const bf16_t* bsrc = (const bf16_t*)(a->ws + WS_W1G) + (size_t)grp * 512 * 2048 + (size_t)(w * 128 + (lane >> 2)) * 32 + ((lane & 3) ^ ((lane >> 4) & 2)) * 8;
        LAS unsigned char* bring = lds + CG_B + w * 8192;
        const unsigned bfo = (unsigned)(CG_B + w * 8192 + (li * 4 + (quad ^ ((li >> 2) & 2))) * 16);
        f32x4 acc[4][8];
#pragma unroll
        for (int i = 0; i < 4; ++i)
#pragma unroll
            for (int j = 0; j < 8; ++j) acc[i][j] = (f32x4){0.f, 0.f, 0.f, 0.f};
        auto dma_b = [&](int kt, int buf) { const unsigned* gp = (const unsigned*)(bsrc + (size_t)kt * (512 * 32)); LAS unsigned* lp = (LAS unsigned*)(bring + buf * 32768);
            __builtin_amdgcn_global_load_lds(gp, lp, 16, 0, 0); __builtin_amdgcn_global_load_lds(gp, lp, 16, 1024, 0);
            __builtin_amdgcn_global_load_lds(gp, lp, 16, 2048, 0); __builtin_amdgcn_global_load_lds(gp, lp, 16, 3072, 0);
            const unsigned* gp2 = gp + 1024; LAS unsigned* lp2 = lp + 1024;
            __builtin_amdgcn_global_load_lds(gp2, lp2, 16, 0, 0); __builtin_amdgcn_global_load_lds(gp2, lp2, 16, 1024, 0);
            __builtin_amdgcn_global_load_lds(gp2, lp2, 16, 2048, 0); __builtin_amdgcn_global_load_lds(gp2, lp2, 16, 3072, 0); };
        int rb = 0;
        dma_b(0, 0); dma_b(1, 1); dma_b(2, 2);
        lds_barrier();
#pragma unroll 1
        for (int s = 0; s < 32; ++s) {
#pragma unroll
            for (int kq = 0; kq < 2; ++kq) {
                const int kt = s * 2 + kq;
                if (kt + 2 < 64) asm volatile("s_waitcnt vmcnt(16)" ::: "memory"); else if (kt + 1 < 64) asm volatile("s_waitcnt vmcnt(8)" ::: "memory"); else asm volatile("s_waitcnt vmcnt(0)" ::: "memory");
                if (kt + 3 < 64) dma_b(kt + 3, (rb + 3) & 3);
                bf16x8 af[4], bf[8];
#pragma unroll
                for (int mt = 0; mt < 4; ++mt) af[mt] = *(const LAS bf16x8*)(As + ((s & 1) * CG_ROWS + mt * 16 + li) * CG_AP + kq * 32 + quad * 8);
#pragma unroll
                for (int nt = 0; nt < 8; ++nt) bf[nt] = *(const LAS bf16x8*)(lds + bfo + rb * 32768 + nt * 1024);
                __builtin_amdgcn_sched_barrier(0);
#pragma unroll
                for (int nt = 0; nt < 8; ++nt)
#pragma unroll
                    for (int mt = 0; mt < 4; ++mt) acc[mt][nt] = mfma16(bf[nt], af[mt], acc[mt][nt]);
                rb = (rb + 1) & 3;
            }
            lds_barrier();
        }
        bf16_t* G = (bf16_t*)(a->ws + WS_G) + ((size_t)grp * 16384 + (size_t)ub * 2048 + c0u) * 512 + w * 128;
#pragma unroll
        for (int mt = 0; mt < 4; ++mt)
#pragma unroll
            for (int nt = 0; nt < 8; ++nt) { u32x2 o; o.x = pk2(acc[mt][nt][0], acc[mt][nt][1]); o.y = pk2(acc[mt][nt][2], acc[mt][nt][3]);
                *(u32x2*)(G + (size_t)((mt >> 1) * 1024 + (mt & 1) * 16 + li) * 512 + nt * 16 + quad * 4) = o; }
    }
    __syncthreads();
}

DI void cmp2_sample_rows(ArgsP a, int m0);
DI void cmp2_sample_unit(ArgsP a, int u) { cmp2_sample_rows(a, (u * 8 + (ltid() >> 6)) * 16); }
DI int cg_unit_row(int u, int kvh) { return (u >> 8) * 16384 + (((u >> 5) & 7) * 2 + kvh) * 1024 + (u & 31) * 32; }
DI void cmp2_sample_own(ArgsP a, int u) { const int w = ltid() >> 6; if (w < 2) cmp2_sample_rows(a, cg_unit_row(u, w)); }
DI void cmp2_sample_tail(ArgsP a) { for (int x = blockIdx.x * 8 + (ltid() >> 6); x < CG_UNITS * 2; x += gridDim.x * 8) cmp2_sample_rows(a, cg_unit_row(x >> 1, x & 1) + 16); }
DI void cmp2_sample_rows(ArgsP a, int m0) {
    const int tid = ltid(), lane = tid & 63, li = lane & 15, quad = lane >> 4;
    const int grp = m0 >> 14, l = grp >> 1, kv = grp & 1, g = (m0 >> 10) & 15, i0 = m0 & 1023;
    const bf16_t* w2 = (const bf16_t*)(a->ws + WS_W2T) + (size_t)grp * 128 * 256 + (size_t)li * 256 + quad * 8;
    f32x4 acc[8];
#pragma unroll
    for (int nt = 0; nt < 8; ++nt) acc[nt] = (f32x4){0.f, 0.f, 0.f, 0.f};
#if CMP_DIRECT
    const bf16_t* g0 = (const bf16_t*)(a->ws + WS_G) + (size_t)(m0 + li) * 512 + quad * 8;
    const float* cb = (const float*)(a->ws + WS_CBIAS) + grp * 256 + quad * 8;
    bf16x8 hf[8];
#pragma unroll
    for (int kk = 0; kk < 8; ++kk) { float x0[8], x1[8]; unpack8(*(const u32x4*)(g0 + kk * 32), x0); unpack8(*(const u32x4*)(g0 + 512 + 256 + kk * 32), x1);
        const f32x4 c0 = *(const f32x4*)(cb + kk * 32), c1 = *(const f32x4*)(cb + kk * 32 + 4);
        hf[kk] = pack8(gelu_tanh(x0[0] + x1[0] + c0[0]), gelu_tanh(x0[1] + x1[1] + c0[1]), gelu_tanh(x0[2] + x1[2] + c0[2]), gelu_tanh(x0[3] + x1[3] + c0[3]),
                       gelu_tanh(x0[4] + x1[4] + c1[0]), gelu_tanh(x0[5] + x1[5] + c1[1]), gelu_tanh(x0[6] + x1[6] + c1[2]), gelu_tanh(x0[7] + x1[7] + c1[3])); }
#else
    const bf16_t* hid = (const bf16_t*)(a->ws + WS_HIDS) + (size_t)(m0 + li) * 256 + quad * 8;
#endif
#pragma unroll
    for (int kk = 0; kk < 8; ++kk) {
#if CMP_DIRECT
        const bf16x8 af = hf[kk];
#else
        const bf16x8 af = ld8(hid + kk * 32);
#endif
#pragma unroll
        for (int nt = 0; nt < 8; ++nt) acc[nt] = mfma16(af, ld8(w2 + (size_t)nt * 16 * 256 + kk * 32), acc[nt]); }
    const float* b2 = a->in[I_B2] + grp * 128;
#pragma unroll
    for (int nt = 0; nt < 8; ++nt) { const float bb = b2[nt * 16 + li];
#pragma unroll
        for (int e = 0; e < 4; ++e) acc[nt][e] += bb; }
    if (kv == 0) {
        const float* gn = a->in[I_AKN] + (size_t)l * 3 * 128;
        float ss[4];
#pragma unroll
        for (int e = 0; e < 4; ++e) { float s = 0.f;
#pragma unroll
            for (int nt = 0; nt < 8; ++nt) s += acc[nt][e] * acc[nt][e];
            s += __shfl_xor(s, 1); s += __shfl_xor(s, 2); s += __shfl_xor(s, 4); s += __shfl_xor(s, 8);
            ss[e] = rsqrtf(s * (1.0f / 128.0f) + EPS); }
        bf16_t* kc = (bf16_t*)(a->ws + WS_KCS) + ((size_t)(l * 16 + g) * 1024 + i0) * 128;
#pragma unroll
        for (int nt = 0; nt < 8; ++nt) { const float gg = gn[nt * 16 + li];
#pragma unroll
            for (int e = 0; e < 4; ++e) { const int i = quad * 4 + e; kc[(size_t)i * 128 + nt * 16 + li] = (i0 + i < NC_S) ? f2bf(acc[nt][e] * ss[e] * gg) : (bf16_t)0; } }
    } else {
        bf16_t* vt = (bf16_t*)(a->ws + WS_VCST) + (size_t)(l * 16 + g) * 128 * 1024;
#pragma unroll
        for (int nt = 0; nt < 8; ++nt) { float v[4];
#pragma unroll
            for (int e = 0; e < 4; ++e) v[e] = (i0 + quad * 4 + e < NC_S) ? acc[nt][e] : 0.f;
            u32x2 wv; wv.x = pk2(v[0], v[1]); wv.y = pk2(v[2], v[3]);
            *(u32x2*)(vt + (size_t)(nt * 16 + li) * 1024 + i0 + quad * 4) = wv; }
    }
}

DI void l1_rows(ArgsP a, int l) {
    const int lane = ltid() & 63, gw = blockIdx.x * 8 + (ltid() >> 6), nw = gridDim.x * 8;
    const float* ng = a->in[I_NG] + l * DM; const float* modl = (const float*)(a->ws + WS_MOD) + (size_t)l * 10 * 6144;
    bf16_t* H = (bf16_t*)(a->ws + WS_H);
    auto xrow = [&](int r) { return (l == 0) ? (r < NTP ? a->in[I_XP] + (size_t)r * DM : a->in[I_XS] + (size_t)(r - NTP) * DM) : (const float*)(a->ws + WS_Y0) + (size_t)r * DM; };
    f32x4 vn[8];
    if (gw < NTOK) { const float* x = xrow(gw);
#pragma unroll
        for (int i = 0; i < 8; ++i) vn[i] = *(const f32x4*)(x + (i * 64 + lane) * 4); }
    for (int r = gw; r < NTOK; r += nw) {
        const float* md = modl + (size_t)(r < NTP ? r / SEQ : 2 + (r - NTP) / DS) * 6144;
        f32x4 v[8]; float ss = 0.f;
#pragma unroll
        for (int i = 0; i < 8; ++i) { v[i] = vn[i]; ss += v[i][0] * v[i][0] + v[i][1] * v[i][1] + v[i][2] * v[i][2] + v[i][3] * v[i][3]; }
        if (r + nw < NTOK) { const float* x = xrow(r + nw);
#pragma unroll
            for (int i = 0; i < 8; ++i) vn[i] = *(const f32x4*)(x + (i * 64 + lane) * 4); }
        f32x4 g4[8], sh[8], sc[8];
#pragma unroll
        for (int i = 0; i < 8; ++i) { const int c = (i * 64 + lane) * 4; g4[i] = *(const f32x4*)(ng + c); sh[i] = *(const f32x4*)(md + c); sc[i] = *(const f32x4*)(md + 2048 + c); }
        ss = wave_sum(ss);
        const float inv = rsqrtf(ss * (1.0f / DM) + EPS);
#pragma unroll
        for (int i = 0; i < 8; ++i) { const int c = (i * 64 + lane) * 4;
            const f32x4 y = v[i] * inv * g4[i] * (sc[i] + 1.0f) + sh[i];
            u32x2 w; w.x = pk2(y[0], y[1]); w.y = pk2(y[2], y[3]);
            *(u32x2*)(H + (size_t)r * DM + c) = w; }
    }
}

DI void l2_thin_task(ArgsP a, LAS unsigned char* lds, int l, int t) {
    const bf16_t* H = (const bf16_t*)(a->ws + WS_H); const bf16_t* W = (const bf16_t*)(a->ws + WS_WINT) + (size_t)l * WIN_ROWS * DM;
    if (t < 256) {
        float* zs = (float*)(a->ws + WS_ZS) + (size_t)t * 32 * ZSLD;
        thin_gemm_block<2, 6>(lds, DM, [&](int row) { return H + (size_t)(t * 32 + row) * DM; }, [&](int col) { return W + (size_t)(ZLD + col) * DM; },
                              [&](int row, int col, float v) { zs[row * ZSLD + col] = v; });
    } else {
        const int j = t - 256;
        bf16_t* z = (bf16_t*)(a->ws + WS_Z) + (size_t)NTP * ZLD; float* zs = (float*)(a->ws + WS_ZS) + (size_t)NTP * ZSLD;
        thin_gemm_block<2, 2>(lds, DM, [&](int row) { return H + (size_t)(NTP + row) * DM; }, [&](int col) { return W + (size_t)(j * 32 + col) * DM; },
                              [&](int row, int col, float v) { const int n = j * 32 + col; if (n < ZLD) z[(size_t)row * ZLD + n] = f2bf(v); else zs[row * ZSLD + n - ZLD] = v; });
    }
}
constexpr int L2_THIN_TASKS = 256 + 195;

DI void l5_thin_task(ArgsP a, LAS unsigned char* lds, int l, int j) {
    const bf16_t* Mx = (const bf16_t*)(a->ws + WS_MIXED) + (size_t)NTP * DM; const bf16_t* W = (const bf16_t*)(a->ws + WS_WOUTT) + (size_t)l * DM * DM;
    const float* X = (l == 0) ? a->in[I_XS] : (const float*)(a->ws + WS_Y0) + (size_t)NTP * DM;
    float* Y = (l == 0) ? (float*)(a->ws + WS_Y0) + (size_t)NTP * DM : a->out + O_YS;
    const float* modl = (const float*)(a->ws + WS_MOD) + (size_t)l * 10 * 6144;
    thin_gemm_block<2, 2>(lds, DM, [&](int row) { return Mx + (size_t)row * DM; }, [&](int col) { return W + (size_t)(j * 32 + col) * DM; },
                          [&](int row, int col, float v) { const int n = j * 32 + col; Y[(size_t)row * DM + n] = X[(size_t)row * DM + n] + modl[(size_t)(2 + row / DS) * 6144 + 4096 + n] * v; });
}

DI u32x4 repack8(const float* v) { u32x4 w; w.x = pk2(v[0], v[1]); w.y = pk2(v[2], v[3]); w.z = pk2(v[4], v[5]); w.w = pk2(v[6], v[7]); return w; }

DI void l3_row(ArgsP a, int l, int r, int lane) {
    bf16_t* zr = (bf16_t*)(a->ws + WS_Z) + (size_t)r * ZLD;
    const float* zs = (const float*)(a->ws + WS_ZS) + (size_t)r * ZSLD;
    const bool smp = r >= NTP; const int rs = r - NTP;
    const int b = smp ? rs / DS : r / SEQ, t = smp ? rs % DS : r % SEQ;
    float* out = a->out;
    const u32x4 wq0 = *(const u32x4*)(zr + ZQ + lane * 16), wq1 = *(const u32x4*)(zr + ZQ + lane * 16 + 8);
    u32x2 wkv[6];
#pragma unroll
    for (int which = 0; which < 6; ++which) wkv[which] = *(const u32x2*)(zr + ZKV + which * 256 + lane * 4);
    const u32x4 wcq = *(const u32x4*)(zr + ZCQ + lane * 8);
    const u32x2 wck = *(const u32x2*)(zr + ZCKV + lane * 4);
    const float kx = zs[ZS_IK + lane];
    float* dpool = smp ? out + O_BPS + (size_t)((l * DB + b) * 15 + 11 + t) * 512 : (t >= SEQ - 15 ? out + O_BPP + (size_t)((l * NB + b) * 15 + t - (SEQ - 15)) * 512 : nullptr);
    u32x4 wbi = {0u, 0u, 0u, 0u};
    if (dpool) wbi = *(const u32x4*)(zr + ZBI + lane * 8);
    const float* gq = a->in[I_AQN] + l * 128 + (lane & 7) * 16;
    const f32x4 gq0 = *(const f32x4*)gq, gq1 = *(const f32x4*)(gq + 4), gq2 = *(const f32x4*)(gq + 8), gq3 = *(const f32x4*)(gq + 12);
    const f32x4 gk1 = *(const f32x4*)(a->in[I_AKN] + (size_t)(l * 3 + 1) * 128 + (lane & 31) * 4), gk2 = *(const f32x4*)(a->in[I_AKN] + (size_t)(l * 3 + 2) * 128 + (lane & 31) * 4);
    const float* gc = a->in[I_CQN] + l * 128 + (lane & 15) * 8;
    const f32x4 gc0 = *(const f32x4*)gc, gc1 = *(const f32x4*)(gc + 4);
    const f32x4 gck = *(const f32x4*)(a->in[I_CKN] + l * 128 + (lane & 31) * 4);
    {
        float v[16];
        unpack8(wq0, v); unpack8(wq1, v + 8);
        float ss = 0.f;
#pragma unroll
        for (int i = 0; i < 16; ++i) ss += v[i] * v[i];
        ss += __shfl_xor(ss, 1); ss += __shfl_xor(ss, 2); ss += __shfl_xor(ss, 4);
        const float inv = rsqrtf(ss * (1.0f / 128.0f) + EPS);
#pragma unroll
        for (int i = 0; i < 4; ++i) { v[i] *= inv * gq0[i]; v[4 + i] *= inv * gq1[i]; v[8 + i] *= inv * gq2[i]; v[12 + i] *= inv * gq3[i]; }
        *(u32x4*)(zr + ZQ + lane * 16) = repack8(v); *(u32x4*)(zr + ZQ + lane * 16 + 8) = repack8(v + 8);
    }
    {
        float* dkv = smp ? out + O_AKVS + (size_t)(l * NTS + rs) * 1024 : out + O_AKVP + (size_t)(l * NTP + r) * 1024;
        float* dwin = smp ? out + O_AWS + (size_t)((l * DB + b) * 512 + 508 + t) * 512 : (t >= SEQ - 512 ? out + O_AWP + (size_t)((l * NB + b) * 512 + t - (SEQ - 512)) * 512 : nullptr);
#pragma unroll
        for (int which = 0; which < 6; ++which) {
            const u32x2 w = wkv[which];
            f32x4 v = {lo2f(w.x), hi2f(w.x), lo2f(w.y), hi2f(w.y)};
            if (which == 2 || which == 4) {
                float ss = v[0] * v[0] + v[1] * v[1] + v[2] * v[2] + v[3] * v[3];
                ss += __shfl_xor(ss, 1); ss += __shfl_xor(ss, 2); ss += __shfl_xor(ss, 4); ss += __shfl_xor(ss, 8); ss += __shfl_xor(ss, 16);
                const float inv = rsqrtf(ss * (1.0f / 128.0f) + EPS);
                v = v * inv * (which == 2 ? gk1 : gk2);
                u32x2 wo; wo.x = pk2(v[0], v[1]); wo.y = pk2(v[2], v[3]); *(u32x2*)(zr + ZKV + which * 256 + lane * 4) = wo;
            }
            if (which < 4) *(f32x4*)(dkv + which * 256 + lane * 4) = v;
            else if (dwin) *(f32x4*)(dwin + (which - 4) * 256 + lane * 4) = v;
        }
    }
    {
        float v[8]; unpack8(wcq, v);
        float ss = 0.f;
#pragma unroll
        for (int i = 0; i < 8; ++i) ss += v[i] * v[i];
        ss += __shfl_xor(ss, 1); ss += __shfl_xor(ss, 2); ss += __shfl_xor(ss, 4); ss += __shfl_xor(ss, 8);
        const float inv = rsqrtf(ss * (1.0f / 128.0f) + EPS);
#pragma unroll
        for (int i = 0; i < 4; ++i) { v[i] *= inv * gc0[i]; v[4 + i] *= inv * gc1[i]; }
        *(u32x4*)(zr + ZCQ + lane * 8) = repack8(v);
    }
    {
        f32x4 v = {lo2f(wck.x), hi2f(wck.x), lo2f(wck.y), hi2f(wck.y)};
        float ss = v[0] * v[0] + v[1] * v[1] + v[2] * v[2] + v[3] * v[3];
        ss += __shfl_xor(ss, 1); ss += __shfl_xor(ss, 2); ss += __shfl_xor(ss, 4); ss += __shfl_xor(ss, 8); ss += __shfl_xor(ss, 16);
        if (lane < 32) { const float inv = rsqrtf(ss * (1.0f / 128.0f) + EPS);
            v = v * inv * gck;
            u32x2 wo; wo.x = pk2(v[0], v[1]); wo.y = pk2(v[2], v[3]); *(u32x2*)(zr + ZCKV + lane * 4) = wo; }
        { u32x2 wc; wc.x = pk2(v[0], v[1]); wc.y = pk2(v[2], v[3]); *(u32x2*)((bf16_t*)(a->ws + WS_CKV) + (size_t)r * 256 + lane * 4) = wc; }
        float* d = smp ? out + O_CKVS + (size_t)(l * NTS + rs) * 256 : out + O_CKVP + (size_t)(l * NTP + r) * 256;
        *(f32x4*)(d + lane * 4) = v;
    }
    {
        float* d = smp ? out + O_KIXS + (size_t)(l * NTS + rs) * 64 : out + O_KIXP + (size_t)(l * NTP + r) * 64;
        d[lane] = kx;
        ((bf16_t*)(a->ws + WS_KIDXB))[(size_t)r * 64 + lane] = f2bf(kx);
    }
    if (dpool) {
        float v[8]; unpack8(wbi, v);
        *(f32x4*)(dpool + lane * 8) = (f32x4){v[0], v[1], v[2], v[3]}; *(f32x4*)(dpool + lane * 8 + 4) = (f32x4){v[4], v[5], v[6], v[7]};
    }
}

DI void pool_unit(ArgsP a, int l, int pu) {
    const int tid = ltid(), w = tid >> 6, lane = tid & 63, li = lane & 15, quad = lane >> 4;
    const bool smp = pu == 128; const int ntask = smp ? 8 : 16;
    const bf16_t* Z = (const bf16_t*)(a->ws + WS_Z);
    bf16_t* Mx = (bf16_t*)(a->ws + WS_MIXED);
    for (int task = w; task < ntask; task += 8) {
        const int mt = task >> 2, g = task & 3, wlen = 2 << g;
        const int rbase = (smp ? NTP : pu * 64) + mt * 16;
        const int r = rbase + li;
        const int t = smp ? (r - NTP) % DS : r % SEQ, bs = smp ? (r - NTP) / DS : 0;
        f32x4 acc[8];
#pragma unroll
        for (int nt = 0; nt < 8; ++nt) acc[nt] = (f32x4){0.f, 0.f, 0.f, 0.f};
        const float rc = 1.0f / (float)(smp ? wlen : (t + 1 < wlen ? t + 1 : wlen));
        const bf16_t* pw = (const bf16_t*)(a->ws + WS_PWT) + (size_t)(l * 4 + g) * 128 * 128 + (size_t)li * 128 + quad * 8;
#pragma unroll 1
        for (int kk = 0; kk < 4; ++kk) {
            const int c0 = g * 128 + kk * 32 + quad * 8;
            float s[8], cur[8];
#pragma unroll
            for (int e = 0; e < 8; ++e) { s[e] = 0.f; cur[e] = 0.f; }
            u32x4 wrow[16];
#pragma unroll
            for (int i = 0; i < 16; ++i) wrow[i] = (i < wlen && t - i >= 0) ? *(const u32x4*)(Z + (size_t)(r - i) * ZLD + ZBI + c0) : (u32x4){0u, 0u, 0u, 0u};
#pragma unroll
            for (int i = 0; i < 16; ++i) { if (i < wlen) {
                float x[8];
                if (t - i >= 0) unpack8(wrow[i], x);
                else if (smp) { const float* sp = a->in[I_SB] + (size_t)((l * DB + bs) * 15 + 15 + (t - i)) * 512 + c0;
                    const f32x4 x0 = *(const f32x4*)sp, x1 = *(const f32x4*)(sp + 4);
                    x[0] = x0[0]; x[1] = x0[1]; x[2] = x0[2]; x[3] = x0[3]; x[4] = x1[0]; x[5] = x1[1]; x[6] = x1[2]; x[7] = x1[3]; }
                else {
#pragma unroll
                    for (int e = 0; e < 8; ++e) x[e] = 0.f; }
#pragma unroll
                for (int e = 0; e < 8; ++e) { s[e] += x[e]; if (i == 0) cur[e] = x[e]; }
            } }
            const bf16x8 af = pack8(s[0] * rc - cur[0], s[1] * rc - cur[1], s[2] * rc - cur[2], s[3] * rc - cur[3], s[4] * rc - cur[4], s[5] * rc - cur[5], s[6] * rc - cur[6], s[7] * rc - cur[7]);
#pragma unroll
            for (int nt = 0; nt < 8; ++nt) acc[nt] = mfma16(af, ld8(pw + (size_t)nt * 16 * 128 + kk * 32), acc[nt]);
        }
        const float* bsc = a->in[I_BSC] + l * 512 + g * 128;
#pragma unroll
        for (int nt = 0; nt < 8; ++nt) { const int col = nt * 16 + li; const float sc = bsc[col];
#pragma unroll
            for (int e = 0; e < 4; ++e) { const size_t row = (size_t)(rbase + quad * 4 + e);
                const float gate = siluf_(bf2f(Z[row * ZLD + ZBS + g * 128 + col]));
                Mx[row * DM + 1024 + g * 128 + col] = f2bf(acc[nt][e] * sc * gate); } }
    }
}

DI void cmp_prompt_unit(ArgsP a, LAS unsigned char* lds, int l, int u) {
    const int tid = ltid(), w = tid >> 6, lane = tid & 63, li = lane & 15, quad = lane >> 4;
    const int kv = u >> 6, g = (u >> 4) & 3, b = g >> 1, kvh = g & 1, i0 = (u & 15) * 16, grp = l * 2 + kv;
    LAS float* part = (LAS float*)lds; LAS bf16_t* hid = (LAS bf16_t*)(lds + 131072); LAS float* ssq = (LAS float*)(lds + 131072 + 16 * 264 * 2);
    {
        const bf16_t* zp = (const bf16_t*)(a->ws + WS_Z) + (size_t)(b * SEQ + 16 * (i0 + li) + 4 * w) * ZLD + ZKV + kv * 256 + kvh * 128 + quad * 8;
        const bf16_t* w1 = (const bf16_t*)(a->ws + WS_W1T) + (size_t)grp * 256 * 4096 + (size_t)li * 4096 + 512 * w + quad * 8;
        f32x4 acc[16];
#pragma unroll
        for (int nt = 0; nt < 16; ++nt) acc[nt] = (f32x4){0.f, 0.f, 0.f, 0.f};
#pragma unroll 2
        for (int kk = 0; kk < 16; ++kk) { const bf16x8 af = ld8(zp + (size_t)(kk >> 2) * ZLD + (kk & 3) * 32);
#pragma unroll
            for (int nt = 0; nt < 16; ++nt) acc[nt] = mfma16(af, ld8(w1 + (size_t)nt * 16 * 4096 + kk * 32), acc[nt]); }
#pragma unroll
        for (int nt = 0; nt < 16; ++nt)
#pragma unroll
            for (int e = 0; e < 4; ++e) part[(w * 16 + quad * 4 + e) * 256 + nt * 16 + li] = acc[nt][e];
    }
    __syncthreads();
    { const float* cb = (const float*)(a->ws + WS_CBIAS) + grp * 256;
      for (int x = tid; x < 4096; x += 512) { const int row = x >> 8, h = x & 255; float s = cb[h];
#pragma unroll
          for (int ww = 0; ww < 8; ++ww) s += part[(ww * 16 + row) * 256 + h];
          hid[row * 264 + h] = f2bf(gelu_tanh(s)); } }
    __syncthreads();
    f32x4 acc2 = {0.f, 0.f, 0.f, 0.f};
    { const bf16_t* w2 = (const bf16_t*)(a->ws + WS_W2T) + (size_t)grp * 128 * 256 + (size_t)(w * 16 + li) * 256 + quad * 8;
      bf16x8 w2f[8];
#pragma unroll
      for (int kk = 0; kk < 8; ++kk) w2f[kk] = ld8(w2 + kk * 32);
#pragma unroll
      for (int kk = 0; kk < 8; ++kk) acc2 = mfma16(*(const LAS bf16x8*)(hid + li * 264 + kk * 32 + quad * 8), w2f[kk], acc2); }
    const int n = w * 16 + li;
    { const float bb = a->in[I_B2][grp * 128 + n];
#pragma unroll
      for (int e = 0; e < 4; ++e) acc2[e] += bb; }
    if (kv == 0) {
#pragma unroll
        for (int e = 0; e < 4; ++e) { float s = acc2[e] * acc2[e]; s += __shfl_xor(s, 1); s += __shfl_xor(s, 2); s += __shfl_xor(s, 4); s += __shfl_xor(s, 8);
            if (li == 0) ssq[w * 16 + quad * 4 + e] = s; }
        __syncthreads();
        const float gg = a->in[I_AKN][(size_t)l * 3 * 128 + n];
        bf16_t* kc = (bf16_t*)(a->ws + WS_KCP) + (size_t)(g * 256 + i0) * 128;
#pragma unroll
        for (int e = 0; e < 4; ++e) { const int row = quad * 4 + e; float tot = 0.f;
#pragma unroll
            for (int ww = 0; ww < 8; ++ww) tot += ssq[ww * 16 + row];
            const float inv = rsqrtf(tot * (1.0f / 128.0f) + EPS);
            kc[(size_t)row * 128 + n] = (i0 + row < NC_P) ? f2bf(acc2[e] * inv * gg) : (bf16_t)0; }
    } else {
        bf16_t* vc = (bf16_t*)(a->ws + WS_VCPT) + (size_t)(g * 256 + i0) * 128;
#pragma unroll
        for (int e = 0; e < 4; ++e) { const int row = quad * 4 + e; vc[(size_t)row * 128 + n] = (i0 + row < NC_P) ? f2bf(acc2[e]) : (bf16_t)0; }
    }
    __syncthreads();
}

DI void score_sample_unit(ArgsP a, LAS unsigned char* lds, int l, int u) {
    const int tid = ltid(), b = u / 33, ch = u % 33;
    LAS float* qi = (LAS float*)lds; LAS float* wi = qi + 1024;
    const bf16_t* Z = (const bf16_t*)(a->ws + WS_Z); const float* Zs = (const float*)(a->ws + WS_ZS);
    for (int i = tid; i < 1024; i += 512) qi[i] = bf2f(Z[(size_t)(NTP + b * DS + (i >> 8)) * ZLD + ZIQ + (i & 255)]);
    if (tid < 16) wi[tid] = Zs[(size_t)(NTP + b * DS + (tid >> 2)) * ZSLD + ZS_IW + (tid & 3)];
    __syncthreads();
    const int s = ch * 512 + tid;
    if (s < PAST + DS) {
        const float* kp = (s < PAST) ? a->in[I_CI] + ((size_t)(l * NPOOL + a->page_table[b * NPAGES + (s >> 7)]) * PAGE + (s & 127)) * 64
                                     : Zs + (size_t)(NTP + b * DS + (s - PAST)) * ZSLD + ZS_IK;
        f32x4 k[16];
#pragma unroll
        for (int i = 0; i < 16; ++i) k[i] = *(const f32x4*)(kp + i * 4);
        float* sc = (float*)(a->ws + WS_SCORES);
#pragma unroll 1
        for (int tt = 0; tt < 4; ++tt) {
            float tot = 0.f;
#pragma unroll
            for (int hh = 0; hh < 4; ++hh) { float d = 0.f;
#pragma unroll
                for (int i = 0; i < 16; ++i) { const f32x4 q = *(const LAS f32x4*)(qi + (tt * 4 + hh) * 64 + i * 4); d += q[0] * k[i][0] + q[1] * k[i][1] + q[2] * k[i][2] + q[3] * k[i][3]; }
                tot += wi[tt * 4 + hh] * fmaxf(d, 0.f); }
            if (tot == 0.f) tot = 0.f;
            if (s >= PAST && s - PAST > tt) tot = -INFINITY;
            sc[(size_t)(b * DS + tt) * SCORE_LD + s] = tot;
        }
    }
    __syncthreads();
}

DI void copy_unit(ArgsP a, int l, int cu) {
    const int tid = ltid(), b = cu >> 3, part = cu & 7;
    { const f32x4* src = (const f32x4*)(a->in[I_SW] + (size_t)((l * DB + b) * 512 + 4) * 512); f32x4* dst = (f32x4*)(a->out + O_AWS + (size_t)((l * DB + b) * 512) * 512);
      for (int i0 = part * 8128 + tid; i0 < (part + 1) * 8128; i0 += 4096) { f32x4 v[8];
#pragma unroll
          for (int k = 0; k < 8; ++k) { const int i = i0 + 512 * k; v[k] = i < (part + 1) * 8128 ? src[i] : (f32x4){0.f, 0.f, 0.f, 0.f}; }
#pragma unroll
          for (int k = 0; k < 8; ++k) { const int i = i0 + 512 * k; if (i < (part + 1) * 8128) dst[i] = v[k]; } } }
    if (part == 0) { const f32x4* src = (const f32x4*)(a->in[I_SB] + (size_t)((l * DB + b) * 15 + 4) * 512); f32x4* dst = (f32x4*)(a->out + O_BPS + (size_t)((l * DB + b) * 15) * 512);
      f32x4 v[3];
#pragma unroll
      for (int k = 0; k < 3; ++k) { const int i = tid + 512 * k; v[k] = i < 1408 ? src[i] : (f32x4){0.f, 0.f, 0.f, 0.f}; }
#pragma unroll
      for (int k = 0; k < 3; ++k) { const int i = tid + 512 * k; if (i < 1408) dst[i] = v[k]; } }
}

constexpr int L3_CMP = 128, L3_SC = 8 * 33, L3_POOL = 129, L3_CP = 64, L3_ROWS = NTOK / 8;
constexpr int L3_TOTAL = L3_CMP + L3_SC + L3_POOL + L3_CP + L3_ROWS;
DI void l3_unit(ArgsP a, LAS unsigned char* lds, int l, int u) {
    if (u < L3_CMP) { cmp_prompt_unit(a, lds, l, u); return; } u -= L3_CMP;
    if (u < L3_SC) { score_sample_unit(a, lds, l, u); return; } u -= L3_SC;
    if (u < L3_POOL) { pool_unit(a, l, u); return; } u -= L3_POOL;
    if (u < L3_CP) { copy_unit(a, l, u); return; } u -= L3_CP;
    l3_row(a, l, u * 8 + (ltid() >> 6), ltid() & 63);
}

struct AttnState { float l; f32x4 o[8]; };
DI void attn_init(AttnState& s) { s.l = 0.f;
#pragma unroll
    for (int dt = 0; dt < 8; ++dt) s.o[dt] = (f32x4){0.f, 0.f, 0.f, 0.f}; }
DI float softmax_shift(const bf16x8 (&qf)[4], float gmax, float bmax) {
    float ss = 0.f;
#pragma unroll
    for (int kk = 0; kk < 4; ++kk)
#pragma unroll
        for (int e = 0; e < 8; ++e) { const float x = bf2f((bf16_t)qf[kk][e]); ss += x * x; }
    ss += __shfl_xor(ss, 16); ss += __shfl_xor(ss, 32);
    return QK_SCALE2 * sqrtf(ss) * 11.3137085f * gmax + bmax;
}
struct NoHook { DI void operator()(const float (&)[8]) const {} };
template <class KF, class VF, class MB, class PH = NoHook>
DI void attn_tile32(AttnState& st, const bf16x8 (&qf)[4], KF kf, VF vf, MB mb, PH ph = PH()) {
    bf16x8 ka[2][4];
#pragma unroll
    for (int sub = 0; sub < 2; ++sub)
#pragma unroll
        for (int kk = 0; kk < 4; ++kk) ka[sub][kk] = kf(sub, kk);
    s16x4 va[8][2];
#pragma unroll
    for (int dt = 0; dt < 8; ++dt) { va[dt][0] = vf(dt, 0); va[dt][1] = vf(dt, 1); }
    f32x4 s0 = {0.f, 0.f, 0.f, 0.f}, s1 = {0.f, 0.f, 0.f, 0.f};
#pragma unroll
    for (int kk = 0; kk < 4; ++kk) { s0 = mfma16(ka[0][kk], qf[kk], s0); s1 = mfma16(ka[1][kk], qf[kk], s1); }
    float p[8];
#pragma unroll
    for (int e = 0; e < 4; ++e) { p[e] = fexp2(mb(0, e, s0[e])); p[4 + e] = fexp2(mb(1, e, s1[e])); }
    st.l += ((p[0] + p[1]) + (p[2] + p[3])) + ((p[4] + p[5]) + (p[6] + p[7]));
    ph(p);
    const bf16x8 pb = pack8(p[0], p[1], p[2], p[3], p[4], p[5], p[6], p[7]);
#pragma unroll
    for (int dt = 0; dt < 8; ++dt) st.o[dt] = mfma16(__builtin_shufflevector(va[dt][0], va[dt][1], 0, 1, 2, 3, 4, 5, 6, 7), pb, st.o[dt]);
}
DI void attn_finish(AttnState& st) {
    float l = st.l; l += __shfl_xor(l, 16); l += __shfl_xor(l, 32);
    const float inv = 1.0f / fmaxf(l, 1e-30f);
#pragma unroll
    for (int dt = 0; dt < 8; ++dt) st.o[dt] *= inv;
}
DI s16x4 lds_tr(const LAS bf16_t* p) { return __builtin_amdgcn_ds_read_tr16_b64_v4i16((LAS s16x4*)p); }
constexpr int KVP = 144;
constexpr int VP = 144;

constexpr int NSA_KS = 0, NSA_VS = 2 * 64 * KVP * 2, NSA_PSUM = NSA_VS + 2 * 64 * VP * 2, NSA_BIAS = NSA_PSUM + 32 * 256 * 4, NSA_WN = NSA_BIAS + 2304;
template <class NEED, class HALFOK, class FAR, class MBF, class MB>
DI void nsa_run_blocks(LAS unsigned char* lds, unsigned long long blockmask, const bf16_t* kbase, const bf16_t* vbase, AttnState& st, const bf16x8 (&qf)[4], int tid, NEED need, HALFOK halfok, FAR isfar, MBF mbfar, MB mb) {
    const int lane = tid & 63, li = lane & 15, quad = lane >> 4;
    LAS bf16_t* Ks = (LAS bf16_t*)(lds + NSA_KS); LAS bf16_t* Vs = (LAS bf16_t*)(lds + NSA_VS);
    const int r0 = tid >> 4, ch = tid & 15;
    u32x4 krA[2], vrA[2];
    unsigned long long cm = blockmask, lm = blockmask;
    int buf = 0;
    auto request = [&](u32x4 (&kr)[2], u32x4 (&vr)[2]) {
        if (lm) { const int jn = __builtin_ctzll(lm); lm &= lm - 1;
#pragma unroll
            for (int i = 0; i < 2; ++i) { const size_t ro = (size_t)(jn * 64 + r0 + i * 32) * ZLD + ch * 8; kr[i] = *(const u32x4*)(kbase + ro); vr[i] = *(const u32x4*)(vbase + ro); } } };
    auto step = [&](u32x4 (&kr)[2], u32x4 (&vr)[2]) {
        const int j = __builtin_ctzll(cm); cm &= cm - 1;
#pragma unroll
        for (int i = 0; i < 2; ++i) { *(LAS u32x4*)(Ks + (buf * 64 + r0 + i * 32) * KVP + ch * 8) = kr[i]; *(LAS u32x4*)(Vs + (buf * 64 + r0 + i * 32) * VP + ch * 8) = vr[i]; }
        __syncthreads();
        request(kr, vr);
        if (need(j)) {
#pragma unroll
            for (int half = 0; half < 2; ++half) {
                if (halfok(j, half)) {
                    const LAS bf16_t* kt = Ks + (buf * 64 + half * 32) * KVP; const LAS bf16_t* vt = Vs + (buf * 64 + half * 32) * VP;
                    auto kfr = [&](int sub, int kk) { return *(const LAS bf16x8*)(kt + (sub * 16 + li) * KVP + kk * 32 + quad * 8); };
                    auto vfr = [&](int dt, int sub) { return lds_tr(vt + (sub * 16 + quad * 4 + (li >> 2)) * VP + dt * 16 + (li & 3) * 4); };
                    if (isfar(j, half)) { const float off = mbfar(j); attn_tile32(st, qf, kfr, vfr, [&](int sub, int e, float raw) { return raw * QK_SCALE2 + off; }); }
                    else attn_tile32(st, qf, kfr, vfr, [&](int sub, int e, float raw) { return mb(j * 64 + half * 32 + sub * 16 + quad * 4 + e, j, raw); });
                }
            }
        }
        buf ^= 1; };
    request(krA, vrA);
    while (cm) step(krA, vrA);
    __syncthreads();
}

DI void nsa_prompt_unit(ArgsP a, LAS unsigned char* lds, int l, int u) {
    const int tid = ltid(), w = tid >> 6, lane = tid & 63, li = lane & 15, quad = lane >> 4;
    const int b = u >> 8, kvh = (u >> 7) & 1, qt = u & 127, t0 = qt * 32;
    const int qi = li >> 2, g = li & 3, h = kvh * 4 + g;
    const int tq0 = t0 + 4 * w, t = tq0 + qi;
    const size_t row = (size_t)b * SEQ + t;
    const bf16_t* Z = (const bf16_t*)(a->ws + WS_Z);
    LAS float* biasL = (LAS float*)(lds + NSA_BIAS); LAS float* psum = (LAS float*)(lds + NSA_PSUM); LAS unsigned long long* wn = (LAS unsigned long long*)(lds + NSA_WN);
    { const float* bt = (const float*)(a->ws + WS_BIAS);
      for (int i = tid; i < 129 * 4; i += 512) biasL[i] = bt[(i >> 2) * 8 + kvh * 4 + (i & 3)]; }
    __syncthreads();
    bf16x8 qf[4];
#pragma unroll
    for (int kk = 0; kk < 4; ++kk) qf[kk] = ld8(Z + row * ZLD + ZQ + h * 128 + kk * 32 + quad * 8);
    const float* zg = (const float*)(a->ws + WS_ZS) + row * ZSLD + ZS_GATE;
    const float gate0 = sigmoidf_(zg[h]), gate1 = sigmoidf_(zg[8 + h]), gate2 = sigmoidf_(zg[16 + h]);
    const float* bx = (const float*)(a->ws + WS_BIAS) + 1600;
    const float bmaxA = ldu(bx + 8);
    const float shC = softmax_shift(qf, ldu(bx + l * 4 + 0), bmaxA), shS = softmax_shift(qf, ldu(bx + l * 4 + 1), bmaxA), shW = softmax_shift(qf, ldu(bx + l * 4 + 2), bmaxA);
    const float b31 = biasL[128 * 4 + g];
    f32x4 otot[8];
    {
        const int nvw = (tq0 + 3 >= 31) ? ((tq0 + 3 - 31) >> 4) + 1 : 0;
        const int nvu = (t0 + 31 >= 31) ? ((t0 + 31 - 31) >> 4) + 1 : 0;
        const bf16_t* Kc = (const bf16_t*)(a->ws + WS_KCP) + (size_t)((b * 2 + kvh) * 256) * 128;
        const bf16_t* Vc = (const bf16_t*)(a->ws + WS_VCPT) + (size_t)((b * 2 + kvh) * 256) * 128;
        LAS bf16_t* Ks = (LAS bf16_t*)(lds + NSA_KS); LAS bf16_t* Vs = (LAS bf16_t*)(lds + NSA_VS);
        const int r0 = tid >> 4, ch = tid & 15;
        u32x4 kr[4][2], vr[4][2];
#pragma unroll
        for (int jb = 0; jb < 4; ++jb) if (jb * 64 < nvu) {
#pragma unroll
            for (int i = 0; i < 2; ++i) { const size_t ro = (size_t)(jb * 64 + r0 + i * 32) * 128 + ch * 8; kr[jb][i] = *(const u32x4*)(Kc + ro); vr[jb][i] = *(const u32x4*)(Vc + ro); } }
        float sc[16][4];
#pragma unroll
        for (int i = 0; i < 16; ++i)
#pragma unroll
            for (int e = 0; e < 4; ++e) sc[i][e] = 0.f;
        AttnState stc; attn_init(stc);
#pragma unroll
        for (int jb = 0; jb < 4; ++jb) if (jb * 64 < nvu) {
            const int buf = jb & 1;
#pragma unroll
            for (int i = 0; i < 2; ++i) { *(LAS u32x4*)(Ks + (buf * 64 + r0 + i * 32) * KVP + ch * 8) = kr[jb][i]; *(LAS u32x4*)(Vs + (buf * 64 + r0 + i * 32) * VP + ch * 8) = vr[jb][i]; }
            __syncthreads();
#pragma unroll
            for (int half = 0; half < 2; ++half) if (jb * 64 + half * 32 < nvw) {
                const LAS bf16_t* kt = Ks + (buf * 64 + half * 32) * KVP; const LAS bf16_t* vt = Vs + (buf * 64 + half * 32) * VP;
                attn_tile32(stc, qf,
                    [&](int sub, int kk) { return *(const LAS bf16x8*)(kt + (sub * 16 + li) * KVP + kk * 32 + quad * 8); },
                    [&](int dt, int sub) { return lds_tr(vt + (sub * 16 + quad * 4 + (li >> 2)) * VP + dt * 16 + (li & 3) * 4); },
                    [&](int sub, int e, float raw) { const int rel = t - (16 * (jb * 64 + half * 32 + sub * 16 + quad * 4 + e) + 31);
                        const float v = raw * QK_SCALE2 + biasL[(rel < 0 ? 0 : (rel < 128 ? rel : 128)) * 4 + g] - shC; return rel >= 0 ? v : -INFINITY; },
                    [&](const float (&p)[8]) {
#pragma unroll
                        for (int e = 0; e < 4; ++e) { sc[jb * 4 + half * 2][e] = p[e]; sc[jb * 4 + half * 2 + 1][e] = p[4 + e]; } });
            }
        }
        __syncthreads();
        float ls = stc.l; ls += __shfl_xor(ls, 16); ls += __shfl_xor(ls, 32);
        const float inv = 1.0f / fmaxf(ls, 1e-30f);
#pragma unroll
        for (int sub = 0; sub < 16; ++sub) {
            f32x4 hs;
#pragma unroll
            for (int e = 0; e < 4; ++e) { float x = sc[sub][e] * inv; x += dpp_xor1(x); x += dpp_xor2(x); hs[e] = x; }
            if (g == 0) *(LAS f32x4*)(psum + (w * 4 + qi) * 256 + sub * 16 + quad * 4) = hs;
        }
#pragma unroll
        for (int dt = 0; dt < 8; ++dt) otot[dt] = stc.o[dt] * (inv * gate0);
    }
    unsigned long long mymask = 0ull, need = 0ull;
#pragma unroll
    for (int qq = 0; qq < 4; ++qq) {
        const int tq = tq0 + qq, cur = tq >> 6, j = lane;
        const LAS float* ps = psum + (w * 4 + qq) * 256;
        const f32x4 v4 = *(const LAS f32x4*)(ps + 4 * j);
        const float pm1 = j > 0 ? ps[4 * j - 1] : 0.f;
        const float imp = pm1 + 2.0f * (v4[0] + v4[1] + v4[2]) + v4[3];
        const bool vis = j <= cur, forced = (j == 0) || (j == cur) || (j == cur - 1);
        const float val = vis ? (forced ? 1e6f : imp) : -INFINITY;
        int rank = 0;
        for (int jj = 0; jj < 64; ++jj) { const float vj = __builtin_bit_cast(float, __builtin_amdgcn_readlane(__builtin_bit_cast(int, val), jj)); rank += (vj > val || (vj == val && jj < j)) ? 1 : 0; }
        const unsigned long long mk = __ballot(vis && rank < 16);
        need |= mk; if (qi == qq) mymask = mk;
    }
    if (lane == 0) wn[w] = need;
    __syncthreads();
    unsigned long long bm = 0ull;
#pragma unroll
    for (int i = 0; i < 8; ++i) bm |= wn[i];
    {
        AttnState st; attn_init(st);
        const bf16_t* kb = Z + (size_t)b * SEQ * ZLD + ZKV + 2 * 256 + kvh * 128;
        nsa_run_blocks(lds, bm, kb, kb + 256, st, qf, tid,
            [&](int j) { return ((need >> j) & 1ull) != 0ull; },
            [&](int j, int half) { return j * 64 + half * 32 <= tq0 + 3; },
            [&](int j, int half) { return j * 64 + half * 32 + 31 + 128 <= tq0; },
            [&](int j) { return ((mymask >> j) & 1ull) ? b31 - shS : -INFINITY; },
            [&](int kp, int j, float raw) { const int rel = t - kp; const float v = raw * QK_SCALE2 + biasL[(rel < 0 ? 0 : (rel < 128 ? rel : 128)) * 4 + g] - shS; return (((mymask >> j) & 1ull) && rel >= 0) ? v : -INFINITY; });
        attn_finish(st);
#pragma unroll
        for (int dt = 0; dt < 8; ++dt) otot[dt] += st.o[dt] * gate1;
    }
    {
        AttnState st; attn_init(st);
        const int jlo = (t0 >= 512 ? t0 - 512 : 0) >> 6, jhi = (t0 + 31) >> 6;
        const unsigned long long wm = (jhi >= 63 ? ~0ull : ((1ull << (jhi + 1)) - 1ull)) & ~((1ull << jlo) - 1ull);
        const bf16_t* kb = Z + (size_t)b * SEQ * ZLD + ZKV + 4 * 256 + kvh * 128;
        nsa_run_blocks(lds, wm, kb, kb + 256, st, qf, tid,
            [&](int j) { return j * 64 + 63 >= tq0 - 512 && j * 64 <= tq0 + 3; },
            [&](int j, int half) { const int k0 = j * 64 + half * 32; return k0 + 31 >= tq0 - 512 && k0 <= tq0 + 3; },
            [&](int j, int half) { const int k0 = j * 64 + half * 32; return k0 + 31 + 128 <= tq0 && k0 >= tq0 + 3 - 512; },
            [&](int j) { return b31 - shW; },
            [&](int kp, int j, float raw) { const int rel = t - kp; const float v = raw * QK_SCALE2 + biasL[(rel < 0 ? 0 : (rel < 128 ? rel : 128)) * 4 + g] - shW; return (rel >= 0 && rel <= 512) ? v : -INFINITY; });
        attn_finish(st);
#pragma unroll
        for (int dt = 0; dt < 8; ++dt) otot[dt] += st.o[dt] * gate2;
    }
    { bf16_t* mx = (bf16_t*)(a->ws + WS_MIXED) + row * DM + h * 128; const bf16_t* sg = Z + row * ZLD + ZAS + h * 128;
#pragma unroll
      for (int dt = 0; dt < 8; ++dt) { const int d = dt * 16 + quad * 4; const u32x2 sw = *(const u32x2*)(sg + d);
          u32x2 o; o.x = pk2(otot[dt][0] * siluf_(lo2f(sw.x)), otot[dt][1] * siluf_(hi2f(sw.x))); o.y = pk2(otot[dt][2] * siluf_(lo2f(sw.y)), otot[dt][3] * siluf_(hi2f(sw.y)));
          *(u32x2*)(mx + d) = o; } }
    __syncthreads();
}

DI unsigned fkey(float f) { const unsigned u = __float_as_uint(f); return (u & 0x80000000u) ? ~u : (u | 0x80000000u); }
DI void wave_topk256(const LAS float* sc, int n, LAS unsigned* hist, LAS int* idx, int lane) {
    unsigned prefix = 0u; int kth = 256;
#pragma unroll 1
    for (int pass = 3; pass >= 0; --pass) {
        const int shift = pass * 8;
        *(LAS u32x4*)(hist + lane * 4) = (u32x4){0u, 0u, 0u, 0u};
        for (int i = lane; i < n; i += 64) { const unsigned u = fkey(sc[i]);
            if (pass == 3 || (u >> (shift + 8)) == prefix) (void)__hip_atomic_fetch_add(hist + ((u >> shift) & 255u), 1u, __ATOMIC_RELAXED, __HIP_MEMORY_SCOPE_WORKGROUP); }
        const u32x4 c = *(const LAS u32x4*)(hist + lane * 4);
        const int tot = (int)(c.x + c.y + c.z + c.w);
        int incl = tot;
#pragma unroll
        for (int o = 1; o < 64; o <<= 1) { const int t2 = __shfl_down(incl, o); if (lane + o < 64) incl += t2; }
        const int a3 = incl - tot, a2 = a3 + (int)c.w, a1 = a2 + (int)c.z, a0 = a1 + (int)c.y;
        int which = -1, ab = 0;
        if (a3 < kth && kth <= a3 + (int)c.w) { which = 3; ab = a3; }
        else if (a2 < kth && kth <= a2 + (int)c.z) { which = 2; ab = a2; }
        else if (a1 < kth && kth <= a1 + (int)c.y) { which = 1; ab = a1; }
        else if (a0 < kth && kth <= a0 + (int)c.x) { which = 0; ab = a0; }
        const unsigned long long hb = __ballot(which >= 0);
        const int src = hb ? __builtin_ctzll(hb) : 0;
        const int dg = __shfl(lane * 4 + which, src), nk = __shfl(kth - ab, src);
        prefix = (prefix << 8) | (unsigned)dg; kth = nk;
    }
    int cnt = 0, ce = 0;
    for (int base = 0; base < n; base += 64) {
        const int i = base + lane; const bool valid = i < n;
        const unsigned u = valid ? fkey(sc[i]) : 0u;
        const bool gt = valid && u > prefix, eq = valid && u == prefix;
        const unsigned long long eqb = __ballot(eq);
        const int eqrank = ce + __builtin_popcountll(eqb & ((1ull << lane) - 1ull));
        const bool take = gt || (eq && eqrank < kth);
        const unsigned long long tb = __ballot(take);
        if (take) idx[cnt + __builtin_popcountll(tb & ((1ull << lane) - 1ull))] = i;
        cnt += __builtin_popcountll(tb); ce += __builtin_popcountll(eqb);
    }
}

DI bool scan_bins(LAS unsigned* hist, int lane, int target, int& B, int& above, int& C) {
    const u32x4 c = *(const LAS u32x4*)(hist + lane * 4);
    const int tot = (int)(c.x + c.y + c.z + c.w);
    const int pre = wave_incl_scan_dpp(tot, lane);
    const int a3 = __builtin_amdgcn_readlane(pre, 63) - pre, a2 = a3 + (int)c.w, a1 = a2 + (int)c.z, a0 = a1 + (int)c.y;
    int which = -1, ab = 0, cc = 0;
    if (a3 < target && target <= a3 + (int)c.w) { which = 3; ab = a3; cc = (int)c.w; }
    else if (a2 < target && target <= a2 + (int)c.z) { which = 2; ab = a2; cc = (int)c.z; }
    else if (a1 < target && target <= a1 + (int)c.y) { which = 1; ab = a1; cc = (int)c.y; }
    else if (a0 < target && target <= a0 + (int)c.x) { which = 0; ab = a0; cc = (int)c.x; }
    const unsigned long long hb = __ballot(which >= 0);
    if (!hb) return false;
    const int src = __builtin_ctzll(hb);
    B = __builtin_amdgcn_readlane(lane * 4 + which, src); above = __builtin_amdgcn_readlane(ab, src); C = __builtin_amdgcn_readlane(cc, src);
    return true;
}
DI void take_candidates(const LAS int* cand, const LAS float* candv, int C, int r, LAS int* idx, int out, int lane) {
    for (int k0 = 0; k0 < C; k0 += 64) {
        const int k = k0 + lane; const bool have = k < C;
        const int myi = have ? cand[k] : 0; const float myv = have ? candv[k] : 0.f;
        int rank = 0;
#pragma unroll 4
        for (int j = 0; j < C; ++j) { const int oi = cand[j]; const float ov = candv[j]; rank += (ov > myv || (ov == myv && oi < myi)) ? 1 : 0; }
        const bool take = have && rank < r;
        const unsigned long long tb = __ballot(take);
        if (take) idx[out + __builtin_popcountll(tb & ((1ull << lane) - 1ull))] = myi;
        out += __builtin_popcountll(tb);
    }
}
DI void wave_topk256_lin(const LAS float* sc, int n, LAS unsigned* hist, LAS int* idx, int lane) {
    const int ng = (n + 511) >> 9, lim = n - lane;
    float lo = INFINITY, hi = -INFINITY;
#pragma unroll 1
    for (int g = 0; g < ng; ++g) {
#pragma unroll
        for (int k = 0; k < 8; ++k) { const int i = g * 8 + k; const float x = sc[i * 64 + lane]; const bool ok = i * 64 < lim; hi = fmaxf(hi, ok ? x : -INFINITY); lo = fminf(lo, ok ? x : INFINITY); } }
    hi = wave_max_dpp(hi); lo = wave_min_dpp(lo);
    const float scale = hi > lo ? 255.0f / (hi - lo) : 0.f;
    *(LAS u32x4*)(hist + lane * 4) = (u32x4){0u, 0u, 0u, 0u};
#pragma unroll 1
    for (int g = 0; g < ng; ++g) {
#pragma unroll
        for (int k = 0; k < 8; ++k) { const int i = g * 8 + k; const float x = sc[i * 64 + lane]; int bn = (int)((x - lo) * scale); bn = bn > 255 ? 255 : (bn < 0 ? 0 : bn);
            if (i * 64 < lim) (void)__hip_atomic_fetch_add(hist + bn, 1u, __ATOMIC_RELAXED, __HIP_MEMORY_SCOPE_WORKGROUP); } }
    int B = 0, above = 0, C = 0;
    if (!scan_bins(hist, lane, 256, B, above, C) || C > 128) { wave_topk256(sc, n, hist, idx, lane); return; }
    LAS int* cand = (LAS int*)hist; LAS float* candv = (LAS float*)hist + 128;
    unsigned long long upm = 0ull, eqm = 0ull;
#pragma unroll 1
    for (int g = 0; g < ng; ++g) { unsigned ub8 = 0u, eb8 = 0u;
#pragma unroll
        for (int k = 0; k < 8; ++k) { const int i = g * 8 + k; const float x = sc[i * 64 + lane]; int bn = (int)((x - lo) * scale); bn = bn > 255 ? 255 : (bn < 0 ? 0 : bn);
            const bool ok = i * 64 < lim; ub8 |= (ok && bn > B) ? (1u << k) : 0u; eb8 |= (ok && bn == B) ? (1u << k) : 0u; }
        upm |= (unsigned long long)ub8 << (g * 8); eqm |= (unsigned long long)eb8 << (g * 8); }
    const int packed = __builtin_popcountll(upm) | (__builtin_popcountll(eqm) << 16);
    const int incl = wave_incl_scan_dpp(packed, lane);
    int ub = (incl - packed) & 0xffff, eb = (incl - packed) >> 16;
    while (upm) { const int i = __builtin_ctzll(upm); upm &= upm - 1; idx[ub++] = i * 64 + lane; }
    while (eqm) { const int i = __builtin_ctzll(eqm); eqm &= eqm - 1; const int e = i * 64 + lane; cand[eb] = e; candv[eb] = sc[e]; ++eb; }
    take_candidates(cand, candv, C, 256 - above, idx, above, lane);
}
DI void wave_topk256_fast(const LAS float* sc, int n, LAS unsigned* hist, LAS int* idx, int lane) {
    if (n <= 1024) { wave_topk256_lin(sc, n, hist, idx, lane); return; }
    unsigned long long m = 0ull; int P;
    {
        float xs[8];
#pragma unroll
        for (int k = 0; k < 8; ++k) xs[k] = sc[k * 64 + lane];
        float lo = xs[0], hi = xs[0];
#pragma unroll
        for (int k = 1; k < 8; ++k) { lo = fminf(lo, xs[k]); hi = fmaxf(hi, xs[k]); }
        hi = wave_max_dpp(hi); lo = wave_min_dpp(lo);
        const float scale = hi > lo ? 255.0f / (hi - lo) : 0.f, off = -lo * scale;
        *(LAS u32x4*)(hist + lane * 4) = (u32x4){0u, 0u, 0u, 0u};
#pragma unroll
        for (int k = 0; k < 8; ++k) { int bn = (int)fmaf(xs[k], scale, off); bn = bn < 0 ? 0 : (bn > 255 ? 255 : bn);
            (void)__hip_atomic_fetch_add(hist + bn, 1u, __ATOMIC_RELAXED, __HIP_MEMORY_SCOPE_WORKGROUP); }
        const float es = 131072.0f / (float)n;
        int S = (int)es + (int)(3.5f * sqrtf(es)) + 3; S = S > 512 ? 512 : S;
        int Bs = 0, ab = 0, cs = 0;
        if (!scan_bins(hist, lane, S, Bs, ab, cs)) Bs = 0;
        const float thr = (float)Bs;
        const int ng = (n + 511) >> 9, lim = n - lane;
#pragma unroll 1
        for (int g = 0; g < ng; ++g) { unsigned b8 = 0u;
#pragma unroll
            for (int k = 0; k < 8; ++k) { const int i = g * 8 + k; const float x = sc[i * 64 + lane]; b8 |= (i * 64 < lim && fmaf(x, scale, off) >= thr) ? (1u << k) : 0u; }
            m |= (unsigned long long)b8 << (g * 8); }
        P = wave_sum_dpp(__builtin_popcountll(m));
    }
    if (P < 256 || __ballot(__builtin_popcountll(m) > 16) != 0ull) { wave_topk256_lin(sc, n, hist, idx, lane); return; }
    float sv[16]; int se[16];
    { unsigned long long mm = m;
#pragma unroll
      for (int k = 0; k < 16; ++k) { const bool have = mm != 0ull; const int i = have ? __builtin_ctzll(mm) : 0; mm &= mm - 1;
          const int e = i * 64 + lane; sv[k] = have ? sc[e] : -INFINITY; se[k] = have ? e : -1; } }
    float lo2 = INFINITY, hi2 = -INFINITY;
#pragma unroll
    for (int k = 0; k < 16; ++k) { hi2 = fmaxf(hi2, sv[k]); lo2 = fminf(lo2, se[k] >= 0 ? sv[k] : INFINITY); }
    hi2 = wave_max_dpp(hi2); lo2 = wave_min_dpp(lo2);
    const float scale2 = hi2 > lo2 ? 255.0f / (hi2 - lo2) : 0.f;
    *(LAS u32x4*)(hist + lane * 4) = (u32x4){0u, 0u, 0u, 0u};
    int bn[16];
#pragma unroll
    for (int k = 0; k < 16; ++k) { int b = (int)((sv[k] - lo2) * scale2); b = b > 255 ? 255 : (b < 0 ? 0 : b); bn[k] = se[k] >= 0 ? b : -1;
        if (se[k] >= 0) (void)__hip_atomic_fetch_add(hist + b, 1u, __ATOMIC_RELAXED, __HIP_MEMORY_SCOPE_WORKGROUP); }
    int B = 0, above = 0, C = 0;
    if (!scan_bins(hist, lane, 256, B, above, C) || C > 128) { wave_topk256_lin(sc, n, hist, idx, lane); return; }
    LAS int* cand = (LAS int*)hist; LAS float* candv = (LAS float*)hist + 128;
    int cu = 0, ce = 0;
#pragma unroll
    for (int k = 0; k < 16; ++k) { cu += bn[k] > B ? 1 : 0; ce += bn[k] == B ? 1 : 0; }
    const int packed = cu | (ce << 16);
    const int incl = wave_incl_scan_dpp(packed, lane);
    int ub = (incl - packed) & 0xffff, eb = (incl - packed) >> 16;
#pragma unroll
    for (int k = 0; k < 16; ++k) { if (bn[k] > B) idx[ub++] = se[k]; if (bn[k] == B) { cand[eb] = se[k]; candv[eb] = sv[k]; ++eb; } }
    take_candidates(cand, candv, C, 256 - above, idx, above, lane);
}

constexpr int DSA_SC = 0, DSA_IDX = 8 * 4096 * 4, DSA_HIST = DSA_IDX + 8 * 256 * 4, DSA_BIAS = DSA_HIST + 8 * 256 * 4;
DI void dsa_prompt_unit(ArgsP a, LAS unsigned char* lds, int l, int u) {
    const int tid = ltid(), w = tid >> 6, lane = tid & 63, li = lane & 15, quad = lane >> 4;
    const int b = u & 1, q8 = u >> 1, t0 = q8 * 8;
    const bf16_t* Z = (const bf16_t*)(a->ws + WS_Z); const float* Zs = (const float*)(a->ws + WS_ZS);
    LAS float* scores = (LAS float*)(lds + DSA_SC); LAS float* biasC = (LAS float*)(lds + DSA_BIAS);
    { const float* bt = (const float*)(a->ws + WS_BIAS) + 129 * 8;
      for (int i = tid; i < 129 * 4; i += 512) biasC[i] = bt[i]; }
    {
        const int qi = li >> 2, ih = li & 3;
        bf16x8 qfi[2][2]; float wi[2];
#pragma unroll
        for (int ct = 0; ct < 2; ++ct) { const size_t row = (size_t)b * SEQ + t0 + ct * 4 + qi;
#pragma unroll
            for (int kk = 0; kk < 2; ++kk) qfi[ct][kk] = ld8(Z + row * ZLD + ZIQ + ih * 64 + kk * 32 + quad * 8);
            wi[ct] = Zs[row * ZSLD + ZS_IW + ih]; }
        const bf16_t* kx = (const bf16_t*)(a->ws + WS_KIDXB) + (size_t)b * SEQ * 64;
        const int nsub = ((t0 + 7) >> 4) + 1;
        for (int sb = w; sb < nsub; sb += 64) {
          bf16x8 kq[8][2];
#pragma unroll
          for (int r = 0; r < 8; ++r) { const int sub = sb + 8 * r; if (sub < nsub) { kq[r][0] = ld8(kx + (size_t)(sub * 16 + li) * 64 + quad * 8); kq[r][1] = ld8(kx + (size_t)(sub * 16 + li) * 64 + 32 + quad * 8); } }
#pragma unroll
          for (int r = 0; r < 8; ++r) { const int sub = sb + 8 * r; if (sub < nsub) {
            const bf16x8 k0 = kq[r][0], k1 = kq[r][1];
#pragma unroll
            for (int ct = 0; ct < 2; ++ct) {
                f32x4 s = {0.f, 0.f, 0.f, 0.f};
                s = mfma16(k0, qfi[ct][0], s); s = mfma16(k1, qfi[ct][1], s);
                const int tq = t0 + ct * 4 + qi;
                f32x4 o;
#pragma unroll
                for (int e = 0; e < 4; ++e) { float x = fmaxf(s[e], 0.f) * wi[ct]; x += dpp_xor1(x); x += dpp_xor2(x); if (x == 0.f) x = 0.f;
                    o[e] = (sub * 16 + quad * 4 + e <= tq) ? x : -INFINITY; }
                if (ih == 0) *(LAS f32x4*)(scores + (ct * 4 + qi) * 4096 + sub * 16 + quad * 4) = o;
            }
          } }
        }
    }
    __syncthreads();
    const int t = t0 + w, n = t + 1;
    const size_t row = (size_t)b * SEQ + t;
    LAS int* idx = (LAS int*)(lds + DSA_IDX) + w * 256;
    bf16x8 qf[4];
#pragma unroll
    for (int kk = 0; kk < 4; ++kk) qf[kk] = ld8(Z + row * ZLD + ZCQ + (li & 3) * 128 + kk * 32 + quad * 8);
    int cnt;
    if (n <= 256) { for (int i = lane; i < 256; i += 64) idx[i] = i < n ? i : 0; cnt = n; }
    else { wave_topk256_fast(scores + w * 4096, n, (LAS unsigned*)(lds + DSA_HIST) + w * 256, idx, lane); cnt = 256;
#ifdef TOPK_SELFCHECK
        {
            long long s1 = 0, s2 = 0;
            for (int i = lane; i < 256; i += 64) { const long long e = idx[i]; s1 += e; s2 += e * e; }
            wave_topk256(scores + w * 4096, n, (LAS unsigned*)(lds + DSA_HIST) + w * 256, idx, lane);
            for (int i = lane; i < 256; i += 64) { const long long e = idx[i]; s1 -= e; s2 -= e * e; }
            for (int o = 1; o < 64; o <<= 1) { s1 += __shfl_xor(s1, o); s2 += __shfl_xor(s2, o); }
            if (s1 != 0 || s2 != 0) cnt = -1;
        }
#endif
    }
    {
        const int head = li & 3;
        LAS bf16_t* vst = (LAS bf16_t*)(lds + DSA_SC + w * 16384);
        const bf16_t* kvb = (const bf16_t*)(a->ws + WS_CKV) + (size_t)b * SEQ * 256;
        const float* bx = (const float*)(a->ws + WS_BIAS) + 1600;
        const float sh = softmax_shift(qf, ldu(bx + l * 4 + 3), ldu(bx + 9));
        AttnState st; attn_init(st);
        const int ntile = (cnt + 31) >> 5;
        const int grp = li >> 2;
        bf16x8 kn[2][4]; u32x4 vn[8];
        auto request_k = [&](int tp) {
            if (tp < ntile) { const LAS int* ix = idx + tp * 32;
                const bf16_t* kr0 = kvb + (size_t)ix[li] * 256 + quad * 8; const bf16_t* kr1 = kvb + (size_t)ix[16 + li] * 256 + quad * 8;
#pragma unroll
                for (int kk = 0; kk < 4; ++kk) { kn[0][kk] = ld8(kr0 + kk * 32); kn[1][kk] = ld8(kr1 + kk * 32); } } };
        auto request_v = [&](int tp) {
            if (tp < ntile) { const LAS int* ix = idx + tp * 32;
#pragma unroll
                for (int i = 0; i < 8; ++i) vn[i] = *(const u32x4*)(kvb + (size_t)ix[i * 4 + quad] * 256 + 128 + li * 8); } };
        request_k(0); request_v(0);
#pragma unroll 1
        for (int t4 = 0; t4 < ntile; t4 += 4) {
            f32x4 s0 = {0.f, 0.f, 0.f, 0.f}, s1 = {0.f, 0.f, 0.f, 0.f};
#pragma unroll
            for (int c = 0; c < 4; ++c) {
                bf16x8 kc[2][4];
#pragma unroll
                for (int kk = 0; kk < 4; ++kk) { kc[0][kk] = kn[0][kk]; kc[1][kk] = kn[1][kk]; }
                request_k(t4 + c + 1);
                f32x4 a0 = {0.f, 0.f, 0.f, 0.f}, a1 = {0.f, 0.f, 0.f, 0.f};
#pragma unroll
                for (int kk = 0; kk < 4; ++kk) { a0 = mfma16(kc[0][kk], qf[kk], a0); a1 = mfma16(kc[1][kk], qf[kk], a1); }
                if (grp == c) { s0 = a0; s1 = a1; }
            }
            const int tpo = t4 + grp;
            const LAS int* ixo = idx + tpo * 32;
            const u32x4 ip0 = *(const LAS u32x4*)(ixo + quad * 4), ip1 = *(const LAS u32x4*)(ixo + 16 + quad * 4);
            float p[8];
#pragma unroll
            for (int e = 0; e < 4; ++e) {
                { const int pos = tpo * 32 + quad * 4 + e, rel = t - (int)ip0[e];
                  const float v = s0[e] * QK_SCALE2 + biasC[(rel < 0 ? 0 : (rel < 128 ? rel : 128)) * 4 + head] - sh; p[e] = fexp2(pos < cnt ? v : -INFINITY); }
                { const int pos = tpo * 32 + 16 + quad * 4 + e, rel = t - (int)ip1[e];
                  const float v = s1[e] * QK_SCALE2 + biasC[(rel < 0 ? 0 : (rel < 128 ? rel : 128)) * 4 + head] - sh; p[4 + e] = fexp2(pos < cnt ? v : -INFINITY); } }
            st.l += ((p[0] + p[1]) + (p[2] + p[3])) + ((p[4] + p[5]) + (p[6] + p[7]));
            const bf16x8 pb = pack8(p[0], p[1], p[2], p[3], p[4], p[5], p[6], p[7]);
#pragma unroll
            for (int c = 0; c < 4; ++c) { if (t4 + c < ntile) {
#pragma unroll
                for (int i = 0; i < 8; ++i) *(LAS u32x4*)(vst + (i * 4 + quad) * VP + li * 8) = vn[i];
                request_v(t4 + c + 1);
                const bf16x8 pbc = (grp == c) ? pb : (bf16x8){0, 0, 0, 0, 0, 0, 0, 0};
#pragma unroll
                for (int dt = 0; dt < 8; ++dt) { const s16x4 v0 = lds_tr(vst + (quad * 4 + (li >> 2)) * VP + dt * 16 + (li & 3) * 4), v1 = lds_tr(vst + (16 + quad * 4 + (li >> 2)) * VP + dt * 16 + (li & 3) * 4);
                    st.o[dt] = mfma16(__builtin_shufflevector(v0, v1, 0, 1, 2, 3, 4, 5, 6, 7), pbc, st.o[dt]); }
            } }
        }
        {
            float lsum = st.l; lsum += __shfl_xor(lsum, 16); lsum += __shfl_xor(lsum, 32); lsum += __shfl_xor(lsum, 4); lsum += __shfl_xor(lsum, 8);
            const float inv = 1.0f / fmaxf(lsum, 1e-30f);
#pragma unroll
            for (int dt = 0; dt < 8; ++dt)
#pragma unroll
                for (int e2 = 0; e2 < 4; ++e2) { float o = st.o[dt][e2]; o += __shfl_xor(o, 4); o += __shfl_xor(o, 8); st.o[dt][e2] = o * inv; }
        }
#ifdef TOPK_SELFCHECK
        if (cnt < 0) {
#pragma unroll
            for (int dt = 0; dt < 8; ++dt) st.o[dt] = (f32x4){NAN, NAN, NAN, NAN}; }
#endif
        if (li < 4) { bf16_t* mx = (bf16_t*)(a->ws + WS_MIXED) + row * DM + 1536 + head * 128; const bf16_t* sg = Z + row * ZLD + ZCS + head * 128;
#pragma unroll
            for (int dt = 0; dt < 8; ++dt) { const int d = dt * 16 + quad * 4; const u32x2 sw = *(const u32x2*)(sg + d);
                u32x2 o; o.x = pk2(st.o[dt][0] * siluf_(lo2f(sw.x)), st.o[dt][1] * siluf_(hi2f(sw.x))); o.y = pk2(st.o[dt][2] * siluf_(lo2f(sw.y)), st.o[dt][3] * siluf_(hi2f(sw.y)));
                *(u32x2*)(mx + d) = o; } }
    }
    __syncthreads();
}

struct RowSrc { const float* f; const bf16_t* h; };
DI bf16x8 row8(const RowSrc r, int off) {
    if (r.f) return cvt8(r.f + off);
    if (r.h) return ld8(r.h + off);
    return (bf16x8){0, 0, 0, 0, 0, 0, 0, 0};
}
template <class RS> DI void stage_v32(LAS bf16_t* vst, RS rs, int li, int quad) {
#pragma unroll
    for (int i = 0; i < 8; ++i) { const int rr = i * 4 + quad; *(LAS bf16x8*)(vst + rr * VP + li * 8) = row8(rs(rr), li * 8); }
}
DI float merge_part(const LAS float* ml, const LAS float* opart, int w0, int nw, int ncol, int col, int d) {
    float L = 0.f, o = 0.f;
    for (int w = w0; w < w0 + nw; ++w) { L += ml[(w * 16 + col) * 2 + 1]; o += opart[(size_t)(w * ncol + col) * 128 + d]; }
    return o / fmaxf(L, 1e-30f);
}
DI void put_part(const AttnState& st, LAS float* ml, LAS float* opart, int w, int ncol, int li, int quad) {
    float l = st.l; l += __shfl_xor(l, 16); l += __shfl_xor(l, 32);
    if (li < ncol) { if (quad == 0) ml[(w * 16 + li) * 2 + 1] = l;
#pragma unroll
        for (int dt = 0; dt < 8; ++dt) *(LAS f32x4*)(opart + (size_t)(w * ncol + li) * 128 + dt * 16 + quad * 4) = st.o[dt]; }
}

constexpr int SN_BIAS = 0, SN_ML = 2304, SN_PSUM = 4096, SN_PLD = 1040, SN_ST = 24576, SN_SEL = SN_ST + 8 * 32 * VP * 2;
DI void nsa_sample_unit(ArgsP a, LAS unsigned char* lds, int l, int u) {
    const int tid = ltid(), w = tid >> 6, lane = tid & 63, li = lane & 15, quad = lane >> 4;
    const int b = u >> 1, kvh = u & 1;
    const bf16_t* Z = (const bf16_t*)(a->ws + WS_Z); const float* Zs = (const float*)(a->ws + WS_ZS);
    LAS float* biasL = (LAS float*)(lds + SN_BIAS); LAS float* ml = (LAS float*)(lds + SN_ML); LAS float* psum = (LAS float*)(lds + SN_PSUM);
    LAS float* opart = (LAS float*)(lds + SN_ST); LAS bf16_t* vst = (LAS bf16_t*)(lds + SN_ST) + w * 32 * VP; LAS int* sel = (LAS int*)(lds + SN_SEL);
    { const float* bt = (const float*)(a->ws + WS_BIAS);
      for (int i = tid; i < 129 * 4; i += 512) biasL[i] = bt[(i >> 2) * 8 + kvh * 4 + (i & 3)];
      for (int i = tid; i < 4 * SN_PLD; i += 512) psum[i] = 0.f; }
    __syncthreads();
    const int tt = li >> 2, g = li & 3, h = kvh * 4 + g, t = PAST + tt;
    const size_t row = (size_t)NTP + b * DS + tt;
    const int fc = tid >> 5, fd = (tid & 31) * 4;
    f32x4 fin = {0.f, 0.f, 0.f, 0.f};
    const float* fzg = Zs + ((size_t)NTP + b * DS + (fc >> 2)) * ZSLD + ZS_GATE + kvh * 4 + (fc & 3);
    const float fg0 = sigmoidf_(fzg[0]), fg1 = sigmoidf_(fzg[8]), fg2 = sigmoidf_(fzg[16]);
    bf16x8 qf[4];
#pragma unroll
    for (int kk = 0; kk < 4; ++kk) qf[kk] = ld8(Z + row * ZLD + ZQ + h * 128 + kk * 32 + quad * 8);
    const float* bx = (const float*)(a->ws + WS_BIAS) + 1600;
    const float shC = softmax_shift(qf, ldu(bx + l * 4 + 0), ldu(bx + 8)), shW = softmax_shift(qf, ldu(bx + l * 4 + 2), ldu(bx + 8));
    {
        const bf16_t* Kc = (const bf16_t*)(a->ws + WS_KCS) + (size_t)((l * 16 + b * 2 + kvh) * 1024) * 128;
        const bf16_t* VcT = (const bf16_t*)(a->ws + WS_VCST) + (size_t)((l * 16 + b * 2 + kvh) * 128) * 1024;
        float sc[8][4];
#pragma unroll
        for (int sub = 0; sub < 8; ++sub) {
            f32x4 s = {0.f, 0.f, 0.f, 0.f};
            const int n0 = w * 128 + sub * 16;
#pragma unroll
            for (int kk = 0; kk < 4; ++kk) s = mfma16(ld8(Kc + (size_t)(n0 + li) * 128 + kk * 32 + quad * 8), qf[kk], s);
#pragma unroll
            for (int e = 0; e < 4; ++e) { const int n = n0 + quad * 4 + e; const int rel = t - (16 * n + 31);
                sc[sub][e] = (n < NC_S) ? s[e] * QK_SCALE2 + biasL[(rel < 128 ? rel : 128) * 4 + g] - shC : -INFINITY; }
        }
        float ls = 0.f;
#pragma unroll
        for (int sub = 0; sub < 8; ++sub)
#pragma unroll
            for (int e = 0; e < 4; ++e) { sc[sub][e] = fexp2(sc[sub][e]); ls += sc[sub][e]; }
        ls += __shfl_xor(ls, 16); ls += __shfl_xor(ls, 32);
        if (quad == 0) ml[(w * 16 + li) * 2 + 1] = ls;
        __syncthreads();
        float L = 0.f;
#pragma unroll
        for (int ww = 0; ww < 8; ++ww) L += ml[(ww * 16 + li) * 2 + 1];
        const float inv = 1.0f / fmaxf(L, 1e-30f);
#pragma unroll
        for (int sub = 0; sub < 8; ++sub) { f32x4 hs;
#pragma unroll
            for (int e = 0; e < 4; ++e) { sc[sub][e] *= inv; float x = sc[sub][e]; x += dpp_xor1(x); x += dpp_xor2(x); hs[e] = x; }
            if (g == 0) *(LAS f32x4*)(psum + tt * SN_PLD + w * 128 + sub * 16 + quad * 4) = hs; }
        f32x4 oc[8];
#pragma unroll
        for (int dt = 0; dt < 8; ++dt) oc[dt] = (f32x4){0.f, 0.f, 0.f, 0.f};
#pragma unroll
        for (int tp = 0; tp < 4; ++tp) {
            const bf16x8 pb = pack8(sc[2 * tp][0], sc[2 * tp][1], sc[2 * tp][2], sc[2 * tp][3], sc[2 * tp + 1][0], sc[2 * tp + 1][1], sc[2 * tp + 1][2], sc[2 * tp + 1][3]);
#pragma unroll
            for (int dt = 0; dt < 8; ++dt) { const bf16_t* vp = VcT + (size_t)(dt * 16 + li) * 1024 + w * 128 + tp * 32 + quad * 4;
                const s16x4 a0 = *(const s16x4*)vp, a1 = *(const s16x4*)(vp + 16);
                oc[dt] = mfma16(__builtin_shufflevector(a0, a1, 0, 1, 2, 3, 4, 5, 6, 7), pb, oc[dt]); }
        }
#pragma unroll
        for (int dt = 0; dt < 8; ++dt) *(LAS f32x4*)(opart + (size_t)(w * 16 + li) * 128 + dt * 16 + quad * 4) = oc[dt];
        __syncthreads();
#pragma unroll
        for (int ww = 0; ww < 8; ++ww) fin += *(const LAS f32x4*)(opart + (size_t)(ww * 16 + fc) * 128 + fd) * fg0;
    }
    if (w < 4) {
        const LAS float* ps = psum + w * SN_PLD;
        float val[4];
#pragma unroll
        for (int k = 0; k < 4; ++k) { const int j = lane + 64 * k;
            const f32x4 v4 = *(const LAS f32x4*)(ps + 4 * j); const float pm1 = j > 0 ? ps[4 * j - 1] : 0.f;
            val[k] = (j == 0 || j == 255) ? -INFINITY : pm1 + 2.0f * (v4[0] + v4[1] + v4[2]) + v4[3]; }
        if (lane == 0) { sel[w * 16 + 0] = 0; sel[w * 16 + 1] = 255; sel[w * 16 + 2] = 256; }
#pragma unroll 1
        for (int it = 0; it < 13; ++it) {
            float bv = val[0]; int bj = lane;
#pragma unroll
            for (int k = 1; k < 4; ++k) if (val[k] > bv) { bv = val[k]; bj = lane + 64 * k; }
#pragma unroll
            for (int o = 1; o < 64; o <<= 1) { const float ov = __shfl_xor(bv, o); const int oj = __shfl_xor(bj, o); if (ov > bv || (ov == bv && oj < bj)) { bv = ov; bj = oj; } }
            if (lane == 0) sel[w * 16 + 3 + it] = bj;
#pragma unroll
            for (int k = 0; k < 4; ++k) if (bj == lane + 64 * k) val[k] = -INFINITY;
        }
    }
    __syncthreads();
    {
        const int tq = w >> 1, tpos = PAST + tq;
        const size_t rq = (size_t)NTP + b * DS + tq;
        bf16x8 q2[4];
#pragma unroll
        for (int kk = 0; kk < 4; ++kk) q2[kk] = ld8(Z + rq * ZLD + ZQ + h * 128 + kk * 32 + quad * 8);
        const float shS = softmax_shift(q2, ldu(bx + l * 4 + 1), ldu(bx + 8));
        AttnState st; attn_init(st);
        const float* ca = a->in[I_CA];
#pragma unroll 1
        for (int bi = 0; bi < 8; ++bi) {
            const int j = sel[tq * 16 + (w & 1) * 8 + bi];
            const int ntile = (j == 256) ? 1 : 2;
            const size_t pbase = (j < 256) ? ((size_t)(l * NPOOL + a->page_table[b * NPAGES + (j >> 1)]) * PAGE + (j & 1) * 64) * 1024 : 0;
#pragma unroll 1
            for (int tl = 0; tl < ntile; ++tl) {
                auto src = [&](int i, int which) { RowSrc r; r.f = nullptr; r.h = nullptr; const int ii = tl * 32 + i;
                    if (j < 256) r.f = ca + pbase + (size_t)ii * 1024 + which * 256 + kvh * 128;
                    else if (ii < DS) r.h = Z + ((size_t)NTP + b * DS + ii) * ZLD + ZKV + which * 256 + kvh * 128;
                    return r; };
                stage_v32(vst, [&](int i) { return src(i, 3); }, li, quad);
                const RowSrc k0 = src(li, 2), k1 = src(16 + li, 2);
                attn_tile32(st, q2,
                    [&](int sub, int kk) { return row8(sub ? k1 : k0, kk * 32 + quad * 8); },
                    [&](int dt, int sub) { return lds_tr(vst + (sub * 16 + quad * 4 + (li >> 2)) * VP + dt * 16 + (li & 3) * 4); },
                    [&](int sub, int e, float raw) { const int rel = tpos - (j * 64 + tl * 32 + sub * 16 + quad * 4 + e);
                        return rel >= 0 ? raw * QK_SCALE2 + biasL[(rel < 128 ? rel : 128) * 4 + g] - shS : -INFINITY; });
            }
        }
        __syncthreads();
        put_part(st, ml, opart, w, 4, li, quad);
        __syncthreads();
        { const int ftq = fc >> 2, fgc = fc & 3;
#pragma unroll
          for (int e = 0; e < 4; ++e) fin[e] += fg1 * merge_part(ml, opart, 2 * ftq, 2, 4, fgc, fd + e); }
        __syncthreads();
    }
    {
        AttnState st; attn_init(st);
        const float* sw = a->in[I_SW] + (size_t)((l * DB + b) * 512) * 512;
#pragma unroll 1
        for (int tl = w; tl < 17; tl += 8) {
            auto src = [&](int i, int which) { RowSrc r; r.f = nullptr; r.h = nullptr; const int ii = tl * 32 + i;
                if (ii < 512) r.f = sw + (size_t)ii * 512 + which * 256 + kvh * 128;
                else if (ii < 512 + DS) r.h = Z + ((size_t)NTP + b * DS + ii - 512) * ZLD + ZKV + (4 + which) * 256 + kvh * 128;
                return r; };
            stage_v32(vst, [&](int i) { return src(i, 1); }, li, quad);
            const RowSrc k0 = src(li, 0), k1 = src(16 + li, 0);
            attn_tile32(st, qf,
                [&](int sub, int kk) { return row8(sub ? k1 : k0, kk * 32 + quad * 8); },
                [&](int dt, int sub) { return lds_tr(vst + (sub * 16 + quad * 4 + (li >> 2)) * VP + dt * 16 + (li & 3) * 4); },
                [&](int sub, int e, float raw) { const int rel = 512 + tt - (tl * 32 + sub * 16 + quad * 4 + e);
                    return (rel >= 0 && rel <= 512) ? raw * QK_SCALE2 + biasL[(rel < 128 ? rel : 128) * 4 + g] - shW : -INFINITY; });
        }
        __syncthreads();
        put_part(st, ml, opart, w, 16, li, quad);
        __syncthreads();
#pragma unroll
        for (int e = 0; e < 4; ++e) fin[e] += fg2 * merge_part(ml, opart, 0, 8, 16, fc, fd + e);
    }
    { const size_t frow = (size_t)NTP + b * DS + (fc >> 2); const int fh = kvh * 4 + (fc & 3);
      const u32x2 sw2 = *(const u32x2*)(Z + frow * ZLD + ZAS + fh * 128 + fd);
      u32x2 o; o.x = pk2(fin[0] * siluf_(lo2f(sw2.x)), fin[1] * siluf_(hi2f(sw2.x))); o.y = pk2(fin[2] * siluf_(lo2f(sw2.y)), fin[3] * siluf_(hi2f(sw2.y)));
      *(u32x2*)((bf16_t*)(a->ws + WS_MIXED) + frow * DM + fh * 128 + fd) = o; }
    __syncthreads();
}

constexpr int SD_SC = 0, SD_HIST = 65792, SD_IDX = SD_HIST + 1024, SD_BIAS = SD_IDX + 1024, SD_CTL = SD_BIAS + 2304, SD_ML = SD_CTL + 256, SD_ST = 71680, SD_OP = SD_ST + 8 * 32 * VP * 2;
DI void dsa_sample_unit(ArgsP a, LAS unsigned char* lds, int l, int q) {
    const int tid = ltid(), w = tid >> 6, lane = tid & 63, li = lane & 15, quad = lane >> 4;
    const int b = q >> 2, tt = q & 3, t = PAST + tt, n = t + 1;
    const bf16_t* Z = (const bf16_t*)(a->ws + WS_Z);
    LAS float* sc = (LAS float*)(lds + SD_SC); LAS unsigned* hist = (LAS unsigned*)(lds + SD_HIST); LAS int* idx = (LAS int*)(lds + SD_IDX);
    LAS float* biasC = (LAS float*)(lds + SD_BIAS); LAS int* ctl = (LAS int*)(lds + SD_CTL); LAS float* ml = (LAS float*)(lds + SD_ML);
    LAS bf16_t* vst = (LAS bf16_t*)(lds + SD_ST) + w * 32 * VP; LAS float* opart = (LAS float*)(lds + SD_OP);
    { const float* bt = (const float*)(a->ws + WS_BIAS) + 129 * 8;
      for (int i = tid; i < 129 * 4; i += 512) biasC[i] = bt[i];
      const float* gs = (const float*)(a->ws + WS_SCORES) + (size_t)q * SCORE_LD;
      for (int i = tid; i < n; i += 512) sc[i] = gs[i]; }
    unsigned prefix = 0u; int kth = 256;
#pragma unroll 1
    for (int pass = 3; pass >= 0; --pass) {
        const int shift = pass * 8;
        if (tid < 256) hist[tid] = 0u;
        __syncthreads();
        for (int i = tid; i < n; i += 512) { const unsigned uu = fkey(sc[i]);
            if (pass == 3 || (uu >> (shift + 8)) == prefix) (void)__hip_atomic_fetch_add(hist + ((uu >> shift) & 255u), 1u, __ATOMIC_RELAXED, __HIP_MEMORY_SCOPE_WORKGROUP); }
        __syncthreads();
        if (w == 0) {
            const u32x4 c = *(const LAS u32x4*)(hist + lane * 4);
            const int tot = (int)(c.x + c.y + c.z + c.w);
            int incl = tot;
#pragma unroll
            for (int o = 1; o < 64; o <<= 1) { const int t2 = __shfl_down(incl, o); if (lane + o < 64) incl += t2; }
            const int a3 = incl - tot, a2 = a3 + (int)c.w, a1 = a2 + (int)c.z, a0 = a1 + (int)c.y;
            int which = -1, ab = 0;
            if (a3 < kth && kth <= a3 + (int)c.w) { which = 3; ab = a3; }
            else if (a2 < kth && kth <= a2 + (int)c.z) { which = 2; ab = a2; }
            else if (a1 < kth && kth <= a1 + (int)c.y) { which = 1; ab = a1; }
            else if (a0 < kth && kth <= a0 + (int)c.x) { which = 0; ab = a0; }
            if (which >= 0) { ctl[0] = lane * 4 + which; ctl[1] = kth - ab; }
        }
        __syncthreads();
        prefix = (prefix << 8) | (unsigned)ctl[0]; kth = ctl[1];
    }
    {
        const int chunk = (((n + 7) >> 3) + 63) & ~63, lo = w * chunk, hi = (lo + chunk < n) ? lo + chunk : n;
        int cg = 0, ce = 0;
        for (int base = lo; base < hi; base += 64) { const int i = base + lane; const bool valid = i < hi; const unsigned uu = valid ? fkey(sc[i]) : 0u;
            cg += __builtin_popcountll(__ballot(valid && uu > prefix)); ce += __builtin_popcountll(__ballot(valid && uu == prefix)); }
        if (lane == 0) { ctl[8 + w * 2] = cg; ctl[9 + w * 2] = ce; }
        __syncthreads();
        int ebase = 0, tbase = 0;
        for (int ww = 0; ww < w; ++ww) { const int eg = ctl[8 + ww * 2], ee = ctl[9 + ww * 2]; const int room = kth - ebase; tbase += eg + (ee < room ? ee : (room > 0 ? room : 0)); ebase += ee; }
        int cnt = tbase, cee = ebase;
        for (int base = lo; base < hi; base += 64) {
            const int i = base + lane; const bool valid = i < hi; const unsigned uu = valid ? fkey(sc[i]) : 0u;
            const bool gt = valid && uu > prefix, eq = valid && uu == prefix;
            const unsigned long long eqb = __ballot(eq);
            const int eqrank = cee + __builtin_popcountll(eqb & ((1ull << lane) - 1ull));
            const bool take = gt || (eq && eqrank < kth);
            const unsigned long long tb = __ballot(take);
            if (take) idx[cnt + __builtin_popcountll(tb & ((1ull << lane) - 1ull))] = i;
            cnt += __builtin_popcountll(tb); cee += __builtin_popcountll(eqb);
        }
    }
    __syncthreads();
    {
        const int head = li & 3;
        const size_t row = (size_t)NTP + q;
        bf16x8 qf[4];
#pragma unroll
        for (int kk = 0; kk < 4; ++kk) qf[kk] = ld8(Z + row * ZLD + ZCQ + head * 128 + kk * 32 + quad * 8);
        const float* cc = a->in[I_CC];
        const float* bx = (const float*)(a->ws + WS_BIAS) + 1600;
        const float sh = softmax_shift(qf, ldu(bx + l * 4 + 3), ldu(bx + 9));
        const LAS int* ix = idx + w * 32;
        auto src = [&](int i, int which) { RowSrc r; r.f = nullptr; r.h = nullptr; const int s = ix[i];
            if (s < PAST) r.f = cc + ((size_t)(l * NPOOL + a->page_table[b * NPAGES + (s >> 7)]) * PAGE + (s & 127)) * 256 + which * 128;
            else r.h = Z + ((size_t)NTP + b * DS + (s - PAST)) * ZLD + ZCKV + which * 128;
            return r; };
        AttnState st; attn_init(st);
        stage_v32(vst, [&](int i) { return src(i, 1); }, li, quad);
        const RowSrc k0 = src(li, 0), k1 = src(16 + li, 0);
        const u32x4 ip0 = *(const LAS u32x4*)(ix + quad * 4), ip1 = *(const LAS u32x4*)(ix + 16 + quad * 4);
        attn_tile32(st, qf,
            [&](int sub, int kk) { return row8(sub ? k1 : k0, kk * 32 + quad * 8); },
            [&](int dt, int sub) { return lds_tr(vst + (sub * 16 + quad * 4 + (li >> 2)) * VP + dt * 16 + (li & 3) * 4); },
            [&](int sub, int e, float raw) { const int rel = t - (int)(sub ? ip1[e] : ip0[e]); return raw * QK_SCALE2 + biasC[(rel < 128 ? rel : 128) * 4 + head] - sh; });
        put_part(st, ml, opart, w, 4, li, quad);
        __syncthreads();
        { const int fh = tid >> 7, fd = tid & 127;
          const float o = merge_part(ml, opart, 0, 8, 4, fh, fd);
          ((bf16_t*)(a->ws + WS_MIXED))[row * DM + 1536 + fh * 128 + fd] = f2bf(o * siluf_(bf2f(Z[row * ZLD + ZCS + fh * 128 + fd]))); }
    }
    __syncthreads();
}

constexpr int L4_SN = 16, L4_SD = 32, L4_NSA = 512, L4_DSA = 1024, L4_TOTAL = L4_SN + L4_SD + L4_NSA + L4_DSA;
DI void l4_phase(ArgsP a, LAS unsigned char* lds, int lq) {
    const int l = lq & 1;
    unsigned* qhead = (unsigned*)(a->ws + WS_CTL) + 4096 + 64 * lq;
    LAS int* tk = (LAS int*)(lds + LDS_TICKET_OFF);
    for (;;) {
        if (threadIdx.x == 0) *tk = (int)__hip_atomic_fetch_add(qhead, 1u, __ATOMIC_RELAXED, __HIP_MEMORY_SCOPE_AGENT);
        __syncthreads();
        const int u = *tk;
        __syncthreads();
#ifndef DUP_NSA
#define DUP_NSA 0
#endif
#ifndef DUP_DSA
#define DUP_DSA 0
#endif
#ifndef DUP_SMP
#define DUP_SMP 0
#endif
        if (u >= L4_TOTAL + DUP_NSA * L4_NSA + DUP_DSA * L4_DSA + DUP_SMP * (L4_SN + L4_SD)) break;
        if (u >= L4_TOTAL) { int m = u - L4_TOTAL;
            if (DUP_SMP && m < L4_SN + L4_SD) { if (m < L4_SN) nsa_sample_unit(a, lds, l, m); else dsa_sample_unit(a, lds, l, m - L4_SN); continue; }
            m -= DUP_SMP * (L4_SN + L4_SD);
            if (DUP_NSA && m < L4_NSA) { nsa_prompt_unit(a, lds, l, ((m & 3) << 7) | (127 - (m >> 2))); continue; }
            m -= DUP_NSA * L4_NSA;
            dsa_prompt_unit(a, lds, l, ((511 - (m >> 1)) << 1) | (m & 1)); continue; }
        if (u < L4_SN) nsa_sample_unit(a, lds, l, u);
        else if (u < L4_SN + L4_SD) dsa_sample_unit(a, lds, l, u - L4_SN);
        else if (u < L4_SN + L4_SD + L4_NSA) { const int m = u - L4_SN - L4_SD; nsa_prompt_unit(a, lds, l, ((m & 3) << 7) | (127 - (m >> 2))); }
        else { const int m = u - L4_SN - L4_SD - L4_NSA; dsa_prompt_unit(a, lds, l, ((511 - (m >> 1)) << 1) | (m & 1)); }
    }
}

constexpr int N_PHASES = 12;
#ifndef MK_LAUNCHES
#define MK_LAUNCHES 1
#endif

__global__ void __launch_bounds__(512, 2) fwd(Args a_) {
    extern __shared__ __attribute__((aligned(16))) unsigned char shm[];
    LAS unsigned char* lds = (LAS unsigned char*)shm;
    if (threadIdx.x == 0) *(LAS u32x4*)(lds + LDS_BAR_OFF) = (u32x4){0u, 0u, 0u, 0u};
    __syncthreads();
    unsigned* ctl = (unsigned*)(a_.ws + WS_CTL);
    XcdBarrier bar = xcd_barrier_post(ctl, (volatile LAS unsigned*)(lds + LDS_BAR_OFF));
    const int G = gridDim.x, bid = blockIdx.x;
#define IN(ph) ((ph) >= a_.ph_lo && (ph) < a_.ph_hi)
#define SEAM(ph) do { if (IN(ph) && IN((ph) + 1)) xcd_barrier(bar); } while (0)

#ifndef DUP_P0
#define DUP_P0 1
#endif
#ifndef DUP_P1
#define DUP_P1 1
#endif
#ifndef DUP_L2
#define DUP_L2 1
#endif
#ifndef DUP_L4
#define DUP_L4 1
#endif
#ifndef DUP_L5
#define DUP_L5 1
#endif
    if (IN(0)) { ArgsP a = largs();
        unsigned* qhead = (unsigned*)(a->ws + WS_CTL) + 4096 + 64 * 6;
        LAS int* tk = (LAS int*)(lds + LDS_TICKET_OFF);
        for (;;) {
            if (threadIdx.x == 0) *tk = (int)__hip_atomic_fetch_add(qhead, 1u, __ATOMIC_RELAXED, __HIP_MEMORY_SCOPE_AGENT);
            __syncthreads();
            const int q = *tk;
            __syncthreads();
            if (q >= PJ_TOTAL) break;
            prologue_unit(a, lds, q < PJ_TOTAL - PJ_T_END ? q + PJ_T_END : q - (PJ_TOTAL - PJ_T_END));
        }
    }
    SEAM(0);
    if (IN(1)) { for (int rep = 0; rep < DUP_P1; ++rep) { ArgsP a = largs();
#if CMP_DIRECT
        { const int per = (CG_UNITS + G - 1) / G;
          for (int u = bid; u < CG_UNITS; u += G) cmp_gemm_direct(a, lds, u);
          asm volatile("s_waitcnt vmcnt(0)" ::: "memory");
          __syncthreads();
          (void)per;
          for (int j0 = 0; bid + j0 * G < CG_UNITS; j0 += 4) { const int w = ltid() >> 6, u = bid + (j0 + (w >> 1)) * G; if (u < CG_UNITS) cmp2_sample_rows(a, cg_unit_row(u, w & 1)); } }
#else
        pg8::Gemm g{(const bf16_t*)(a->ws + WS_ACMPS), (const bf16_t*)(a->ws + WS_W1T), 65536, 256, 4096, 2048, 4096};
        pg8::OrderCmpS S{G, bid};
        pg8::EpiHid E{(bf16_t*)(a->ws + WS_HIDS), (const float*)(a->ws + WS_CBIAS)};
        pg8::gemm_phase<pg8::EpiHid, pg8::OrderCmpS, false>(lds, g, S, E, nullptr);
        asm volatile("s_waitcnt vmcnt(0)" ::: "memory");
        __syncthreads();
        for (int L = bid; L < 256; L += G) { cmp2_sample_unit(a, 2 * L); cmp2_sample_unit(a, 2 * L + 1); }
#endif
        l1_rows(a, 0);
        if (rep + 1 < DUP_P1) xcd_barrier(bar); }
    }
    SEAM(1);
#pragma unroll 1
    for (int l = 0; l < NL; ++l) {
        const int p0 = 2 + 5 * l;
        if (l > 0) {
            if (IN(p0)) { ArgsP a = largs(); l1_rows(a, l); }
            SEAM(p0);
        }
        if (IN(p0 + 1)) { for (int rep = 0; rep < DUP_L2; ++rep) { ArgsP a = largs();
#if CMP_DIRECT
            if (l == 0 && rep == 0) cmp2_sample_tail(a);
#endif
            pg8::Gemm g{(const bf16_t*)(a->ws + WS_H), (const bf16_t*)(a->ws + WS_WINT) + (size_t)l * WIN_ROWS * DM, NTP, ZLD, DM, DM, DM};
            pg8::StaticOrder S; S.init(NTP, ZLD, G, bid);
            pg8::EpiZ E{(bf16_t*)(a->ws + WS_Z), ZLD};
            pg8::gemm_phase<pg8::EpiZ, pg8::StaticOrder, false>(lds, g, S, E, nullptr);
            __syncthreads();
            for (int t = bid; t < L2_THIN_TASKS; t += G) l2_thin_task(a, lds, l, t);
            if (rep + 1 < DUP_L2) xcd_barrier(bar); }
        }
        SEAM(p0 + 1);
        if (IN(p0 + 2)) { ArgsP a = largs();
            unsigned* qhead = (unsigned*)(a->ws + WS_CTL) + 4096 + 64 * (4 + l);
            LAS int* tk = (LAS int*)(lds + LDS_TICKET_OFF);
            for (;;) {
                if (threadIdx.x == 0) *tk = (int)__hip_atomic_fetch_add(qhead, 1u, __ATOMIC_RELAXED, __HIP_MEMORY_SCOPE_AGENT);
                __syncthreads();
                const int u = *tk;
                __syncthreads();
                if (u >= L3_TOTAL) break;
                l3_unit(a, lds, l, u);
            }
        }
        SEAM(p0 + 2);
        if (IN(p0 + 3)) { for (int rep = 0; rep < DUP_L4; ++rep) { ArgsP a = largs(); l4_phase(a, lds, l + 2 * rep); if (rep + 1 < DUP_L4) xcd_barrier(bar); } }
        SEAM(p0 + 3);
        if (IN(p0 + 4)) { for (int rep = 0; rep < DUP_L5; ++rep) { ArgsP a = largs();
            pg8::Gemm g{(const bf16_t*)(a->ws + WS_MIXED), (const bf16_t*)(a->ws + WS_WOUTT) + (size_t)l * DM * DM, NTP, DM, DM, DM, DM};
            pg8::StaticOrder S; S.init(NTP, DM, G, bid);
            pg8::EpiY E{l == 0 ? a->in[I_XP] : (const float*)(a->ws + WS_Y0), l == 0 ? (float*)(a->ws + WS_Y0) : a->out + O_YP, (const float*)(a->ws + WS_MOD) + (size_t)l * 10 * 6144};
            pg8::gemm_phase<pg8::EpiY, pg8::StaticOrder, false>(lds, g, S, E, nullptr);
            __syncthreads();
            for (int t = bid; t < 64; t += G) l5_thin_task(a, lds, l, t);
            if (rep + 1 < DUP_L5) xcd_barrier(bar); }
        }
        if (l + 1 < NL) SEAM(p0 + 4);
    }
#undef IN
#undef SEAM
}

extern "C" void kernel_launch(void* const* d_in, const int* in_sizes, int n_in, void* d_out, int out_size, void* d_ws, size_t ws_size, hipStream_t stream) {
    static int grid = 0;
    if (grid == 0) {
        if (n_in != 27 || (size_t)out_size != O_END || ws_size < WS_END2) { fprintf(stderr, "kernel_launch: unexpected shapes (n_in %d, out %d, ws %zu; need 27, %zu, >= %zu)\n", n_in, out_size, ws_size, (size_t)O_END, (size_t)WS_END2); grid = -1; return; }
        int dev = 0, cus = 0, per_cu = 0;
        if (hipGetDevice(&dev) != hipSuccess || hipDeviceGetAttribute(&cus, hipDeviceAttributeMultiprocessorCount, dev) != hipSuccess) { grid = -1; return; }
        if (hipFuncSetAttribute((const void*)fwd, hipFuncAttributeMaxDynamicSharedMemorySize, LDS_BYTES) != hipSuccess) { fprintf(stderr, "kernel_launch: hipFuncSetAttribute failed\n"); grid = -1; return; }
        if (hipOccupancyMaxActiveBlocksPerMultiprocessor(&per_cu, (const void*)fwd, 512, LDS_BYTES) != hipSuccess || per_cu < 1) { fprintf(stderr, "kernel_launch: occupancy query says %d blocks per CU\n", per_cu); per_cu = 1; }
        (void)hipGetLastError();
        grid = cus;
    }
    if (grid < 0) return;
    (void)hipMemsetAsync((char*)d_ws + WS_CTL, 0, CTL_BYTES, stream);
    Args a{};
    for (int i = 0; i < 27; ++i) a.in[i] = (const float*)d_in[i];
    a.page_table = (const int*)d_in[I_PT];
    a.out = (float*)d_out; a.ws = (unsigned char*)d_ws;
#if MK_LAUNCHES == 1
    a.ph_lo = 0; a.ph_hi = N_PHASES;
    hipLaunchKernelGGL(fwd, dim3(grid), dim3(512), LDS_BYTES, stream, a);
#else
    for (int ph = 0; ph < N_PHASES; ++ph) { a.ph_lo = ph; a.ph_hi = ph + 1; hipLaunchKernelGGL(fwd, dim3(grid), dim3(512), LDS_BYTES, stream, a); }
#endif
}
```

```cpp
#include <hip/hip_runtime.h>
#include <stdint.h>
#include <stdio.h>

#define DI __device__ __forceinline__
#define LAS __attribute__((address_space(3)))
typedef unsigned short bf16_t;
typedef short bf16x8 __attribute__((ext_vector_type(8)));
typedef short s16x4 __attribute__((ext_vector_type(4)));
typedef float f32x4 __attribute__((ext_vector_type(4)));
typedef float f32x2 __attribute__((ext_vector_type(2)));
typedef unsigned u32x4 __attribute__((ext_vector_type(4)));
typedef unsigned u32x2 __attribute__((ext_vector_type(2)));

constexpr int DM = 2048, NB = 2, SEQ = 4096, NL = 2, DB = 8, DS = 4, PAST = 16384, PAGE = 128;
constexpr int HD = 128;
constexpr int NTP = NB * SEQ;
constexpr int NTS = DB * DS;
constexpr int NTOK = NTP + NTS;
constexpr int NPAGES = 128, NPOOL = 1280, WINB = 512, POOLB = 15;
constexpr int NIN = 6236;
constexpr int NC_S = 1023;
constexpr int NC_P = 255;
constexpr int ZLD = 6144;
constexpr int ZQ = 0, ZKV = 1024, ZAS = 2560, ZBI = 3584, ZBS = 4096, ZCQ = 4608, ZCKV = 5120, ZIQ = 5376, ZCS = 5632;
constexpr int ZSLD = 96, ZS_IK = 0, ZS_GATE = 64, ZS_IW = 88;
constexpr int WIN_ROWS = ZLD + ZSLD;
constexpr float LOG2E = 1.4426950408889634f;
constexpr float QK_SCALE2 = 0.08838834764831845f * 1.4426950408889634f;
constexpr float EPS = 1e-6f;
constexpr int SCORE_LD = 16512;
constexpr int LDS_BYTES = 163840, LDS_BAR_OFF = LDS_BYTES - 16, LDS_TICKET_OFF = LDS_BYTES - 32;

constexpr size_t al256(size_t x) { return (x + 255) & ~(size_t)255; }
constexpr size_t WS_CTL = 0, CTL_BYTES = 65536;
constexpr size_t WS_WINT = WS_CTL + CTL_BYTES;
constexpr size_t WS_WOUTT = WS_WINT + al256((size_t)NL * WIN_ROWS * DM * 2);
constexpr size_t WS_W1T = WS_WOUTT + al256((size_t)NL * DM * DM * 2);
constexpr size_t WS_W2T = WS_W1T + al256((size_t)4 * 256 * 4096 * 2);
constexpr size_t WS_PWT = WS_W2T + al256((size_t)4 * 128 * 256 * 2);
constexpr size_t WS_MOD = WS_PWT + al256((size_t)8 * 128 * 128 * 2);
constexpr size_t WS_CBIAS = WS_MOD + al256((size_t)NL * 10 * 6144 * 4);
constexpr size_t WS_BIAS = WS_CBIAS + al256((size_t)4 * 256 * 4);
constexpr size_t WS_H = WS_BIAS + 8192;
constexpr size_t WS_Z = WS_H + al256((size_t)8448 * DM * 2);
constexpr size_t WS_ZS = WS_Z + al256((size_t)8448 * ZLD * 2);
constexpr size_t WS_KIDXB = WS_ZS + al256((size_t)8448 * ZSLD * 4);
constexpr size_t WS_MIXED = WS_KIDXB + al256((size_t)8448 * 64 * 2);
constexpr size_t WS_Y0 = WS_MIXED + al256((size_t)8448 * DM * 2);
constexpr size_t WS_ACMPS = WS_Y0 + al256((size_t)8448 * DM * 4);
constexpr size_t WS_HIDS = WS_ACMPS + al256((size_t)(65536 + 2) * 2048 * 2);
constexpr size_t WS_KCS = WS_HIDS + al256((size_t)65536 * 256 * 2);
constexpr size_t WS_VCST = WS_KCS + al256((size_t)NL * 16 * 1024 * 128 * 2);
constexpr size_t WS_KCP = WS_VCST + al256((size_t)NL * 16 * 1024 * 128 * 2);
constexpr size_t WS_VCPT = WS_KCP + al256((size_t)4 * 256 * 128 * 2);
constexpr size_t WS_SCORES = WS_VCPT + al256((size_t)4 * 256 * 128 * 2);
constexpr size_t WS_CKV = WS_SCORES + al256((size_t)NTS * SCORE_LD * 4);
constexpr size_t WS_W1G = WS_CKV + al256((size_t)8448 * 256 * 2);
constexpr size_t WS_END = WS_W1G + al256((size_t)4 * 512 * 2048 * 2);
constexpr size_t WS_NKV = WS_END;
constexpr size_t WS_END2 = WS_NKV + al256((size_t)NB * 2 * 4 * SEQ * 128 * 2);
constexpr size_t WS_G = WS_ACMPS;

constexpr size_t O_YP = 0;
constexpr size_t O_YS = O_YP + (size_t)NTP * DM;
constexpr size_t O_AKVP = O_YS + (size_t)NTS * DM;
constexpr size_t O_AKVS = O_AKVP + (size_t)NL * NTP * 1024;
constexpr size_t O_CKVP = O_AKVS + (size_t)NL * NTS * 1024;
constexpr size_t O_CKVS = O_CKVP + (size_t)NL * NTP * 256;
constexpr size_t O_KIXP = O_CKVS + (size_t)NL * NTS * 256;
constexpr size_t O_KIXS = O_KIXP + (size_t)NL * NTP * 64;
constexpr size_t O_AWP = O_KIXS + (size_t)NL * NTS * 64;
constexpr size_t O_AWS = O_AWP + (size_t)NL * NB * 512 * 512;
constexpr size_t O_BPP = O_AWS + (size_t)NL * DB * 512 * 512;
constexpr size_t O_BPS = O_BPP + (size_t)NL * NB * 15 * 512;
constexpr size_t O_END = O_BPS + (size_t)NL * DB * 15 * 512;

struct Args {
    const float* in[27];
    const int* page_table;
    float* out;
    unsigned char* ws;
    int ph_lo, ph_hi;
};
enum { I_XP = 0, I_XS, I_CA, I_CC, I_CI, I_SW, I_SB, I_PT, I_CP, I_CSM, I_RB, I_NG, I_WADA, I_BADA, I_WIN, I_WOUT, I_AQN, I_AKN, I_PE, I_W1, I_B1, I_W2, I_B2, I_PW, I_BSC, I_CQN, I_CKN };

typedef const __attribute__((address_space(4))) Args* ArgsP;
DI int ltid() { int t = threadIdx.x; asm volatile("" : "+v"(t)); return t; }
DI ArgsP largs() { ArgsP p = (ArgsP)__builtin_amdgcn_kernarg_segment_ptr(); asm volatile("" : "+s"(p)); return p; }
DI float bf2f(bf16_t b) { return __uint_as_float(((unsigned)b) << 16); }
DI bf16_t f2bf(float f) { unsigned u = __float_as_uint(f); u += 0x7FFFu + ((u >> 16) & 1u); return (bf16_t)(u >> 16); }
typedef __bf16 bf16x2_t __attribute__((ext_vector_type(2)));
DI unsigned pk2(float lo, float hi) { const f32x2 v = {lo, hi}; return __builtin_bit_cast(unsigned, __builtin_convertvector(v, bf16x2_t)); }
DI float lo2f(unsigned w) { return __uint_as_float(w << 16); }
DI float hi2f(unsigned w) { return __uint_as_float(w & 0xffff0000u); }
DI float ldu(const float* p) { return __hip_atomic_load(p, __ATOMIC_RELAXED, __HIP_MEMORY_SCOPE_AGENT); }
DI float fexp2(float x) { return __builtin_amdgcn_exp2f(x); }
DI float frcp(float x) { return __builtin_amdgcn_rcpf(x); }
DI float sigmoidf_(float x) { return frcp(1.0f + fexp2(-x * LOG2E)); }
DI float siluf_(float x) { return x * sigmoidf_(x); }
DI float gelu_tanh(float x) { const float u = x * (1.0f + 0.044715f * x * x); return x * frcp(1.0f + fexp2(-2.302208198f * u)); }
DI f32x4 mfma16(bf16x8 a, bf16x8 b, f32x4 c) { return __builtin_amdgcn_mfma_f32_16x16x32_bf16(a, b, c, 0, 0, 0); }
DI float wave_sum(float v) { for (int o = 32; o >= 1; o >>= 1) v += __shfl_xor(v, o); return v; }
DI bf16x8 pack8(float a0, float a1, float a2, float a3, float a4, float a5, float a6, float a7) {
    u32x4 p; p.x = pk2(a0, a1); p.y = pk2(a2, a3); p.z = pk2(a4, a5); p.w = pk2(a6, a7); return __builtin_bit_cast(bf16x8, p);
}
DI void unpack8(const u32x4 w, float* v) { v[0] = lo2f(w.x); v[1] = hi2f(w.x); v[2] = lo2f(w.y); v[3] = hi2f(w.y); v[4] = lo2f(w.z); v[5] = hi2f(w.z); v[6] = lo2f(w.w); v[7] = hi2f(w.w); }
DI bf16x8 ld8(const bf16_t* p) { return *(const bf16x8*)p; }
DI bf16x8 cvt8(const float* p) { const f32x4 a = *(const f32x4*)p, b = *(const f32x4*)(p + 4); return pack8(a[0], a[1], a[2], a[3], b[0], b[1], b[2], b[3]); }
DI float dpp_xor1(float v) { return __builtin_bit_cast(float, __builtin_amdgcn_update_dpp(0, __builtin_bit_cast(int, v), 0xB1, 0xF, 0xF, true)); }
DI float dpp_xor2(float v) { return __builtin_bit_cast(float, __builtin_amdgcn_update_dpp(0, __builtin_bit_cast(int, v), 0x4E, 0xF, 0xF, true)); }
template <int CTRL> DI float dppf(float v) { return __builtin_bit_cast(float, __builtin_amdgcn_update_dpp(__builtin_bit_cast(int, v), __builtin_bit_cast(int, v), CTRL, 0xF, 0xF, false)); }
template <int CTRL> DI int dppi(int v) { return __builtin_amdgcn_update_dpp(v, v, CTRL, 0xF, 0xF, false); }
template <int CTRL> DI int dppi0(int v) { return __builtin_amdgcn_update_dpp(0, v, CTRL, 0xF, 0xF, true); }
DI float rlanef(float v, int l) { return __builtin_bit_cast(float, __builtin_amdgcn_readlane(__builtin_bit_cast(int, v), l)); }
DI float wave_max_dpp(float v) {
    v = fmaxf(v, dppf<0xB1>(v)); v = fmaxf(v, dppf<0x4E>(v)); v = fmaxf(v, dppf<0x141>(v)); v = fmaxf(v, dppf<0x140>(v));
    return fmaxf(fmaxf(rlanef(v, 0), rlanef(v, 16)), fmaxf(rlanef(v, 32), rlanef(v, 48)));
}
DI float wave_min_dpp(float v) {
    v = fminf(v, dppf<0xB1>(v)); v = fminf(v, dppf<0x4E>(v)); v = fminf(v, dppf<0x141>(v)); v = fminf(v, dppf<0x140>(v));
    return fminf(fminf(rlanef(v, 0), rlanef(v, 16)), fminf(rlanef(v, 32), rlanef(v, 48)));
}
DI int wave_sum_dpp(int v) {
    v += dppi<0xB1>(v); v += dppi<0x4E>(v); v += dppi<0x141>(v); v += dppi<0x140>(v);
    return __builtin_amdgcn_readlane(v, 0) + __builtin_amdgcn_readlane(v, 16) + __builtin_amdgcn_readlane(v, 32) + __builtin_amdgcn_readlane(v, 48);
}
DI int wave_incl_scan_dpp(int v, int lane) {
    v += dppi0<0x111>(v); v += dppi0<0x112>(v); v += dppi0<0x114>(v); v += dppi0<0x118>(v);
    const int r0 = __builtin_amdgcn_readlane(v, 15), r1 = __builtin_amdgcn_readlane(v, 31), r2 = __builtin_amdgcn_readlane(v, 47);
    return v + (lane >= 16 ? r0 : 0) + (lane >= 32 ? r1 : 0) + (lane >= 48 ? r2 : 0);
}
DI void lds_barrier() { asm volatile("s_waitcnt lgkmcnt(0)" ::: "memory"); __builtin_amdgcn_s_barrier(); asm volatile("" ::: "memory"); }
DI int t5_bucket(int rel) { if (rel < 16) return rel; const int b = 16 + (int)(logf((float)rel * (1.0f / 16.0f)) / logf(8.0f) * 16.0f); return b < 31 ? b : 31; }

#define XB_TMO      128
#define XB_XCNT(j)  (256  + 64 * (j))
#define XB_XSUB(j)  (1280 + 64 * (j))
#define XB_XGEN(j)  (2304 + 64 * (j))
#define XB_TOP      3328
#define XB_TOPGEN   3392
#define XCD_BAR_WORDS 3456
#define XB_SPIN_CAP (1u << 18)

__device__ __forceinline__ unsigned xb_ld(unsigned* p)              { return __hip_atomic_load(p, __ATOMIC_RELAXED, __HIP_MEMORY_SCOPE_AGENT); }
__device__ __forceinline__ unsigned xb_add(unsigned* p, unsigned v) { return __hip_atomic_fetch_add(p, v, __ATOMIC_RELAXED, __HIP_MEMORY_SCOPE_AGENT); }
__device__ __forceinline__ unsigned xb_xcc_id() { return (unsigned)__builtin_amdgcn_s_getreg((3 << 11) | 20) & 0xFu; }
#define XB_SPIN(cond, bar) do { unsigned _sp = 0; while (cond) { __builtin_amdgcn_s_sleep(1); \
    if ((++_sp & 255u) == 0u) { if (xb_ld(&(bar)[XB_TMO])) break; if (_sp > XB_SPIN_CAP) { atomicAdd(&(bar)[XB_TMO], 1u); break; } } } } while (0)

struct XcdBarrier {
    unsigned* bar; unsigned x;
    volatile LAS unsigned* st;
};

__device__ __forceinline__ XcdBarrier xcd_barrier_post(unsigned* bar, volatile LAS unsigned* st) {
    XcdBarrier b; b.bar = bar; b.x = xb_xcc_id(); b.st = st;
    if (threadIdx.x == 0) (void)xb_add(&bar[XB_XCNT(b.x)], 1u);
    return b;
}
__device__ __forceinline__ void xcd_barrier_complete(unsigned* bar, unsigned x, unsigned& nloc, unsigned& nx) {
    const unsigned G = gridDim.x * gridDim.y * gridDim.z;
    unsigned sum, cnt, mine, sp = 0u;
    for (;;) {
        sum = 0u; cnt = 0u; mine = 0u;
#pragma unroll
        for (unsigned j = 0; j < 16; ++j) { const unsigned c = xb_ld(&bar[XB_XCNT(j)]); sum += c; cnt += (c > 0u) ? 1u : 0u; mine = (j == x) ? c : mine; }
        if (sum == G) break;
        __builtin_amdgcn_s_sleep(1);
        if ((++sp & 255u) == 0u) { if (xb_ld(&bar[XB_TMO])) break; if (sp > XB_SPIN_CAP) { atomicAdd(&bar[XB_TMO], 1u); break; } }
    }
    nloc = mine > 0u ? mine : 1u; nx = cnt > 0u ? cnt : 1u;
}

__device__ __forceinline__ void xcd_barrier(const XcdBarrier& b) {
    asm volatile("s_waitcnt vmcnt(0)" ::: "memory");
    __syncthreads();
    if (threadIdx.x == 0) {
        unsigned* bar = b.bar;
        __builtin_amdgcn_s_waitcnt(0);
        unsigned nloc = b.st[0], nx = b.st[1];
        if (nloc == 0u) { xcd_barrier_complete(bar, b.x, nloc, nx); b.st[0] = nloc; b.st[1] = nx; }
        const unsigned old = xb_add(&bar[XB_XSUB(b.x)], 1u);
        const unsigned gen = old / nloc;
        if (old + 1u == (gen + 1u) * nloc) {
            __builtin_amdgcn_fence(__ATOMIC_RELEASE, "agent");
            asm volatile("s_waitcnt vmcnt(0)" ::: "memory");
            const unsigned og = xb_add(&bar[XB_TOP], 1u);
            const unsigned tg = og / nx;
            if (og + 1u == (tg + 1u) * nx) xb_add(&bar[XB_TOPGEN], 1u);
            else XB_SPIN(xb_ld(&bar[XB_TOPGEN]) == tg, bar);
            __builtin_amdgcn_fence(__ATOMIC_ACQUIRE, "agent");
            xb_add(&bar[XB_XGEN(b.x)], 1u);
            asm volatile("s_waitcnt vmcnt(0)" ::: "memory");
        } else {
            XB_SPIN(xb_ld(&bar[XB_XGEN(b.x)]) == gen, bar);
            __builtin_amdgcn_fence(__ATOMIC_ACQUIRE, "agent");
            asm volatile("s_waitcnt vmcnt(0)" ::: "memory");
        }
    }
    __syncthreads();
}

namespace pg8 {
#define PG8_LAS LAS
constexpr int BM = 256, BK = 64, HALF = 128, HTB = HALF * BK * 2  , STAGE_BYTES = 8 * HTB, NXCD = 8, WGM = 8;

__host__ __device__ __forceinline__ int lds_byte(int r, int c) { const int st = (r >> 4) * 2 + (c >> 5), rr = r & 15, cc = c & 31, ob = rr * 64 + cc * 2; return st * 1024 + (ob ^ (((ob >> 9) & 1) << 5)); }
__host__ __device__ __forceinline__ void stage_rc(int b, int& R, int& C) { const int st = b / 1024, sb = b % 1024, swz = sb ^ (((sb >> 9) & 1) << 5); R = (st >> 1) * 16 + swz / 64; C = (st & 1) * 32 + (swz % 64) / 2; }
__host__ __device__ __forceinline__ int perm32(int rho) { const int n = rho >> 4, i = rho & 15; return 8 * (i >> 2) + 4 * n + (i & 3); }

struct Unit { int pm, pn; size_t ka, kb; };
struct Gemm { const bf16_t* A; const bf16_t* Bt; int M, N, K, lda, ldb; };

struct StaticOrder {
    int nM, nN, nwg, G, c;
    __host__ __device__ void init(int M, int N, int G_, int c_) { nM = M / BM; nN = N / BM; nwg = nM * nN; G = G_; c = c_; }
    __host__ __device__ bool next(int i, Unit& u) const {
        const long L = (long)i * G + c; if (L >= nwg) return false;
        int wgid = (int)L; { const int q = nwg / NXCD, r = nwg % NXCD, xcd = wgid % NXCD, off = wgid / NXCD; wgid = (xcd < r ? xcd * (q + 1) : r * (q + 1) + (xcd - r) * q) + off; }
        const int nig = WGM * nN, gid = wgid / nig, fm = gid * WGM, gsz = (nM - fm) < WGM ? (nM - fm) : WGM;
        u.pm = fm + ((wgid % nig) % gsz); u.pn = (wgid % nig) / gsz; u.ka = 0; u.kb = 0; return true;
    }
    __device__ __forceinline__ void a_ready(const Unit&) const {}
    __device__ __forceinline__ void done(const Unit&) const {}
};
template <class Epi, class Sched, bool STAMP = false>
__device__ __forceinline__ void gemm_phase(PG8_LAS unsigned char* lds, const Gemm g, const Sched& S, const Epi& E, unsigned long long* stamps) {
    const int tid = ltid(), wid = __builtin_amdgcn_readfirstlane(tid >> 6), lane = tid & 63, wr = wid >> 2, wc = wid & 3, fr = lane & 15, fq = lane >> 4;
    const int K = g.K, nt = K / BK;
    int ts_lo = 0, ts_hi = 0, nts = 0; const unsigned long long rt_entry = STAMP ? (unsigned long long)wall_clock64() : 0ull;
#define PG8_STAMP() do { if (STAMP && wid == 0 && nts < 64) { const unsigned long long _c = (unsigned long long)clock64(); \
        ts_lo = (lane == nts) ? (int)(unsigned)_c : ts_lo; ts_hi = (lane == nts) ? (int)(unsigned)(_c >> 32) : ts_hi; ++nts; } } while (0)
    PG8_STAMP();
    unsigned voffA[2], voffB[2];
#pragma unroll
    for (int i = 0; i < 2; ++i) { int R, C; stage_rc(tid * 16 + i * 8192, R, C); const int Rb = Epi::PERM ? ((R & ~31) + perm32(R & 31)) : R;
        voffA[i] = (unsigned)(R * g.lda + C) * 2u; voffB[i] = (unsigned)(Rb * g.ldb + C) * 2u; }
    const size_t kstep = (size_t)(BK * 2);
    const size_t hstepA = (size_t)HALF * g.lda * 2, hstepB = (size_t)HALF * g.ldb * 2;
    const size_t tstepA = 2 * hstepA, tstepB = 2 * hstepB;
    const unsigned ldsw = (unsigned)wid * 1024u;
    const int aoff = lds_byte(wr * 64 + fr, fq * 8), boff = lds_byte(wc * 32 + fr, fq * 8);
#define PG8_SA(b, h) (((b) * 2 + (h)) * HTB)
#define PG8_SB(b, h) ((4 + (b) * 2 + (h)) * HTB)
#define PG8_STAGE(bufoff, gbase, voff) do { _Pragma("unroll") for (int _i = 0; _i < 2; ++_i) \
        __builtin_amdgcn_global_load_lds((const unsigned*)((const char*)(gbase) + (voff)[_i]), (PG8_LAS unsigned*)(lds + (bufoff) + ldsw + _i * 8192), 16, 0, 0); } while (0)
#define PG8_LDA(dst, b, h) do { _Pragma("unroll") for (int m = 0; m < 4; ++m) _Pragma("unroll") for (int k = 0; k < 2; ++k) dst[m][k] = *(const PG8_LAS bf16x8*)(lds + PG8_SA(b, h) + aoff + m * 2048 + k * 1024); } while (0)
#define PG8_LDB(dst, b, h) do { _Pragma("unroll") for (int n = 0; n < 2; ++n) _Pragma("unroll") for (int k = 0; k < 2; ++k) dst[n][k] = *(const PG8_LAS bf16x8*)(lds + PG8_SB(b, h) + boff + n * 2048 + k * 1024); } while (0)
#define PG8_MMA(ai, bj, At, Bt) do { __builtin_amdgcn_s_setprio(1); _Pragma("unroll") for (int m = 0; m < 4; ++m) _Pragma("unroll") for (int n = 0; n < 2; ++n) _Pragma("unroll") for (int k = 0; k < 2; ++k) \
        acc[ai][bj][m][n] = __builtin_amdgcn_mfma_f32_16x16x32_bf16(Bt[n][k], At[m][k], acc[ai][bj][m][n], 0, 0, 0); __builtin_amdgcn_s_setprio(0); } while (0)
#define PG8_WAIT_V(n) asm volatile("s_waitcnt vmcnt(" #n ")" ::: "memory")
#define PG8_WAIT_L(n) asm volatile("s_waitcnt lgkmcnt(" #n ")" ::: "memory")
#define PG8_BAR __builtin_amdgcn_s_barrier()
#define PG8_SCHED __builtin_amdgcn_sched_barrier(0)
    Unit cur, nxt; int ui = 0;
    if (!S.next(0, cur)) return;
    f32x4 acc[2][2][4][2];
#pragma unroll
    for (int a = 0; a < 2; ++a)
#pragma unroll
        for (int b = 0; b < 2; ++b)
#pragma unroll
            for (int m = 0; m < 4; ++m)
#pragma unroll
                for (int n = 0; n < 2; ++n) acc[a][b][m][n] = (f32x4){0.f, 0.f, 0.f, 0.f};
    bf16x8 At[4][2], B0[2][2], B1[2][2];
    const char* cA = (const char*)g.A + (size_t)cur.pm * tstepA + cur.ka * 2; const char* cB = (const char*)g.Bt + (size_t)cur.pn * tstepB + cur.kb * 2;
    S.a_ready(cur);
    PG8_STAGE(PG8_SB(0, 0), cB, voffB); PG8_STAGE(PG8_SA(0, 0), cA, voffA); PG8_STAGE(PG8_SB(0, 1), cB + hstepB, voffB); PG8_STAGE(PG8_SA(0, 1), cA + hstepA, voffA);
    if (wr == 1) PG8_BAR;
    PG8_WAIT_V(4); PG8_BAR;
    PG8_STAGE(PG8_SB(1, 0), cB + kstep, voffB); PG8_STAGE(PG8_SA(1, 0), cA + kstep, voffA); PG8_STAGE(PG8_SB(1, 1), cB + hstepB + kstep, voffB);
    PG8_WAIT_V(6); PG8_BAR;
    PG8_STAMP();
    for (;;) {
        const bool has_next = S.next(ui + 1, nxt);
        const char* nA = has_next ? (const char*)g.A + (size_t)nxt.pm * tstepA + nxt.ka * 2 : cA; const char* nB = has_next ? (const char*)g.Bt + (size_t)nxt.pn * tstepB + nxt.kb * 2 : cB;
        for (int t = 0; t < nt; t += 2) {
            const bool last = (t == nt - 2);
            const char* a1 = cA + (size_t)(t + 1) * kstep;
            const char* a2 = last ? nA : cA + (size_t)(t + 2) * kstep; const char* b2 = last ? nB : cB + (size_t)(t + 2) * kstep;
            const char* a3 = a2 + kstep; const char* b3 = b2 + kstep;
            if (last && has_next) S.a_ready(nxt);
            PG8_LDB(B0, 0, 0); PG8_SCHED; PG8_LDA(At, 0, 0); PG8_STAGE(PG8_SA(1, 1), a1 + hstepA, voffA);
            PG8_WAIT_L(8); PG8_BAR; PG8_WAIT_L(0); PG8_MMA(0, 0, At, B0); PG8_BAR; PG8_SCHED;
            PG8_LDB(B1, 0, 1); PG8_STAGE(PG8_SB(0, 0), b2, voffB);
            PG8_BAR; PG8_WAIT_L(0); PG8_MMA(0, 1, At, B1); PG8_BAR;
            PG8_LDA(At, 0, 1); PG8_STAGE(PG8_SA(0, 0), a2, voffA);
            PG8_BAR; PG8_WAIT_L(0); PG8_MMA(1, 0, At, B0); PG8_BAR; PG8_SCHED;
            PG8_STAGE(PG8_SB(0, 1), b2 + hstepB, voffB);
            PG8_WAIT_V(6); PG8_BAR; PG8_MMA(1, 1, At, B1); PG8_BAR;
            PG8_LDB(B0, 1, 0); PG8_SCHED; PG8_LDA(At, 1, 0); PG8_STAGE(PG8_SA(0, 1), a2 + hstepA, voffA);
            PG8_WAIT_L(8); PG8_BAR; PG8_WAIT_L(0); PG8_MMA(0, 0, At, B0); PG8_BAR; PG8_SCHED;
            PG8_LDB(B1, 1, 1); PG8_STAGE(PG8_SB(1, 0), b3, voffB);
            PG8_BAR; PG8_WAIT_L(0); PG8_MMA(0, 1, At, B1); PG8_BAR;
            PG8_LDA(At, 1, 1); PG8_STAGE(PG8_SA(1, 0), a3, voffA);
            PG8_BAR; PG8_WAIT_L(0); PG8_MMA(1, 0, At, B0); PG8_BAR; PG8_SCHED;
            PG8_STAGE(PG8_SB(1, 1), b3 + hstepB, voffB);
            PG8_WAIT_V(6); PG8_BAR; PG8_MMA(1, 1, At, B1); PG8_BAR;
        }
        PG8_STAMP();
        if constexpr (!Epi::AFTER_DRAIN) { E(acc, cur, wr, wc, fr, fq); S.done(cur); }
        PG8_STAMP();
        if (!has_next) break;
#pragma unroll
        for (int a = 0; a < 2; ++a)
#pragma unroll
            for (int b = 0; b < 2; ++b)
#pragma unroll
                for (int m = 0; m < 4; ++m)
#pragma unroll
                    for (int n = 0; n < 2; ++n) acc[a][b][m][n] = (f32x4){0.f, 0.f, 0.f, 0.f};
        cur = nxt; cA = nA; cB = nB; ++ui;
    }
    PG8_WAIT_V(0);
    if (wr == 0) PG8_BAR;
    PG8_BAR;
    if constexpr (Epi::AFTER_DRAIN) { E.fused(acc, cur, wr, wc, fr, fq, lds, wid, lane); S.done(cur); }
    PG8_STAMP();
    if (STAMP && wid == 0) { stamps[lane] = lane < nts ? (((unsigned long long)(unsigned)ts_hi << 32) | (unsigned)ts_lo) : 0ull;
        if (lane == 62) stamps[62] = rt_entry; if (lane == 63) stamps[63] = (unsigned long long)wall_clock64(); }
#undef PG8_STAMP
#undef PG8_SA
#undef PG8_SB
#undef PG8_STAGE
#undef PG8_LDA
#undef PG8_LDB
#undef PG8_MMA
#undef PG8_WAIT_V
#undef PG8_WAIT_L
#undef PG8_BAR
#undef PG8_SCHED
}
}

namespace pg8 {
struct EpiZ {
    static constexpr bool PERM = true, AFTER_DRAIN = false;
    bf16_t* O; int ldc;
    DI void operator()(const f32x4 (&acc)[2][2][4][2], const Unit& u, int wr, int wc, int fr, int fq) const {
        const int row0 = u.pm * BM + wr * 64 + fr, col0 = u.pn * BM + wc * 32 + 8 * fq;
#pragma unroll
        for (int ai = 0; ai < 2; ++ai)
#pragma unroll
            for (int m = 0; m < 4; ++m) { bf16_t* rowp = O + (size_t)(row0 + ai * HALF + m * 16) * ldc + col0;
#pragma unroll
                for (int bj = 0; bj < 2; ++bj) { const f32x4 v0 = acc[ai][bj][m][0], v1 = acc[ai][bj][m][1];
                    u32x4 w; w.x = pk2(v0[0], v0[1]); w.y = pk2(v0[2], v0[3]); w.z = pk2(v1[0], v1[1]); w.w = pk2(v1[2], v1[3]);
                    *(u32x4*)(rowp + bj * HALF) = w; } }
    }
};
struct EpiHid {
    static constexpr bool PERM = true, AFTER_DRAIN = false;
    bf16_t* O; const float* bias;
    DI void operator()(const f32x4 (&acc)[2][2][4][2], const Unit& u, int wr, int wc, int fr, int fq) const {
        const int row0 = u.pm * BM + wr * 64 + fr, col0 = wc * 32 + 8 * fq;
        const float* b = bias + (u.pm >> 6) * 256;
        f32x4 bv[2][2];
#pragma unroll
        for (int bj = 0; bj < 2; ++bj)
#pragma unroll
            for (int n = 0; n < 2; ++n) bv[bj][n] = *(const f32x4*)(b + col0 + bj * HALF + 4 * n);
#pragma unroll
        for (int ai = 0; ai < 2; ++ai)
#pragma unroll
            for (int m = 0; m < 4; ++m) { bf16_t* rowp = O + (size_t)(row0 + ai * HALF + m * 16) * 256 + col0;
#pragma unroll
                for (int bj = 0; bj < 2; ++bj) { f32x4 v0 = acc[ai][bj][m][0] + bv[bj][0], v1 = acc[ai][bj][m][1] + bv[bj][1];
#pragma unroll
                    for (int j = 0; j < 4; ++j) { v0[j] = gelu_tanh(v0[j]); v1[j] = gelu_tanh(v1[j]); }
                    u32x4 w; w.x = pk2(v0[0], v0[1]); w.y = pk2(v0[2], v0[3]); w.z = pk2(v1[0], v1[1]); w.w = pk2(v1[2], v1[3]);
                    *(u32x4*)(rowp + bj * HALF) = w; } }
    }
};
struct EpiY {
    static constexpr bool PERM = false, AFTER_DRAIN = false;
    const float* X; float* Y; const float* gate;
    DI void operator()(const f32x4 (&acc)[2][2][4][2], const Unit& u, int wr, int wc, int fr, int fq) const {
        const int row0 = u.pm * BM + wr * 64 + fr, col0 = u.pn * BM + wc * 32 + 4 * fq;
        const float* g = gate + (size_t)((u.pm * BM) / SEQ) * 6144 + 4096;
        f32x4 gv[2][2];
#pragma unroll
        for (int bj = 0; bj < 2; ++bj)
#pragma unroll
            for (int n = 0; n < 2; ++n) gv[bj][n] = *(const f32x4*)(g + col0 + bj * HALF + n * 16);
#pragma unroll
        for (int ai = 0; ai < 2; ++ai)
#pragma unroll
            for (int m = 0; m < 4; ++m) { const size_t off = (size_t)(row0 + ai * HALF + m * 16) * DM + col0;
#pragma unroll
                for (int bj = 0; bj < 2; ++bj)
#pragma unroll
                    for (int n = 0; n < 2; ++n) { const f32x4 x = *(const f32x4*)(X + off + bj * HALF + n * 16);
                        *(f32x4*)(Y + off + bj * HALF + n * 16) = x + gv[bj][n] * acc[ai][bj][m][n]; }
                asm volatile("" ::: "memory"); }
    }
};
struct OrderCmpS {
    int G, c;
    DI bool next(int i, Unit& u) const { const int L = i * G + c; if (L >= 256) return false; u.pm = L; u.pn = 0; u.ka = 0; u.kb = (size_t)(L >> 6) * 256 * 4096; return true; }
    DI void a_ready(const Unit&) const {}
    DI void done(const Unit&) const {}
};
}

template <int MT, int NT, class AF, class BF, class EP>
DI void thin_gemm_block(LAS unsigned char* lds, int K, AF aptr, BF bptr, EP ep) {
    const int tid = ltid(), w = tid >> 6, lane = tid & 63, li = lane & 15, quad = lane >> 4;
    const int kw = K / 8, kb = w * kw;
    f32x4 acc[MT][NT];
#pragma unroll
    for (int i = 0; i < MT; ++i)
#pragma unroll
        for (int j = 0; j < NT; ++j) acc[i][j] = (f32x4){0.f, 0.f, 0.f, 0.f};
    const bf16_t* ap[MT]; const bf16_t* bp[NT];
#pragma unroll
    for (int i = 0; i < MT; ++i) ap[i] = aptr(i * 16 + li) + kb + quad * 8;
#pragma unroll
    for (int j = 0; j < NT; ++j) bp[j] = bptr(j * 16 + li) + kb + quad * 8;
#pragma unroll 2
    for (int k = 0; k < kw; k += 32) {
        bf16x8 af[MT], bf[NT];
#pragma unroll
        for (int i = 0; i < MT; ++i) af[i] = ld8(ap[i] + k);
#pragma unroll
        for (int j = 0; j < NT; ++j) bf[j] = ld8(bp[j] + k);
#pragma unroll
        for (int i = 0; i < MT; ++i)
#pragma unroll
            for (int j = 0; j < NT; ++j) acc[i][j] = mfma16(af[i], bf[j], acc[i][j]);
    }
    LAS float* part = (LAS float*)lds;
#pragma unroll
    for (int i = 0; i < MT; ++i)
#pragma unroll
        for (int j = 0; j < NT; ++j)
#pragma unroll
            for (int e = 0; e < 4; ++e) part[((w * MT * NT + i * NT + j) * 4 + e) * 64 + lane] = acc[i][j][e];
    __syncthreads();
    for (int x = tid; x < MT * NT * 256; x += 512) {
        const int tile = x >> 8, r = x & 255, e = r >> 6, ln = r & 63;
        float s = 0.f;
#pragma unroll
        for (int ww = 0; ww < 8; ++ww) s += part[((ww * MT * NT + tile) * 4 + e) * 64 + ln];
        ep((tile / NT) * 16 + (ln >> 4) * 4 + e, (tile % NT) * 16 + (ln & 15), s);
    }
    __syncthreads();
}

DI int win_col(int n) {
    if (n < 2560) return n; if (n < 5632) return n + 24; if (n < 6144) return n + 92;
    const int j = n - 6144; if (j < 64) return 5656 + j; if (j < 88) return 2560 + (j - 64); if (j < 92) return 5720 + (j - 88); return -1;
}
template <class CM>
DI void transpose_tile(LAS float* tile, const float* src, size_t src_ld, bf16_t* dst, size_t dst_ld, int k0, int n0, int nmax, int KT, CM colmap) {
    const int tid = ltid();
    { const int c = tid & 63, kq = tid >> 6, n = n0 + c; const int sc = (n < nmax) ? colmap(n) : -1;
      float v[32];
#pragma unroll
      for (int i = 0; i < 32; ++i) v[i] = (sc >= 0 && i < KT * 8) ? src[(size_t)(k0 + kq + 8 * i) * src_ld + sc] : 0.f;
#pragma unroll
      for (int i = 0; i < 32; ++i) if (i < KT * 8) tile[(kq + 8 * i) * 65 + c] = v[i]; }
    __syncthreads();
    { const int nn = tid >> 3, k8 = tid & 7;
      if (n0 + nn < nmax) {
          for (int kt = 0; kt < KT; ++kt) { float v[8];
#pragma unroll
              for (int i = 0; i < 8; ++i) v[i] = tile[(kt * 64 + k8 * 8 + i) * 65 + nn];
              u32x4 w; w.x = pk2(v[0], v[1]); w.y = pk2(v[2], v[3]); w.z = pk2(v[4], v[5]); w.w = pk2(v[6], v[7]);
              *(u32x4*)(dst + (size_t)(n0 + nn) * dst_ld + k0 + kt * 64 + k8 * 8) = w; } } }
    __syncthreads();
}

DI void transpose_tile_w1g(LAS float* tile, const float* src, bf16_t* dstg, int k0, int n0, int prow) {
    const int tid = ltid();
    { const int c = tid & 63, kq = tid >> 6;
      float v[32];
#pragma unroll
      for (int i = 0; i < 32; ++i) v[i] = src[(size_t)(k0 + kq + 8 * i) * 256 + n0 + c];
#pragma unroll
      for (int i = 0; i < 32; ++i) tile[(kq + 8 * i) * 65 + c] = v[i]; }
    __syncthreads();
    { const int nn = tid >> 3, k8 = tid & 7;
      for (int kt = 0; kt < 4; ++kt) { float v[8];
#pragma unroll
          for (int i = 0; i < 8; ++i) v[i] = tile[(kt * 64 + k8 * 8 + i) * 65 + nn];
          u32x4 w; w.x = pk2(v[0], v[1]); w.y = pk2(v[2], v[3]); w.z = pk2(v[4], v[5]); w.w = pk2(v[6], v[7]);
          const int k = k0 + kt * 64 + k8 * 8;
          *(u32x4*)(dstg + ((size_t)(k >> 5) * 512 + prow + n0 + nn) * 32 + (k & 31)) = w; } }
    __syncthreads();
}

constexpr int PJ_WIN = 2 * 98 * 8, PJ_WOUT = 2 * 32 * 8, PJ_W1 = 4 * 4 * 16, PJ_W2 = 4 * 2, PJ_PW = 8 * 2;
constexpr int PJ_T_END = PJ_WIN + PJ_WOUT + PJ_W1 + PJ_W2 + PJ_PW;
#ifndef CMP_DIRECT
#define CMP_DIRECT 1
#endif
#if CMP_DIRECT
constexpr int PJ_MOD = 96, PJ_CB = 16, PJ_ACV = 256, PJ_BT = 1;
#else
constexpr int PJ_MOD = 96, PJ_CB = 16, PJ_ACV = 2048, PJ_BT = 1;
#endif
constexpr int PJ_TOTAL = PJ_T_END + PJ_MOD + PJ_CB + PJ_ACV + PJ_BT;

DI void mod_unit(ArgsP a, LAS unsigned char* lds, int u) {
    const int tid = ltid();
        const int l = u / 48, cg = u % 48;
        LAS float* sil = (LAS float*)lds; LAS float* red = sil + 10 * 2048;
        for (int i = tid; i < 10 * 2048; i += 512) { const int r = i >> 11, k = i & 2047; const float c = (r < 2) ? a->in[I_CP][r * DM + k] : a->in[I_CSM][(r - 2) * DM + k]; sil[i] = siluf_(c); }
        __syncthreads();
        const int ks = tid >> 6, ln = tid & 63;
        f32x2 acc[10];
#pragma unroll
        for (int r = 0; r < 10; ++r) acc[r] = (f32x2){0.f, 0.f};
        const float* wp = a->in[I_WADA] + (size_t)l * DM * 6144 + cg * 128 + ln * 2;
#pragma unroll 1
        for (int k0 = ks * 256; k0 < ks * 256 + 256; k0 += 16) {
            f32x2 wv[16];
#pragma unroll
            for (int j = 0; j < 16; ++j) wv[j] = __builtin_nontemporal_load((const f32x2*)(wp + (size_t)(k0 + j) * 6144));
#pragma unroll
            for (int j4 = 0; j4 < 4; ++j4)
#pragma unroll
                for (int r = 0; r < 10; ++r) { const f32x4 sv = *(const LAS f32x4*)(sil + r * 2048 + k0 + j4 * 4);
#pragma unroll
                    for (int j = 0; j < 4; ++j) acc[r] += wv[j4 * 4 + j] * sv[j]; }
        }
#pragma unroll
        for (int r = 0; r < 10; ++r) *(LAS f32x2*)(red + (ks * 10 + r) * 128 + ln * 2) = acc[r];
        __syncthreads();
        for (int i = tid; i < 1280; i += 512) { const int r = i >> 7, c2 = i & 127; float s = 0.f;
#pragma unroll
            for (int k2 = 0; k2 < 8; ++k2) s += red[(k2 * 10 + r) * 128 + c2];
            ((float*)(a->ws + WS_MOD))[(size_t)(l * 10 + r) * 6144 + cg * 128 + c2] = s + a->in[I_BADA][l * 6144 + cg * 128 + c2]; }
        __syncthreads();
}

DI void prologue_unit(ArgsP a, LAS unsigned char* lds, int u) {
    const int tid = ltid();
    LAS float* tile = (LAS float*)lds;
    auto ident = [](int n) { return n; };
    if (u < PJ_WIN) { const int l = u / 784, r = u % 784, nt = r / 8, kt = r % 8;
        transpose_tile(tile, a->in[I_WIN] + (size_t)l * DM * NIN, NIN, (bf16_t*)(a->ws + WS_WINT) + (size_t)l * WIN_ROWS * DM, DM, kt * 256, nt * 64, WIN_ROWS, 4, [](int n) { return win_col(n); });
        return; }
    u -= PJ_WIN;
    if (u < PJ_WOUT) { const int l = u / 256, r = u % 256, nt = r / 8, kt = r % 8;
        transpose_tile(tile, a->in[I_WOUT] + (size_t)l * DM * DM, DM, (bf16_t*)(a->ws + WS_WOUTT) + (size_t)l * DM * DM, DM, kt * 256, nt * 64, DM, 4, ident);
        return; }
    u -= PJ_WOUT;
    if (u < PJ_W1) { const int g = u / 64, r = u % 64, nt = r / 16, kt = r % 16;
        transpose_tile(tile, a->in[I_W1] + (size_t)g * 4096 * 256, 256, (bf16_t*)(a->ws + WS_W1T) + (size_t)g * 256 * 4096, 4096, kt * 256, nt * 64, 256, 4, ident);
        return; }
    u -= PJ_W1;
    if (u < PJ_W2) { const int g = u / 2, nt = u % 2;
        transpose_tile(tile, a->in[I_W2] + (size_t)g * 256 * 128, 128, (bf16_t*)(a->ws + WS_W2T) + (size_t)g * 128 * 256, 256, 0, nt * 64, 128, 4, ident);
        return; }
    u -= PJ_W2;
    if (u < PJ_PW) { const int g = u / 2, nt = u % 2;
        transpose_tile(tile, a->in[I_PW] + (size_t)g * 128 * 128, 128, (bf16_t*)(a->ws + WS_PWT) + (size_t)g * 128 * 128, 128, 0, nt * 64, 128, 2, ident);
        return; }
    u -= PJ_PW;
    if (u < PJ_MOD) { mod_unit(a, lds, u); return; }
    u -= PJ_MOD;
    if (u < PJ_CB) {
        const int g = u / 4, cg = u % 4;
        LAS float* pe = (LAS float*)lds; LAS float* red = pe + 4096;
        for (int i = tid; i < 4096; i += 512) pe[i] = a->in[I_PE][(size_t)g * 4096 + i];
        __syncthreads();
        const int ks = tid >> 6, cc = tid & 63, col = cg * 64 + cc;
        const float* wp = a->in[I_W1] + (size_t)g * 4096 * 256 + col;
        float acc = 0.f;
#pragma unroll 8
        for (int k = ks * 512; k < ks * 512 + 512; ++k) acc += pe[k] * wp[(size_t)k * 256];
        red[ks * 64 + cc] = acc;
        __syncthreads();
        if (tid < 64) { float s = 0.f;
#pragma unroll
            for (int k2 = 0; k2 < 8; ++k2) s += red[k2 * 64 + tid];
            ((float*)(a->ws + WS_CBIAS))[g * 256 + cg * 64 + tid] = s + a->in[I_B1][g * 256 + cg * 64 + tid]; }
        __syncthreads();
        return; }
    u -= PJ_CB;
#if CMP_DIRECT
    if (u < PJ_ACV) {
        const int g = u >> 6, r = u & 63, pp = r >> 5, nt = (r >> 3) & 3, kt = r & 7;
        transpose_tile_w1g(tile, a->in[I_W1] + (size_t)g * 4096 * 256 + (size_t)pp * 2048 * 256, (bf16_t*)(a->ws + WS_W1G) + (size_t)g * 512 * 2048, kt * 256, nt * 64, pp * 256);
        return; }
#else
    if (u < PJ_ACV) {
        const int l = u / 1024, r = u % 1024, b = r / 128, pi = r % 128;
        const int page = a->page_table[b * NPAGES + pi];
        const float* src = a->in[I_CA] + ((size_t)(l * NPOOL + page) * PAGE) * 1024;
        bf16_t* dst = (bf16_t*)(a->ws + WS_ACMPS);
        const int f4 = tid & 127, rq = tid >> 7;
        const int kv = f4 >> 6, kvh = (f4 >> 5) & 1, d = (f4 & 31) * 4;
        for (int r0 = rq; r0 < 128; r0 += 32) {
            f32x4 v[8];
#pragma unroll
            for (int i = 0; i < 8; ++i) v[i] = __builtin_nontemporal_load((const f32x4*)(src + (size_t)(r0 + 4 * i) * 1024 + f4 * 4));
#pragma unroll
            for (int i = 0; i < 8; ++i) { const int rr = r0 + 4 * i;
                const size_t m = ((size_t)((l * 2 + kv) * 16 + b * 2 + kvh)) * 1024 + pi * 8 + (rr >> 4);
                u32x2 w; w.x = pk2(v[i][0], v[i][1]); w.y = pk2(v[i][2], v[i][3]);
                *(u32x2*)(dst + m * 2048 + (rr & 15) * 128 + d) = w; }
        }
        return; }
#endif
    u -= PJ_ACV;
    {
        float* bt = (float*)(a->ws + WS_BIAS);
        if (tid < 129) { const int bk = t5_bucket(tid);
            for (int h = 0; h < 8; ++h) bt[tid * 8 + h] = a->in[I_RB][bk * 12 + h] * LOG2E;
            for (int h = 0; h < 4; ++h) bt[129 * 8 + tid * 4 + h] = a->in[I_RB][bk * 12 + 8 + h] * LOG2E; }
        if (tid >= 192 && tid < 200) { const int l = (tid - 192) >> 2, j = (tid - 192) & 3; const float* gp = j < 3 ? a->in[I_AKN] + (size_t)(l * 3 + j) * 128 : a->in[I_CKN] + l * 128;
            float m = 0.f; for (int d = 0; d < 128; ++d) m = fmaxf(m, fabsf(gp[d])); bt[1600 + l * 4 + j] = m; }
        if (tid == 256 || tid == 257) { float m = 0.f; const int h0 = tid == 256 ? 0 : 8, h1 = tid == 256 ? 8 : 12;
            for (int bk = 0; bk < 32; ++bk) for (int h = h0; h < h1; ++h) m = fmaxf(m, fabsf(a->in[I_RB][bk * 12 + h])); bt[1608 + (tid - 256)] = m * LOG2E; }
    }
}

constexpr int CG_ROWS = 64, CG_UNITS = 65536 / CG_ROWS;
constexpr int CG_AP = 80;
constexpr int CG_A = 0, CG_B = 2 * CG_ROWS * CG_AP * 2;
DI void cmp_gemm_direct(ArgsP a, LAS unsigned char* lds, int u) {
    const int tid = ltid(), w = __builtin_amdgcn_readfirstlane(tid >> 6), lane = tid & 63, li = lane & 15, quad = lane >> 4;
    const int grp = u >> 8, ub = (u >> 5) & 7, c0u = (u & 31) * 32, l = grp >> 1, kv = grp & 1;
    LAS bf16_t* As = (LAS bf16_t*)(lds + CG_A);
    if (w >= 4) {
        const int tl = tid - 256, ar = tl >> 3, aq = tl & 7;
        const int c = c0u + ar;
        const float* arow = a->in[I_CA] + ((size_t)(l * NPOOL + a->page_table[ub * NPAGES + (c >> 3)]) * PAGE + (c & 7) * 16) * 1024 + kv * 256 + aq * 4;
        f32x4 st[6][4];
        auto req = [&](int s, f32x4 (&v)[4]) { if (s < 32) { const float* p = arow + (size_t)(s >> 1) * 1024 + (s & 1) * 64;
#pragma unroll
            for (int i = 0; i < 4; ++i) v[i] = __builtin_nontemporal_load((const f32x4*)(p + (i >> 1) * 128 + (i & 1) * 32)); } };
        auto put = [&](int s, const f32x4 (&v)[4]) { if (s < 32) {
#pragma unroll
            for (int i = 0; i < 4; ++i) { u32x2 wv; wv.x = pk2(v[i][0], v[i][1]); wv.y = pk2(v[i][2], v[i][3]);
                *(LAS u32x2*)(As + ((s & 1) * CG_ROWS + (i >> 1) * 32 + ar) * CG_AP + ((i & 1) * 8 + aq) * 4) = wv; } } };
#pragma unroll
        for (int s = 0; s < 6; ++s) req(s, st[s]);
        put(0, st[0]); req(6, st[0]);
        lds_barrier();
#pragma unroll
        for (int s = 0; s < 32; ++s) { put(s + 1, st[(s + 1) % 6]); req(s + 7, st[(s + 1) % 6]); lds_barrier(); }
    } else {
        const bf16_t* bsrc = (const bf16_t*)(a->ws + WS_W1G) + (size_t)grp * 512 * 2048 + (size_t)(w * 128 + (lane >> 2)) * 32 + ((lane & 3) ^ ((lane >> 4) & 2)) * 8;
        LAS unsigned char* bring = lds + CG_B + w * 8192;
        const unsigned bfo = (unsigned)(CG_B + w * 8192 + (li * 4 + (quad ^ ((li >> 2) & 2))) * 16);
        f32x4 acc[4][8];
#pragma unroll
        for (int i = 0; i < 4; ++i)
#pragma unroll
            for (int j = 0; j < 8; ++j) acc[i][j] = (f32x4){0.f, 0.f, 0.f, 0.f};
        auto dma_b = [&](int kt, int buf) { const unsigned* gp = (const unsigned*)(bsrc + (size_t)kt * (512 * 32)); LAS unsigned* lp = (LAS unsigned*)(bring + buf * 32768);
            __builtin_amdgcn_global_load_lds(gp, lp, 16, 0, 0); __builtin_amdgcn_global_load_lds(gp, lp, 16, 1024, 0);
            __builtin_amdgcn_global_load_lds(gp, lp, 16, 2048, 0); __builtin_amdgcn_global_load_lds(gp, lp, 16, 3072, 0);
            const unsigned* gp2 = gp + 1024; LAS unsigned* lp2 = lp + 1024;
            __builtin_amdgcn_global_load_lds(gp2, lp2, 16, 0, 0); __builtin_amdgcn_global_load_lds(gp2, lp2, 16, 1024, 0);
            __builtin_amdgcn_global_load_lds(gp2, lp2, 16, 2048, 0); __builtin_amdgcn_global_load_lds(gp2, lp2, 16, 3072, 0); };
        int rb = 0;
        dma_b(0, 0); dma_b(1, 1); dma_b(2, 2);
        lds_barrier();
#pragma unroll 1
        for (int s = 0; s < 32; ++s) {
#pragma unroll
            for (int kq = 0; kq < 2; ++kq) {
                const int kt = s * 2 + kq;
                if (kt + 2 < 64) asm volatile("s_waitcnt vmcnt(16)" ::: "memory"); else if (kt + 1 < 64) asm volatile("s_waitcnt vmcnt(8)" ::: "memory"); else asm volatile("s_waitcnt vmcnt(0)" ::: "memory");
                if (kt + 3 < 64) dma_b(kt + 3, (rb + 3) & 3);
                bf16x8 af[4], bf[8];
#pragma unroll
                for (int mt = 0; mt < 4; ++mt) af[mt] = *(const LAS bf16x8*)(As + ((s & 1) * CG_ROWS + mt * 16 + li) * CG_AP + kq * 32 + quad * 8);
#pragma unroll
                for (int nt = 0; nt < 8; ++nt) bf[nt] = *(const LAS bf16x8*)(lds + bfo + rb * 32768 + nt * 1024);
                __builtin_amdgcn_sched_barrier(0);
#pragma unroll
                for (int nt = 0; nt < 8; ++nt)
#pragma unroll
                    for (int mt = 0; mt < 4; ++mt) acc[mt][nt] = mfma16(bf[nt], af[mt], acc[mt][nt]);
                rb = (rb + 1) & 3;
            }
            lds_barrier();
        }
        bf16_t* G = (bf16_t*)(a->ws + WS_G) + ((size_t)grp * 16384 + (size_t)ub * 2048 + c0u) * 512 + w * 128;
#pragma unroll
        for (int mt = 0; mt < 4; ++mt)
#pragma unroll
            for (int nt = 0; nt < 8; ++nt) { u32x2 o; o.x = pk2(acc[mt][nt][0], acc[mt][nt][1]); o.y = pk2(acc[mt][nt][2], acc[mt][nt][3]);
                *(u32x2*)(G + (size_t)((mt >> 1) * 1024 + (mt & 1) * 16 + li) * 512 + nt * 16 + quad * 4) = o; }
    }
    __syncthreads();
}

DI void cmp2_sample_rows(ArgsP a, int m0);
DI void cmp2_sample_unit(ArgsP a, int u) { cmp2_sample_rows(a, (u * 8 + (ltid() >> 6)) * 16); }
DI int cg_unit_row(int u, int kvh) { return (u >> 8) * 16384 + (((u >> 5) & 7) * 2 + kvh) * 1024 + (u & 31) * 32; }
DI void cmp2_sample_own(ArgsP a, int u) { const int w = ltid() >> 6; if (w < 2) cmp2_sample_rows(a, cg_unit_row(u, w)); }
DI void cmp2_sample_tail(ArgsP a) { for (int x = blockIdx.x * 8 + (ltid() >> 6); x < CG_UNITS * 2; x += gridDim.x * 8) cmp2_sample_rows(a, cg_unit_row(x >> 1, x & 1) + 16); }
DI void cmp2_sample_rows(ArgsP a, int m0) {
    const int tid = ltid(), lane = tid & 63, li = lane & 15, quad = lane >> 4;
    const int grp = m0 >> 14, l = grp >> 1, kv = grp & 1, g = (m0 >> 10) & 15, i0 = m0 & 1023;
    const bf16_t* w2 = (const bf16_t*)(a->ws + WS_W2T) + (size_t)grp * 128 * 256 + (size_t)li * 256 + quad * 8;
    f32x4 acc[8];
#pragma unroll
    for (int nt = 0; nt < 8; ++nt) acc[nt] = (f32x4){0.f, 0.f, 0.f, 0.f};
#if CMP_DIRECT
    const bf16_t* g0 = (const bf16_t*)(a->ws + WS_G) + (size_t)(m0 + li) * 512 + quad * 8;
    const float* cb = (const float*)(a->ws + WS_CBIAS) + grp * 256 + quad * 8;
    bf16x8 hf[8];
#pragma unroll
    for (int kk = 0; kk < 8; ++kk) { float x0[8], x1[8]; unpack8(*(const u32x4*)(g0 + kk * 32), x0); unpack8(*(const u32x4*)(g0 + 512 + 256 + kk * 32), x1);
        const f32x4 c0 = *(const f32x4*)(cb + kk * 32), c1 = *(const f32x4*)(cb + kk * 32 + 4);
        hf[kk] = pack8(gelu_tanh(x0[0] + x1[0] + c0[0]), gelu_tanh(x0[1] + x1[1] + c0[1]), gelu_tanh(x0[2] + x1[2] + c0[2]), gelu_tanh(x0[3] + x1[3] + c0[3]),
                       gelu_tanh(x0[4] + x1[4] + c1[0]), gelu_tanh(x0[5] + x1[5] + c1[1]), gelu_tanh(x0[6] + x1[6] + c1[2]), gelu_tanh(x0[7] + x1[7] + c1[3])); }
#else
    const bf16_t* hid = (const bf16_t*)(a->ws + WS_HIDS) + (size_t)(m0 + li) * 256 + quad * 8;
#endif
#pragma unroll
    for (int kk = 0; kk < 8; ++kk) {
#if CMP_DIRECT
        const bf16x8 af = hf[kk];
#else
        const bf16x8 af = ld8(hid + kk * 32);
#endif
#pragma unroll
        for (int nt = 0; nt < 8; ++nt) acc[nt] = mfma16(af, ld8(w2 + (size_t)nt * 16 * 256 + kk * 32), acc[nt]); }
    const float* b2 = a->in[I_B2] + grp * 128;
#pragma unroll
    for (int nt = 0; nt < 8; ++nt) { const float bb = b2[nt * 16 + li];
#pragma unroll
        for (int e = 0; e < 4; ++e) acc[nt][e] += bb; }
    if (kv == 0) {
        const float* gn = a->in[I_AKN] + (size_t)l * 3 * 128;
        float ss[4];
#pragma unroll
        for (int e = 0; e < 4; ++e) { float s = 0.f;
#pragma unroll
            for (int nt = 0; nt < 8; ++nt) s += acc[nt][e] * acc[nt][e];
            s += __shfl_xor(s, 1); s += __shfl_xor(s, 2); s += __shfl_xor(s, 4); s += __shfl_xor(s, 8);
            ss[e] = rsqrtf(s * (1.0f / 128.0f) + EPS); }
        bf16_t* kc = (bf16_t*)(a->ws + WS_KCS) + ((size_t)(l * 16 + g) * 1024 + i0) * 128;
#pragma unroll
        for (int nt = 0; nt < 8; ++nt) { const float gg = gn[nt * 16 + li];
#pragma unroll
            for (int e = 0; e < 4; ++e) { const int i = quad * 4 + e; kc[(size_t)i * 128 + nt * 16 + li] = (i0 + i < NC_S) ? f2bf(acc[nt][e] * ss[e] * gg) : (bf16_t)0; } }
    } else {
        bf16_t* vt = (bf16_t*)(a->ws + WS_VCST) + (size_t)(l * 16 + g) * 128 * 1024;
#pragma unroll
        for (int nt = 0; nt < 8; ++nt) { float v[4];
#pragma unroll
            for (int e = 0; e < 4; ++e) v[e] = (i0 + quad * 4 + e < NC_S) ? acc[nt][e] : 0.f;
            u32x2 wv; wv.x = pk2(v[0], v[1]); wv.y = pk2(v[2], v[3]);
            *(u32x2*)(vt + (size_t)(nt * 16 + li) * 1024 + i0 + quad * 4) = wv; }
    }
}

DI void l1_rows(ArgsP a, int l) {
    const int lane = ltid() & 63, gw = blockIdx.x * 8 + (ltid() >> 6), nw = gridDim.x * 8;
    const float* ng = a->in[I_NG] + l * DM; const float* modl = (const float*)(a->ws + WS_MOD) + (size_t)l * 10 * 6144;
    bf16_t* H = (bf16_t*)(a->ws + WS_H);
    auto xrow = [&](int r) { return (l == 0) ? (r < NTP ? a->in[I_XP] + (size_t)r * DM : a->in[I_XS] + (size_t)(r - NTP) * DM) : (const float*)(a->ws + WS_Y0) + (size_t)r * DM; };
    f32x4 vn[8];
    if (gw < NTOK) { const float* x = xrow(gw);
#pragma unroll
        for (int i = 0; i < 8; ++i) vn[i] = *(const f32x4*)(x + (i * 64 + lane) * 4); }
    for (int r = gw; r < NTOK; r += nw) {
        const float* md = modl + (size_t)(r < NTP ? r / SEQ : 2 + (r - NTP) / DS) * 6144;
        f32x4 v[8]; float ss = 0.f;
#pragma unroll
        for (int i = 0; i < 8; ++i) { v[i] = vn[i]; ss += v[i][0] * v[i][0] + v[i][1] * v[i][1] + v[i][2] * v[i][2] + v[i][3] * v[i][3]; }
        if (r + nw < NTOK) { const float* x = xrow(r + nw);
#pragma unroll
            for (int i = 0; i < 8; ++i) vn[i] = *(const f32x4*)(x + (i * 64 + lane) * 4); }
        f32x4 g4[8], sh[8], sc[8];
#pragma unroll
        for (int i = 0; i < 8; ++i) { const int c = (i * 64 + lane) * 4; g4[i] = *(const f32x4*)(ng + c); sh[i] = *(const f32x4*)(md + c); sc[i] = *(const f32x4*)(md + 2048 + c); }
        ss = wave_sum(ss);
        const float inv = rsqrtf(ss * (1.0f / DM) + EPS);
#pragma unroll
        for (int i = 0; i < 8; ++i) { const int c = (i * 64 + lane) * 4;
            const f32x4 y = v[i] * inv * g4[i] * (sc[i] + 1.0f) + sh[i];
            u32x2 w; w.x = pk2(y[0], y[1]); w.y = pk2(y[2], y[3]);
            *(u32x2*)(H + (size_t)r * DM + c) = w; }
    }
}

DI void l2_thin_task(ArgsP a, LAS unsigned char* lds, int l, int t) {
    const bf16_t* H = (const bf16_t*)(a->ws + WS_H); const bf16_t* W = (const bf16_t*)(a->ws + WS_WINT) + (size_t)l * WIN_ROWS * DM;
    if (t < 256) {
        float* zs = (float*)(a->ws + WS_ZS) + (size_t)t * 32 * ZSLD;
        thin_gemm_block<2, 6>(lds, DM, [&](int row) { return H + (size_t)(t * 32 + row) * DM; }, [&](int col) { return W + (size_t)(ZLD + col) * DM; },
                              [&](int row, int col, float v) { zs[row * ZSLD + col] = v; });
    } else {
        const int j = t - 256;
        bf16_t* z = (bf16_t*)(a->ws + WS_Z) + (size_t)NTP * ZLD; float* zs = (float*)(a->ws + WS_ZS) + (size_t)NTP * ZSLD;
        thin_gemm_block<2, 2>(lds, DM, [&](int row) { return H + (size_t)(NTP + row) * DM; }, [&](int col) { return W + (size_t)(j * 32 + col) * DM; },
                              [&](int row, int col, float v) { const int n = j * 32 + col; if (n < ZLD) z[(size_t)row * ZLD + n] = f2bf(v); else zs[row * ZSLD + n - ZLD] = v; });
    }
}
constexpr int L2_THIN_TASKS = 256 + 195;

DI void l5_thin_task(ArgsP a, LAS unsigned char* lds, int l, int j) {
    const bf16_t* Mx = (const bf16_t*)(a->ws + WS_MIXED) + (size_t)NTP * DM; const bf16_t* W = (const bf16_t*)(a->ws + WS_WOUTT) + (size_t)l * DM * DM;
    const float* X = (l == 0) ? a->in[I_XS] : (const float*)(a->ws + WS_Y0) + (size_t)NTP * DM;
    float* Y = (l == 0) ? (float*)(a->ws + WS_Y0) + (size_t)NTP * DM : a->out + O_YS;
    const float* modl = (const float*)(a->ws + WS_MOD) + (size_t)l * 10 * 6144;
    thin_gemm_block<2, 2>(lds, DM, [&](int row) { return Mx + (size_t)row * DM; }, [&](int col) { return W + (size_t)(j * 32 + col) * DM; },
                          [&](int row, int col, float v) { const int n = j * 32 + col; Y[(size_t)row * DM + n] = X[(size_t)row * DM + n] + modl[(size_t)(2 + row / DS) * 6144 + 4096 + n] * v; });
}

DI u32x4 repack8(const float* v) { u32x4 w; w.x = pk2(v[0], v[1]); w.y = pk2(v[2], v[3]); w.z = pk2(v[4], v[5]); w.w = pk2(v[6], v[7]); return w; }

DI void l3_row(ArgsP a, int l, int r, int lane) {
    bf16_t* zr = (bf16_t*)(a->ws + WS_Z) + (size_t)r * ZLD;
    const float* zs = (const float*)(a->ws + WS_ZS) + (size_t)r * ZSLD;
    const bool smp = r >= NTP; const int rs = r - NTP;
    const int b = smp ? rs / DS : r / SEQ, t = smp ? rs % DS : r % SEQ;
    float* out = a->out;
    const u32x4 wq0 = *(const u32x4*)(zr + ZQ + lane * 16), wq1 = *(const u32x4*)(zr + ZQ + lane * 16 + 8);
    u32x2 wkv[6];
#pragma unroll
    for (int which = 0; which < 6; ++which) wkv[which] = *(const u32x2*)(zr + ZKV + which * 256 + lane * 4);
    const u32x4 wcq = *(const u32x4*)(zr + ZCQ + lane * 8);
    const u32x2 wck = *(const u32x2*)(zr + ZCKV + lane * 4);
    const float kx = zs[ZS_IK + lane];
    float* dpool = smp ? out + O_BPS + (size_t)((l * DB + b) * 15 + 11 + t) * 512 : (t >= SEQ - 15 ? out + O_BPP + (size_t)((l * NB + b) * 15 + t - (SEQ - 15)) * 512 : nullptr);
    u32x4 wbi = {0u, 0u, 0u, 0u};
    if (dpool) wbi = *(const u32x4*)(zr + ZBI + lane * 8);
    const float* gq = a->in[I_AQN] + l * 128 + (lane & 7) * 16;
    const f32x4 gq0 = *(const f32x4*)gq, gq1 = *(const f32x4*)(gq + 4), gq2 = *(const f32x4*)(gq + 8), gq3 = *(const f32x4*)(gq + 12);
    const f32x4 gk1 = *(const f32x4*)(a->in[I_AKN] + (size_t)(l * 3 + 1) * 128 + (lane & 31) * 4), gk2 = *(const f32x4*)(a->in[I_AKN] + (size_t)(l * 3 + 2) * 128 + (lane & 31) * 4);
    const float* gc = a->in[I_CQN] + l * 128 + (lane & 15) * 8;
    const f32x4 gc0 = *(const f32x4*)gc, gc1 = *(const f32x4*)(gc + 4);
    const f32x4 gck = *(const f32x4*)(a->in[I_CKN] + l * 128 + (lane & 31) * 4);
    {
        float v[16];
        unpack8(wq0, v); unpack8(wq1, v + 8);
        float ss = 0.f;
#pragma unroll
        for (int i = 0; i < 16; ++i) ss += v[i] * v[i];
        ss += __shfl_xor(ss, 1); ss += __shfl_xor(ss, 2); ss += __shfl_xor(ss, 4);
        const float inv = rsqrtf(ss * (1.0f / 128.0f) + EPS);
#pragma unroll
        for (int i = 0; i < 4; ++i) { v[i] *= inv * gq0[i]; v[4 + i] *= inv * gq1[i]; v[8 + i] *= inv * gq2[i]; v[12 + i] *= inv * gq3[i]; }
        *(u32x4*)(zr + ZQ + lane * 16) = repack8(v); *(u32x4*)(zr + ZQ + lane * 16 + 8) = repack8(v + 8);
    }
    {
        float* dkv = smp ? out + O_AKVS + (size_t)(l * NTS + rs) * 1024 : out + O_AKVP + (size_t)(l * NTP + r) * 1024;
        float* dwin = smp ? out + O_AWS + (size_t)((l * DB + b) * 512 + 508 + t) * 512 : (t >= SEQ - 512 ? out + O_AWP + (size_t)((l * NB + b) * 512 + t - (SEQ - 512)) * 512 : nullptr);
#pragma unroll
        for (int which = 0; which < 6; ++which) {
            const u32x2 w = wkv[which];
            f32x4 v = {lo2f(w.x), hi2f(w.x), lo2f(w.y), hi2f(w.y)};
            if (which == 2 || which == 4) {
                float ss = v[0] * v[0] + v[1] * v[1] + v[2] * v[2] + v[3] * v[3];
                ss += __shfl_xor(ss, 1); ss += __shfl_xor(ss, 2); ss += __shfl_xor(ss, 4); ss += __shfl_xor(ss, 8); ss += __shfl_xor(ss, 16);
                const float inv = rsqrtf(ss * (1.0f / 128.0f) + EPS);
                v = v * inv * (which == 2 ? gk1 : gk2);
                u32x2 wo; wo.x = pk2(v[0], v[1]); wo.y = pk2(v[2], v[3]); *(u32x2*)(zr + ZKV + which * 256 + lane * 4) = wo;
            }
            if (which < 4) *(f32x4*)(dkv + which * 256 + lane * 4) = v;
            else if (dwin) *(f32x4*)(dwin + (which - 4) * 256 + lane * 4) = v;
        }
    }
    {
        float v[8]; unpack8(wcq, v);
        float ss = 0.f;
#pragma unroll
        for (int i = 0; i < 8; ++i) ss += v[i] * v[i];
        ss += __shfl_xor(ss, 1); ss += __shfl_xor(ss, 2); ss += __shfl_xor(ss, 4); ss += __shfl_xor(ss, 8);
        const float inv = rsqrtf(ss * (1.0f / 128.0f) + EPS);
#pragma unroll
        for (int i = 0; i < 4; ++i) { v[i] *= inv * gc0[i]; v[4 + i] *= inv * gc1[i]; }
        *(u32x4*)(zr + ZCQ + lane * 8) = repack8(v);
    }
    {
        f32x4 v = {lo2f(wck.x), hi2f(wck.x), lo2f(wck.y), hi2f(wck.y)};
        float ss = v[0] * v[0] + v[1] * v[1] + v[2] * v[2] + v[3] * v[3];
        ss += __shfl_xor(ss, 1); ss += __shfl_xor(ss, 2); ss += __shfl_xor(ss, 4); ss += __shfl_xor(ss, 8); ss += __shfl_xor(ss, 16);
        if (lane < 32) { const float inv = rsqrtf(ss * (1.0f / 128.0f) + EPS);
            v = v * inv * gck;
            u32x2 wo; wo.x = pk2(v[0], v[1]); wo.y = pk2(v[2], v[3]); *(u32x2*)(zr + ZCKV + lane * 4) = wo; }
        { u32x2 wc; wc.x = pk2(v[0], v[1]); wc.y = pk2(v[2], v[3]); *(u32x2*)((bf16_t*)(a->ws + WS_CKV) + (size_t)r * 256 + lane * 4) = wc; }
        float* d = smp ? out + O_CKVS + (size_t)(l * NTS + rs) * 256 : out + O_CKVP + (size_t)(l * NTP + r) * 256;
        *(f32x4*)(d + lane * 4) = v;
    }
    {
        float* d = smp ? out + O_KIXS + (size_t)(l * NTS + rs) * 64 : out + O_KIXP + (size_t)(l * NTP + r) * 64;
        d[lane] = kx;
        ((bf16_t*)(a->ws + WS_KIDXB))[(size_t)r * 64 + lane] = f2bf(kx);
    }
    if (dpool) {
        float v[8]; unpack8(wbi, v);
        *(f32x4*)(dpool + lane * 8) = (f32x4){v[0], v[1], v[2], v[3]}; *(f32x4*)(dpool + lane * 8 + 4) = (f32x4){v[4], v[5], v[6], v[7]};
    }
}

DI void pool_unit(ArgsP a, int l, int pu) {
    const int tid = ltid(), w = tid >> 6, lane = tid & 63, li = lane & 15, quad = lane >> 4;
    const bool smp = pu == 128; const int ntask = smp ? 8 : 16;
    const bf16_t* Z = (const bf16_t*)(a->ws + WS_Z);
    bf16_t* Mx = (bf16_t*)(a->ws + WS_MIXED);
    for (int task = w; task < ntask; task += 8) {
        const int mt = task >> 2, g = task & 3, wlen = 2 << g;
        const int rbase = (smp ? NTP : pu * 64) + mt * 16;
        const int r = rbase + li;
        const int t = smp ? (r - NTP) % DS : r % SEQ, bs = smp ? (r - NTP) / DS : 0;
        f32x4 acc[8];
#pragma unroll
        for (int nt = 0; nt < 8; ++nt) acc[nt] = (f32x4){0.f, 0.f, 0.f, 0.f};
        const float rc = 1.0f / (float)(smp ? wlen : (t + 1 < wlen ? t + 1 : wlen));
        const bf16_t* pw = (const bf16_t*)(a->ws + WS_PWT) + (size_t)(l * 4 + g) * 128 * 128 + (size_t)li * 128 + quad * 8;
#pragma unroll 1
        for (int kk = 0; kk < 4; ++kk) {
            const int c0 = g * 128 + kk * 32 + quad * 8;
            float s[8], cur[8];
#pragma unroll
            for (int e = 0; e < 8; ++e) { s[e] = 0.f; cur[e] = 0.f; }
            u32x4 wrow[16];
#pragma unroll
            for (int i = 0; i < 16; ++i) wrow[i] = (i < wlen && t - i >= 0) ? *(const u32x4*)(Z + (size_t)(r - i) * ZLD + ZBI + c0) : (u32x4){0u, 0u, 0u, 0u};
#pragma unroll
            for (int i = 0; i < 16; ++i) { if (i < wlen) {
                float x[8];
                if (t - i >= 0) unpack8(wrow[i], x);
                else if (smp) { const float* sp = a->in[I_SB] + (size_t)((l * DB + bs) * 15 + 15 + (t - i)) * 512 + c0;
                    const f32x4 x0 = *(const f32x4*)sp, x1 = *(const f32x4*)(sp + 4);
                    x[0] = x0[0]; x[1] = x0[1]; x[2] = x0[2]; x[3] = x0[3]; x[4] = x1[0]; x[5] = x1[1]; x[6] = x1[2]; x[7] = x1[3]; }
                else {
#pragma unroll
                    for (int e = 0; e < 8; ++e) x[e] = 0.f; }
#pragma unroll
                for (int e = 0; e < 8; ++e) { s[e] += x[e]; if (i == 0) cur[e] = x[e]; }
            } }
            const bf16x8 af = pack8(s[0] * rc - cur[0], s[1] * rc - cur[1], s[2] * rc - cur[2], s[3] * rc - cur[3], s[4] * rc - cur[4], s[5] * rc - cur[5], s[6] * rc - cur[6], s[7] * rc - cur[7]);
#pragma unroll
            for (int nt = 0; nt < 8; ++nt) acc[nt] = mfma16(af, ld8(pw + (size_t)nt * 16 * 128 + kk * 32), acc[nt]);
        }
        const float* bsc = a->in[I_BSC] + l * 512 + g * 128;
#pragma unroll
        for (int nt = 0; nt < 8; ++nt) { const int col = nt * 16 + li; const float sc = bsc[col];
#pragma unroll
            for (int e = 0; e < 4; ++e) { const size_t row = (size_t)(rbase + quad * 4 + e);
                const float gate = siluf_(bf2f(Z[row * ZLD + ZBS + g * 128 + col]));
                Mx[row * DM + 1024 + g * 128 + col] = f2bf(acc[nt][e] * sc * gate); } }
    }
}

DI void cmp_prompt_unit(ArgsP a, LAS unsigned char* lds, int l, int u) {
    const int tid = ltid(), w = tid >> 6, lane = tid & 63, li = lane & 15, quad = lane >> 4;
    const int kv = u >> 6, g = (u >> 4) & 3, b = g >> 1, kvh = g & 1, i0 = (u & 15) * 16, grp = l * 2 + kv;
    LAS float* part = (LAS float*)lds; LAS bf16_t* hid = (LAS bf16_t*)(lds + 131072); LAS float* ssq = (LAS float*)(lds + 131072 + 16 * 264 * 2);
    {
        const bf16_t* zp = (const bf16_t*)(a->ws + WS_Z) + (size_t)(b * SEQ + 16 * (i0 + li) + 4 * w) * ZLD + ZKV + kv * 256 + kvh * 128 + quad * 8;
        const bf16_t* w1 = (const bf16_t*)(a->ws + WS_W1T) + (size_t)grp * 256 * 4096 + (size_t)li * 4096 + 512 * w + quad * 8;
        f32x4 acc[16];
#pragma unroll
        for (int nt = 0; nt < 16; ++nt) acc[nt] = (f32x4){0.f, 0.f, 0.f, 0.f};
#pragma unroll 2
        for (int kk = 0; kk < 16; ++kk) { const bf16x8 af = ld8(zp + (size_t)(kk >> 2) * ZLD + (kk & 3) * 32);
#pragma unroll
            for (int nt = 0; nt < 16; ++nt) acc[nt] = mfma16(af, ld8(w1 + (size_t)nt * 16 * 4096 + kk * 32), acc[nt]); }
#pragma unroll
        for (int nt = 0; nt < 16; ++nt)
#pragma unroll
            for (int e = 0; e < 4; ++e) part[(w * 16 + quad * 4 + e) * 256 + nt * 16 + li] = acc[nt][e];
    }
    __syncthreads();
    { const float* cb = (const float*)(a->ws + WS_CBIAS) + grp * 256;
      for (int x = tid; x < 4096; x += 512) { const int row = x >> 8, h = x & 255; float s = cb[h];
#pragma unroll
          for (int ww = 0; ww < 8; ++ww) s += part[(ww * 16 + row) * 256 + h];
          hid[row * 264 + h] = f2bf(gelu_tanh(s)); } }
    __syncthreads();
    f32x4 acc2 = {0.f, 0.f, 0.f, 0.f};
    { const bf16_t* w2 = (const bf16_t*)(a->ws + WS_W2T) + (size_t)grp * 128 * 256 + (size_t)(w * 16 + li) * 256 + quad * 8;
      bf16x8 w2f[8];
#pragma unroll
      for (int kk = 0; kk < 8; ++kk) w2f[kk] = ld8(w2 + kk * 32);
#pragma unroll
      for (int kk = 0; kk < 8; ++kk) acc2 = mfma16(*(const LAS bf16x8*)(hid + li * 264 + kk * 32 + quad * 8), w2f[kk], acc2); }
    const int n = w * 16 + li;
    { const float bb = a->in[I_B2][grp * 128 + n];
#pragma unroll
      for (int e = 0; e < 4; ++e) acc2[e] += bb; }
    if (kv == 0) {
#pragma unroll
        for (int e = 0; e < 4; ++e) { float s = acc2[e] * acc2[e]; s += __shfl_xor(s, 1); s += __shfl_xor(s, 2); s += __shfl_xor(s, 4); s += __shfl_xor(s, 8);
            if (li == 0) ssq[w * 16 + quad * 4 + e] = s; }
        __syncthreads();
        const float gg = a->in[I_AKN][(size_t)l * 3 * 128 + n];
        bf16_t* kc = (bf16_t*)(a->ws + WS_KCP) + (size_t)(g * 256 + i0) * 128;
#pragma unroll
        for (int e = 0; e < 4; ++e) { const int row = quad * 4 + e; float tot = 0.f;
#pragma unroll
            for (int ww = 0; ww < 8; ++ww) tot += ssq[ww * 16 + row];
            const float inv = rsqrtf(tot * (1.0f / 128.0f) + EPS);
            kc[(size_t)row * 128 + n] = (i0 + row < NC_P) ? f2bf(acc2[e] * inv * gg) : (bf16_t)0; }
    } else {
        bf16_t* vc = (bf16_t*)(a->ws + WS_VCPT) + (size_t)(g * 256 + i0) * 128;
#pragma unroll
        for (int e = 0; e < 4; ++e) { const int row = quad * 4 + e; vc[(size_t)row * 128 + n] = (i0 + row < NC_P) ? f2bf(acc2[e]) : (bf16_t)0; }
    }
    __syncthreads();
}

DI void score_sample_unit(ArgsP a, LAS unsigned char* lds, int l, int u) {
    const int tid = ltid(), b = u / 33, ch = u % 33;
    LAS float* qi = (LAS float*)lds; LAS float* wi = qi + 1024;
    const bf16_t* Z = (const bf16_t*)(a->ws + WS_Z); const float* Zs = (const float*)(a->ws + WS_ZS);
    for (int i = tid; i < 1024; i += 512) qi[i] = bf2f(Z[(size_t)(NTP + b * DS + (i >> 8)) * ZLD + ZIQ + (i & 255)]);
    if (tid < 16) wi[tid] = Zs[(size_t)(NTP + b * DS + (tid >> 2)) * ZSLD + ZS_IW + (tid & 3)];
    __syncthreads();
    const int s = ch * 512 + tid;
    if (s < PAST + DS) {
        const float* kp = (s < PAST) ? a->in[I_CI] + ((size_t)(l * NPOOL + a->page_table[b * NPAGES + (s >> 7)]) * PAGE + (s & 127)) * 64
                                     : Zs + (size_t)(NTP + b * DS + (s - PAST)) * ZSLD + ZS_IK;
        f32x4 k[16];
#pragma unroll
        for (int i = 0; i < 16; ++i) k[i] = *(const f32x4*)(kp + i * 4);
        float* sc = (float*)(a->ws + WS_SCORES);
#pragma unroll 1
        for (int tt = 0; tt < 4; ++tt) {
            float tot = 0.f;
#pragma unroll
            for (int hh = 0; hh < 4; ++hh) { float d = 0.f;
#pragma unroll
                for (int i = 0; i < 16; ++i) { const f32x4 q = *(const LAS f32x4*)(qi + (tt * 4 + hh) * 64 + i * 4); d += q[0] * k[i][0] + q[1] * k[i][1] + q[2] * k[i][2] + q[3] * k[i][3]; }
                tot += wi[tt * 4 + hh] * fmaxf(d, 0.f); }
            if (tot == 0.f) tot = 0.f;
            if (s >= PAST && s - PAST > tt) tot = -INFINITY;
            sc[(size_t)(b * DS + tt) * SCORE_LD + s] = tot;
        }
    }
    __syncthreads();
}

DI void copy_unit(ArgsP a, int l, int cu) {
    const int tid = ltid(), b = cu >> 3, part = cu & 7;
    { const f32x4* src = (const f32x4*)(a->in[I_SW] + (size_t)((l * DB + b) * 512 + 4) * 512); f32x4* dst = (f32x4*)(a->out + O_AWS + (size_t)((l * DB + b) * 512) * 512);
      for (int i0 = part * 8128 + tid; i0 < (part + 1) * 8128; i0 += 4096) { f32x4 v[8];
#pragma unroll
          for (int k = 0; k < 8; ++k) { const int i = i0 + 512 * k; v[k] = i < (part + 1) * 8128 ? src[i] : (f32x4){0.f, 0.f, 0.f, 0.f}; }
#pragma unroll
          for (int k = 0; k < 8; ++k) { const int i = i0 + 512 * k; if (i < (part + 1) * 8128) dst[i] = v[k]; } } }
    if (part == 0) { const f32x4* src = (const f32x4*)(a->in[I_SB] + (size_t)((l * DB + b) * 15 + 4) * 512); f32x4* dst = (f32x4*)(a->out + O_BPS + (size_t)((l * DB + b) * 15) * 512);
      f32x4 v[3];
#pragma unroll
      for (int k = 0; k < 3; ++k) { const int i = tid + 512 * k; v[k] = i < 1408 ? src[i] : (f32x4){0.f, 0.f, 0.f, 0.f}; }
#pragma unroll
      for (int k = 0; k < 3; ++k) { const int i = tid + 512 * k; if (i < 1408) dst[i] = v[k]; } }
}

constexpr int PJ_DEF_MOD = 48, PJ_DEF_TR = 784 + 256;
constexpr int PJ_NOW = PJ_TOTAL - PJ_DEF_MOD - PJ_DEF_TR;
DI int pj_now_unit(int q) {
    if (q < 48) return PJ_T_END + q;
    q -= 48;
    if (q < PJ_CB + PJ_ACV + PJ_BT) return PJ_T_END + PJ_MOD + q;
    q -= PJ_CB + PJ_ACV + PJ_BT;
    if (q < 784) return q;
    q -= 784;
    if (q < 256) return PJ_WIN + q;
    q -= 256;
    return PJ_WIN + PJ_WOUT + q;
}
DI void deferred_tr_unit(ArgsP a, LAS unsigned char* lds, int m) {
    LAS float* tile = (LAS float*)lds;
    if (m < 784) { const int nt = m / 8, kt = m % 8;
        transpose_tile(tile, a->in[I_WIN] + (size_t)DM * NIN, NIN, (bf16_t*)(a->ws + WS_WINT) + (size_t)WIN_ROWS * DM, DM, kt * 256, nt * 64, WIN_ROWS, 4, [](int n) { return win_col(n); });
    } else { const int r = m - 784, nt = r / 8, kt = r % 8;
        transpose_tile(tile, a->in[I_WOUT] + (size_t)DM * DM, DM, (bf16_t*)(a->ws + WS_WOUTT) + (size_t)DM * DM, DM, kt * 256, nt * 64, DM, 4, [](int n) { return n; }); }
}

constexpr int L3_CMP = 128, L3_SC = 8 * 33, L3_POOL = 129, L3_CP = 64, L3_ROWS = NTOK / 8;
constexpr int L3_TOTAL = L3_CMP + L3_SC + L3_POOL + L3_CP + L3_ROWS;
DI void l3_unit(ArgsP a, LAS unsigned char* lds, int l, int u) {
    if (u < L3_CMP) { cmp_prompt_unit(a, lds, l, u); return; } u -= L3_CMP;
    if (u < L3_SC) { score_sample_unit(a, lds, l, u); return; } u -= L3_SC;
    if (u < L3_POOL) { pool_unit(a, l, u); return; } u -= L3_POOL;
    if (u < L3_CP) { copy_unit(a, l, u); return; } u -= L3_CP;
    l3_row(a, l, u * 8 + (ltid() >> 6), ltid() & 63);
}

struct AttnState { float l; f32x4 o[8]; };
DI void attn_init(AttnState& s) { s.l = 0.f;
#pragma unroll
    for (int dt = 0; dt < 8; ++dt) s.o[dt] = (f32x4){0.f, 0.f, 0.f, 0.f}; }
DI float softmax_shift(const bf16x8 (&qf)[4], float gmax, float bmax) {
    float ss = 0.f;
#pragma unroll
    for (int kk = 0; kk < 4; ++kk)
#pragma unroll
        for (int e = 0; e < 8; ++e) { const float x = bf2f((bf16_t)qf[kk][e]); ss += x * x; }
    ss += __shfl_xor(ss, 16); ss += __shfl_xor(ss, 32);
    return QK_SCALE2 * sqrtf(ss) * 11.3137085f * gmax + bmax;
}
struct NoHook { DI void operator()(const float (&)[8]) const {} };
template <class KF, class VF, class MB, class PH = NoHook>
DI void attn_tile32(AttnState& st, const bf16x8 (&qf)[4], KF kf, VF vf, MB mb, PH ph = PH()) {
    bf16x8 ka[2][4];
#pragma unroll
    for (int sub = 0; sub < 2; ++sub)
#pragma unroll
        for (int kk = 0; kk < 4; ++kk) ka[sub][kk] = kf(sub, kk);
    s16x4 va[8][2];
#pragma unroll
    for (int dt = 0; dt < 8; ++dt) { va[dt][0] = vf(dt, 0); va[dt][1] = vf(dt, 1); }
    f32x4 s0 = {0.f, 0.f, 0.f, 0.f}, s1 = {0.f, 0.f, 0.f, 0.f};
#pragma unroll
    for (int kk = 0; kk < 4; ++kk) { s0 = mfma16(ka[0][kk], qf[kk], s0); s1 = mfma16(ka[1][kk], qf[kk], s1); }
    float p[8];
#pragma unroll
    for (int e = 0; e < 4; ++e) { p[e] = fexp2(mb(0, e, s0[e])); p[4 + e] = fexp2(mb(1, e, s1[e])); }
    st.l += ((p[0] + p[1]) + (p[2] + p[3])) + ((p[4] + p[5]) + (p[6] + p[7]));
    ph(p);
    const bf16x8 pb = pack8(p[0], p[1], p[2], p[3], p[4], p[5], p[6], p[7]);
#pragma unroll
    for (int dt = 0; dt < 8; ++dt) st.o[dt] = mfma16(__builtin_shufflevector(va[dt][0], va[dt][1], 0, 1, 2, 3, 4, 5, 6, 7), pb, st.o[dt]);
}
DI void attn_finish(AttnState& st) {
    float l = st.l; l += __shfl_xor(l, 16); l += __shfl_xor(l, 32);
    const float inv = 1.0f / fmaxf(l, 1e-30f);
#pragma unroll
    for (int dt = 0; dt < 8; ++dt) st.o[dt] *= inv;
}
DI s16x4 lds_tr(const LAS bf16_t* p) { return __builtin_amdgcn_ds_read_tr16_b64_v4i16((LAS s16x4*)p); }
constexpr int KVP = 144;
constexpr int VP = 144;

constexpr int NSA_KS = 0, NSA_VS = 2 * 64 * KVP * 2, NSA_PSUM = NSA_VS + 2 * 64 * VP * 2, NSA_BIAS = NSA_PSUM + 32 * 256 * 4, NSA_WN = NSA_BIAS + 2304;
template <class NEED, class HALFOK, class FAR, class MBF, class MB>
DI void nsa_run_blocks(LAS unsigned char* lds, unsigned long long blockmask, const bf16_t* kbase, const bf16_t* vbase, AttnState& st, const bf16x8 (&qf)[4], int tid, NEED need, HALFOK halfok, FAR isfar, MBF mbfar, MB mb) {
    const int lane = tid & 63, li = lane & 15, quad = lane >> 4;
    LAS bf16_t* Ks = (LAS bf16_t*)(lds + NSA_KS); LAS bf16_t* Vs = (LAS bf16_t*)(lds + NSA_VS);
    const int r0 = tid >> 4, ch = tid & 15;
    u32x4 krA[2], vrA[2];
    unsigned long long cm = blockmask, lm = blockmask;
    int buf = 0;
    auto request = [&](u32x4 (&kr)[2], u32x4 (&vr)[2]) {
        if (lm) { const int jn = __builtin_ctzll(lm); lm &= lm - 1;
#pragma unroll
            for (int i = 0; i < 2; ++i) { const size_t ro = (size_t)(jn * 64 + r0 + i * 32) * ZLD + ch * 8; kr[i] = *(const u32x4*)(kbase + ro); vr[i] = *(const u32x4*)(vbase + ro); } } };
    auto step = [&](u32x4 (&kr)[2], u32x4 (&vr)[2]) {
        const int j = __builtin_ctzll(cm); cm &= cm - 1;
#pragma unroll
        for (int i = 0; i < 2; ++i) { *(LAS u32x4*)(Ks + (buf * 64 + r0 + i * 32) * KVP + ch * 8) = kr[i]; *(LAS u32x4*)(Vs + (buf * 64 + r0 + i * 32) * VP + ch * 8) = vr[i]; }
        __syncthreads();
        request(kr, vr);
        if (need(j)) {
#pragma unroll
            for (int half = 0; half < 2; ++half) {
                if (halfok(j, half)) {
                    const LAS bf16_t* kt = Ks + (buf * 64 + half * 32) * KVP; const LAS bf16_t* vt = Vs + (buf * 64 + half * 32) * VP;
                    auto kfr = [&](int sub, int kk) { return *(const LAS bf16x8*)(kt + (sub * 16 + li) * KVP + kk * 32 + quad * 8); };
                    auto vfr = [&](int dt, int sub) { return lds_tr(vt + (sub * 16 + quad * 4 + (li >> 2)) * VP + dt * 16 + (li & 3) * 4); };
                    if (isfar(j, half)) { const float off = mbfar(j); attn_tile32(st, qf, kfr, vfr, [&](int sub, int e, float raw) { return raw * QK_SCALE2 + off; }); }
                    else attn_tile32(st, qf, kfr, vfr, [&](int sub, int e, float raw) { return mb(j * 64 + half * 32 + sub * 16 + quad * 4 + e, j, raw); });
                }
            }
        }
        buf ^= 1; };
    request(krA, vrA);
    while (cm) step(krA, vrA);
    __syncthreads();
}

DI void nsa_prompt_unit(ArgsP a, LAS unsigned char* lds, int l, int u) {
    const int tid = ltid(), w = tid >> 6, lane = tid & 63, li = lane & 15, quad = lane >> 4;
    const int b = u >> 8, kvh = (u >> 7) & 1, qt = u & 127, t0 = qt * 32;
    const int qi = li >> 2, g = li & 3, h = kvh * 4 + g;
    const int tq0 = t0 + 4 * w, t = tq0 + qi;
    const size_t row = (size_t)b * SEQ + t;
    const bf16_t* Z = (const bf16_t*)(a->ws + WS_Z);
    LAS float* biasL = (LAS float*)(lds + NSA_BIAS); LAS float* psum = (LAS float*)(lds + NSA_PSUM); LAS unsigned long long* wn = (LAS unsigned long long*)(lds + NSA_WN);
    { const float* bt = (const float*)(a->ws + WS_BIAS);
      for (int i = tid; i < 129 * 4; i += 512) biasL[i] = bt[(i >> 2) * 8 + kvh * 4 + (i & 3)]; }
    __syncthreads();
    bf16x8 qf[4];
#pragma unroll
    for (int kk = 0; kk < 4; ++kk) qf[kk] = ld8(Z + row * ZLD + ZQ + h * 128 + kk * 32 + quad * 8);
    const float* zg = (const float*)(a->ws + WS_ZS) + row * ZSLD + ZS_GATE;
    const float gate0 = sigmoidf_(zg[h]), gate1 = sigmoidf_(zg[8 + h]), gate2 = sigmoidf_(zg[16 + h]);
    const float* bx = (const float*)(a->ws + WS_BIAS) + 1600;
    const float bmaxA = ldu(bx + 8);
    const float shC = softmax_shift(qf, ldu(bx + l * 4 + 0), bmaxA), shS = softmax_shift(qf, ldu(bx + l * 4 + 1), bmaxA), shW = softmax_shift(qf, ldu(bx + l * 4 + 2), bmaxA);
    const float b31 = biasL[128 * 4 + g];
    f32x4 otot[8];
    {
        const int nvw = (tq0 + 3 >= 31) ? ((tq0 + 3 - 31) >> 4) + 1 : 0;
        const int nvu = (t0 + 31 >= 31) ? ((t0 + 31 - 31) >> 4) + 1 : 0;
        const bf16_t* Kc = (const bf16_t*)(a->ws + WS_KCP) + (size_t)((b * 2 + kvh) * 256) * 128;
        const bf16_t* Vc = (const bf16_t*)(a->ws + WS_VCPT) + (size_t)((b * 2 + kvh) * 256) * 128;
        LAS bf16_t* Ks = (LAS bf16_t*)(lds + NSA_KS); LAS bf16_t* Vs = (LAS bf16_t*)(lds + NSA_VS);
        const int r0 = tid >> 4, ch = tid & 15;
        u32x4 kr[4][2], vr[4][2];
#pragma unroll
        for (int jb = 0; jb < 4; ++jb) if (jb * 64 < nvu) {
#pragma unroll
            for (int i = 0; i < 2; ++i) { const size_t ro = (size_t)(jb * 64 + r0 + i * 32) * 128 + ch * 8; kr[jb][i] = *(const u32x4*)(Kc + ro); vr[jb][i] = *(const u32x4*)(Vc + ro); } }
        float sc[16][4];
#pragma unroll
        for (int i = 0; i < 16; ++i)
#pragma unroll
            for (int e = 0; e < 4; ++e) sc[i][e] = 0.f;
        AttnState stc; attn_init(stc);
#pragma unroll
        for (int jb = 0; jb < 4; ++jb) if (jb * 64 < nvu) {
            const int buf = jb & 1;
#pragma unroll
            for (int i = 0; i < 2; ++i) { *(LAS u32x4*)(Ks + (buf * 64 + r0 + i * 32) * KVP + ch * 8) = kr[jb][i]; *(LAS u32x4*)(Vs + (buf * 64 + r0 + i * 32) * VP + ch * 8) = vr[jb][i]; }
            __syncthreads();
#pragma unroll
            for (int half = 0; half < 2; ++half) if (jb * 64 + half * 32 < nvw) {
                const LAS bf16_t* kt = Ks + (buf * 64 + half * 32) * KVP; const LAS bf16_t* vt = Vs + (buf * 64 + half * 32) * VP;
                attn_tile32(stc, qf,
                    [&](int sub, int kk) { return *(const LAS bf16x8*)(kt + (sub * 16 + li) * KVP + kk * 32 + quad * 8); },
                    [&](int dt, int sub) { return lds_tr(vt + (sub * 16 + quad * 4 + (li >> 2)) * VP + dt * 16 + (li & 3) * 4); },
                    [&](int sub, int e, float raw) { const int rel = t - (16 * (jb * 64 + half * 32 + sub * 16 + quad * 4 + e) + 31);
                        const float v = raw * QK_SCALE2 + biasL[(rel < 0 ? 0 : (rel < 128 ? rel : 128)) * 4 + g] - shC; return rel >= 0 ? v : -INFINITY; },
                    [&](const float (&p)[8]) {
#pragma unroll
                        for (int e = 0; e < 4; ++e) { sc[jb * 4 + half * 2][e] = p[e]; sc[jb * 4 + half * 2 + 1][e] = p[4 + e]; } });
            }
        }
        __syncthreads();
        float ls = stc.l; ls += __shfl_xor(ls, 16); ls += __shfl_xor(ls, 32);
        const float inv = 1.0f / fmaxf(ls, 1e-30f);
#pragma unroll
        for (int sub = 0; sub < 16; ++sub) {
            f32x4 hs;
#pragma unroll
            for (int e = 0; e < 4; ++e) { float x = sc[sub][e] * inv; x += dpp_xor1(x); x += dpp_xor2(x); hs[e] = x; }
            if (g == 0) *(LAS f32x4*)(psum + (w * 4 + qi) * 256 + sub * 16 + quad * 4) = hs;
        }
#pragma unroll
        for (int dt = 0; dt < 8; ++dt) otot[dt] = stc.o[dt] * (inv * gate0);
    }
    unsigned long long mymask = 0ull, need = 0ull;
#pragma unroll
    for (int qq = 0; qq < 4; ++qq) {
        const int tq = tq0 + qq, cur = tq >> 6, j = lane;
        const LAS float* ps = psum + (w * 4 + qq) * 256;
        const f32x4 v4 = *(const LAS f32x4*)(ps + 4 * j);
        const float pm1 = j > 0 ? ps[4 * j - 1] : 0.f;
        const float imp = pm1 + 2.0f * (v4[0] + v4[1] + v4[2]) + v4[3];
        const bool vis = j <= cur, forced = (j == 0) || (j == cur) || (j == cur - 1);
        const float val = vis ? (forced ? 1e6f : imp) : -INFINITY;
        int rank = 0;
        for (int jj = 0; jj < 64; ++jj) { const float vj = __builtin_bit_cast(float, __builtin_amdgcn_readlane(__builtin_bit_cast(int, val), jj)); rank += (vj > val || (vj == val && jj < j)) ? 1 : 0; }
        const unsigned long long mk = __ballot(vis && rank < 16);
        need |= mk; if (qi == qq) mymask = mk;
    }
    if (lane == 0) wn[w] = need;
    __syncthreads();
    unsigned long long bm = 0ull;
#pragma unroll
    for (int i = 0; i < 8; ++i) bm |= wn[i];
    {
        AttnState st; attn_init(st);
        const bf16_t* kb = Z + (size_t)b * SEQ * ZLD + ZKV + 2 * 256 + kvh * 128;
        nsa_run_blocks(lds, bm, kb, kb + 256, st, qf, tid,
            [&](int j) { return ((need >> j) & 1ull) != 0ull; },
            [&](int j, int half) { return j * 64 + half * 32 <= tq0 + 3; },
            [&](int j, int half) { return j * 64 + half * 32 + 31 + 128 <= tq0; },
            [&](int j) { return ((mymask >> j) & 1ull) ? b31 - shS : -INFINITY; },
            [&](int kp, int j, float raw) { const int rel = t - kp; const float v = raw * QK_SCALE2 + biasL[(rel < 0 ? 0 : (rel < 128 ? rel : 128)) * 4 + g] - shS; return (((mymask >> j) & 1ull) && rel >= 0) ? v : -INFINITY; });
        attn_finish(st);
#pragma unroll
        for (int dt = 0; dt < 8; ++dt) otot[dt] += st.o[dt] * gate1;
    }
    {
        AttnState st; attn_init(st);
        const int jlo = (t0 >= 512 ? t0 - 512 : 0) >> 6, jhi = (t0 + 31) >> 6;
        const unsigned long long wm = (jhi >= 63 ? ~0ull : ((1ull << (jhi + 1)) - 1ull)) & ~((1ull << jlo) - 1ull);
        const bf16_t* kb = Z + (size_t)b * SEQ * ZLD + ZKV + 4 * 256 + kvh * 128;
        nsa_run_blocks(lds, wm, kb, kb + 256, st, qf, tid,
            [&](int j) { return j * 64 + 63 >= tq0 - 512 && j * 64 <= tq0 + 3; },
            [&](int j, int half) { const int k0 = j * 64 + half * 32; return k0 + 31 >= tq0 - 512 && k0 <= tq0 + 3; },
            [&](int j, int half) { const int k0 = j * 64 + half * 32; return k0 + 31 + 128 <= tq0 && k0 >= tq0 + 3 - 512; },
            [&](int j) { return b31 - shW; },
            [&](int kp, int j, float raw) { const int rel = t - kp; const float v = raw * QK_SCALE2 + biasL[(rel < 0 ? 0 : (rel < 128 ? rel : 128)) * 4 + g] - shW; return (rel >= 0 && rel <= 512) ? v : -INFINITY; });
        attn_finish(st);
#pragma unroll
        for (int dt = 0; dt < 8; ++dt) otot[dt] += st.o[dt] * gate2;
    }
    { bf16_t* mx = (bf16_t*)(a->ws + WS_MIXED) + row * DM + h * 128; const bf16_t* sg = Z + row * ZLD + ZAS + h * 128;
#pragma unroll
      for (int dt = 0; dt < 8; ++dt) { const int d = dt * 16 + quad * 4; const u32x2 sw = *(const u32x2*)(sg + d);
          u32x2 o; o.x = pk2(otot[dt][0] * siluf_(lo2f(sw.x)), otot[dt][1] * siluf_(hi2f(sw.x))); o.y = pk2(otot[dt][2] * siluf_(lo2f(sw.y)), otot[dt][3] * siluf_(hi2f(sw.y)));
          *(u32x2*)(mx + d) = o; } }
    __syncthreads();
}

DI unsigned fkey(float f) { const unsigned u = __float_as_uint(f); return (u & 0x80000000u) ? ~u : (u | 0x80000000u); }
DI void wave_topk256(const LAS float* sc, int n, LAS unsigned* hist, LAS int* idx, int lane) {
    unsigned prefix = 0u; int kth = 256;
#pragma unroll 1
    for (int pass = 3; pass >= 0; --pass) {
        const int shift = pass * 8;
        *(LAS u32x4*)(hist + lane * 4) = (u32x4){0u, 0u, 0u, 0u};
        for (int i = lane; i < n; i += 64) { const unsigned u = fkey(sc[i]);
            if (pass == 3 || (u >> (shift + 8)) == prefix) (void)__hip_atomic_fetch_add(hist + ((u >> shift) & 255u), 1u, __ATOMIC_RELAXED, __HIP_MEMORY_SCOPE_WORKGROUP); }
        const u32x4 c = *(const LAS u32x4*)(hist + lane * 4);
        const int tot = (int)(c.x + c.y + c.z + c.w);
        int incl = tot;
#pragma unroll
        for (int o = 1; o < 64; o <<= 1) { const int t2 = __shfl_down(incl, o); if (lane + o < 64) incl += t2; }
        const int a3 = incl - tot, a2 = a3 + (int)c.w, a1 = a2 + (int)c.z, a0 = a1 + (int)c.y;
        int which = -1, ab = 0;
        if (a3 < kth && kth <= a3 + (int)c.w) { which = 3; ab = a3; }
        else if (a2 < kth && kth <= a2 + (int)c.z) { which = 2; ab = a2; }
        else if (a1 < kth && kth <= a1 + (int)c.y) { which = 1; ab = a1; }
        else if (a0 < kth && kth <= a0 + (int)c.x) { which = 0; ab = a0; }
        const unsigned long long hb = __ballot(which >= 0);
        const int src = hb ? __builtin_ctzll(hb) : 0;
        const int dg = __shfl(lane * 4 + which, src), nk = __shfl(kth - ab, src);
        prefix = (prefix << 8) | (unsigned)dg; kth = nk;
    }
    int cnt = 0, ce = 0;
    for (int base = 0; base < n; base += 64) {
        const int i = base + lane; const bool valid = i < n;
        const unsigned u = valid ? fkey(sc[i]) : 0u;
        const bool gt = valid && u > prefix, eq = valid && u == prefix;
        const unsigned long long eqb = __ballot(eq);
        const int eqrank = ce + __builtin_popcountll(eqb & ((1ull << lane) - 1ull));
        const bool take = gt || (eq && eqrank < kth);
        const unsigned long long tb = __ballot(take);
        if (take) idx[cnt + __builtin_popcountll(tb & ((1ull << lane) - 1ull))] = i;
        cnt += __builtin_popcountll(tb); ce += __builtin_popcountll(eqb);
    }
}

DI bool scan_bins(LAS unsigned* hist, int lane, int target, int& B, int& above, int& C) {
    const u32x4 c = *(const LAS u32x4*)(hist + lane * 4);
    const int tot = (int)(c.x + c.y + c.z + c.w);
    const int pre = wave_incl_scan_dpp(tot, lane);
    const int a3 = __builtin_amdgcn_readlane(pre, 63) - pre, a2 = a3 + (int)c.w, a1 = a2 + (int)c.z, a0 = a1 + (int)c.y;
    int which = -1, ab = 0, cc = 0;
    if (a3 < target && target <= a3 + (int)c.w) { which = 3; ab = a3; cc = (int)c.w; }
    else if (a2 < target && target <= a2 + (int)c.z) { which = 2; ab = a2; cc = (int)c.z; }
    else if (a1 < target && target <= a1 + (int)c.y) { which = 1; ab = a1; cc = (int)c.y; }
    else if (a0 < target && target <= a0 + (int)c.x) { which = 0; ab = a0; cc = (int)c.x; }
    const unsigned long long hb = __ballot(which >= 0);
    if (!hb) return false;
    const int src = __builtin_ctzll(hb);
    B = __builtin_amdgcn_readlane(lane * 4 + which, src); above = __builtin_amdgcn_readlane(ab, src); C = __builtin_amdgcn_readlane(cc, src);
    return true;
}
DI void take_candidates(const LAS int* cand, const LAS float* candv, int C, int r, LAS int* idx, int out, int lane) {
    for (int k0 = 0; k0 < C; k0 += 64) {
        const int k = k0 + lane; const bool have = k < C;
        const int myi = have ? cand[k] : 0; const float myv = have ? candv[k] : 0.f;
        int rank = 0;
#pragma unroll 4
        for (int j = 0; j < C; ++j) { const int oi = cand[j]; const float ov = candv[j]; rank += (ov > myv || (ov == myv && oi < myi)) ? 1 : 0; }
        const bool take = have && rank < r;
        const unsigned long long tb = __ballot(take);
        if (take) idx[out + __builtin_popcountll(tb & ((1ull << lane) - 1ull))] = myi;
        out += __builtin_popcountll(tb);
    }
}
DI void wave_topk256_lin(const LAS float* sc, int n, LAS unsigned* hist, LAS int* idx, int lane) {
    const int ng = (n + 511) >> 9, lim = n - lane;
    float lo = INFINITY, hi = -INFINITY;
#pragma unroll 1
    for (int g = 0; g < ng; ++g) {
#pragma unroll
        for (int k = 0; k < 8; ++k) { const int i = g * 8 + k; const float x = sc[i * 64 + lane]; const bool ok = i * 64 < lim; hi = fmaxf(hi, ok ? x : -INFINITY); lo = fminf(lo, ok ? x : INFINITY); } }
    hi = wave_max_dpp(hi); lo = wave_min_dpp(lo);
    const float scale = hi > lo ? 255.0f / (hi - lo) : 0.f;
    *(LAS u32x4*)(hist + lane * 4) = (u32x4){0u, 0u, 0u, 0u};
#pragma unroll 1
    for (int g = 0; g < ng; ++g) {
#pragma unroll
        for (int k = 0; k < 8; ++k) { const int i = g * 8 + k; const float x = sc[i * 64 + lane]; int bn = (int)((x - lo) * scale); bn = bn > 255 ? 255 : (bn < 0 ? 0 : bn);
            if (i * 64 < lim) (void)__hip_atomic_fetch_add(hist + bn, 1u, __ATOMIC_RELAXED, __HIP_MEMORY_SCOPE_WORKGROUP); } }
    int B = 0, above = 0, C = 0;
    if (!scan_bins(hist, lane, 256, B, above, C) || C > 128) { wave_topk256(sc, n, hist, idx, lane); return; }
    LAS int* cand = (LAS int*)hist; LAS float* candv = (LAS float*)hist + 128;
    unsigned long long upm = 0ull, eqm = 0ull;
#pragma unroll 1
    for (int g = 0; g < ng; ++g) { unsigned ub8 = 0u, eb8 = 0u;
#pragma unroll
        for (int k = 0; k < 8; ++k) { const int i = g * 8 + k; const float x = sc[i * 64 + lane]; int bn = (int)((x - lo) * scale); bn = bn > 255 ? 255 : (bn < 0 ? 0 : bn);
            const bool ok = i * 64 < lim; ub8 |= (ok && bn > B) ? (1u << k) : 0u; eb8 |= (ok && bn == B) ? (1u << k) : 0u; }
        upm |= (unsigned long long)ub8 << (g * 8); eqm |= (unsigned long long)eb8 << (g * 8); }
    const int packed = __builtin_popcountll(upm) | (__builtin_popcountll(eqm) << 16);
    const int incl = wave_incl_scan_dpp(packed, lane);
    int ub = (incl - packed) & 0xffff, eb = (incl - packed) >> 16;
    while (upm) { const int i = __builtin_ctzll(upm); upm &= upm - 1; idx[ub++] = i * 64 + lane; }
    while (eqm) { const int i = __builtin_ctzll(eqm); eqm &= eqm - 1; const int e = i * 64 + lane; cand[eb] = e; candv[eb] = sc[e]; ++eb; }
    take_candidates(cand, candv, C, 256 - above, idx, above, lane);
}
DI void wave_topk256_fast(const LAS float* sc, int n, LAS unsigned* hist, LAS int* idx, int lane) {
    if (n <= 1024) { wave_topk256_lin(sc, n, hist, idx, lane); return; }
    unsigned long long m = 0ull; int P;
    {
        float xs[8];
#pragma unroll
        for (int k = 0; k < 8; ++k) xs[k] = sc[k * 64 + lane];
        float lo = xs[0], hi = xs[0];
#pragma unroll
        for (int k = 1; k < 8; ++k) { lo = fminf(lo, xs[k]); hi = fmaxf(hi, xs[k]); }
        hi = wave_max_dpp(hi); lo = wave_min_dpp(lo);
        const float scale = hi > lo ? 255.0f / (hi - lo) : 0.f, off = -lo * scale;
        *(LAS u32x4*)(hist + lane * 4) = (u32x4){0u, 0u, 0u, 0u};
#pragma unroll
        for (int k = 0; k < 8; ++k) { int bn = (int)fmaf(xs[k], scale, off); bn = bn < 0 ? 0 : (bn > 255 ? 255 : bn);
            (void)__hip_atomic_fetch_add(hist + bn, 1u, __ATOMIC_RELAXED, __HIP_MEMORY_SCOPE_WORKGROUP); }
        const float es = 131072.0f / (float)n;
        int S = (int)es + (int)(3.5f * sqrtf(es)) + 3; S = S > 512 ? 512 : S;
        int Bs = 0, ab = 0, cs = 0;
        if (!scan_bins(hist, lane, S, Bs, ab, cs)) Bs = 0;
        const float thr = (float)Bs;
        const int ng = (n + 511) >> 9, lim = n - lane;
#pragma unroll 1
        for (int g = 0; g < ng; ++g) { unsigned b8 = 0u;
#pragma unroll
            for (int k = 0; k < 8; ++k) { const int i = g * 8 + k; const float x = sc[i * 64 + lane]; b8 |= (i * 64 < lim && fmaf(x, scale, off) >= thr) ? (1u << k) : 0u; }
            m |= (unsigned long long)b8 << (g * 8); }
        P = wave_sum_dpp(__builtin_popcountll(m));
    }
    if (P < 256 || __ballot(__builtin_popcountll(m) > 16) != 0ull) { wave_topk256_lin(sc, n, hist, idx, lane); return; }
    float sv[16]; int se[16];
    { unsigned long long mm = m;
#pragma unroll
      for (int k = 0; k < 16; ++k) { const bool have = mm != 0ull; const int i = have ? __builtin_ctzll(mm) : 0; mm &= mm - 1;
          const int e = i * 64 + lane; sv[k] = have ? sc[e] : -INFINITY; se[k] = have ? e : -1; } }
    float lo2 = INFINITY, hi2 = -INFINITY;
#pragma unroll
    for (int k = 0; k < 16; ++k) { hi2 = fmaxf(hi2, sv[k]); lo2 = fminf(lo2, se[k] >= 0 ? sv[k] : INFINITY); }
    hi2 = wave_max_dpp(hi2); lo2 = wave_min_dpp(lo2);
    const float scale2 = hi2 > lo2 ? 255.0f / (hi2 - lo2) : 0.f;
    *(LAS u32x4*)(hist + lane * 4) = (u32x4){0u, 0u, 0u, 0u};
    int bn[16];
#pragma unroll
    for (int k = 0; k < 16; ++k) { int b = (int)((sv[k] - lo2) * scale2); b = b > 255 ? 255 : (b < 0 ? 0 : b); bn[k] = se[k] >= 0 ? b : -1;
        if (se[k] >= 0) (void)__hip_atomic_fetch_add(hist + b, 1u, __ATOMIC_RELAXED, __HIP_MEMORY_SCOPE_WORKGROUP); }
    int B = 0, above = 0, C = 0;
    if (!scan_bins(hist, lane, 256, B, above, C) || C > 128) { wave_topk256_lin(sc, n, hist, idx, lane); return; }
    LAS int* cand = (LAS int*)hist; LAS float* candv = (LAS float*)hist + 128;
    int cu = 0, ce = 0;
#pragma unroll
    for (int k = 0; k < 16; ++k) { cu += bn[k] > B ? 1 : 0; ce += bn[k] == B ? 1 : 0; }
    const int packed = cu | (ce << 16);
    const int incl = wave_incl_scan_dpp(packed, lane);
    int ub = (incl - packed) & 0xffff, eb = (incl - packed) >> 16;
#pragma unroll
    for (int k = 0; k < 16; ++k) { if (bn[k] > B) idx[ub++] = se[k]; if (bn[k] == B) { cand[eb] = se[k]; candv[eb] = sv[k]; ++eb; } }
    take_candidates(cand, candv, C, 256 - above, idx, above, lane);
}

constexpr int DSA_SC = 0, DSA_IDX = 8 * 4096 * 4, DSA_HIST = DSA_IDX + 8 * 256 * 4, DSA_BIAS = DSA_HIST + 8 * 256 * 4;
DI void dsa_prompt_unit(ArgsP a, LAS unsigned char* lds, int l, int u) {
    const int tid = ltid(), w = tid >> 6, lane = tid & 63, li = lane & 15, quad = lane >> 4;
    const int b = u & 1, q8 = u >> 1, t0 = q8 * 8;
    const bf16_t* Z = (const bf16_t*)(a->ws + WS_Z); const float* Zs = (const float*)(a->ws + WS_ZS);
    LAS float* scores = (LAS float*)(lds + DSA_SC); LAS float* biasC = (LAS float*)(lds + DSA_BIAS);
    { const float* bt = (const float*)(a->ws + WS_BIAS) + 129 * 8;
      for (int i = tid; i < 129 * 4; i += 512) biasC[i] = bt[i]; }
    {
        const int qi = li >> 2, ih = li & 3;
        bf16x8 qfi[2][2]; float wi[2];
#pragma unroll
        for (int ct = 0; ct < 2; ++ct) { const size_t row = (size_t)b * SEQ + t0 + ct * 4 + qi;
#pragma unroll
            for (int kk = 0; kk < 2; ++kk) qfi[ct][kk] = ld8(Z + row * ZLD + ZIQ + ih * 64 + kk * 32 + quad * 8);
            wi[ct] = Zs[row * ZSLD + ZS_IW + ih]; }
        const bf16_t* kx = (const bf16_t*)(a->ws + WS_KIDXB) + (size_t)b * SEQ * 64;
        const int nsub = ((t0 + 7) >> 4) + 1;
        for (int sb = w; sb < nsub; sb += 64) {
          bf16x8 kq[8][2];
#pragma unroll
          for (int r = 0; r < 8; ++r) { const int sub = sb + 8 * r; if (sub < nsub) { kq[r][0] = ld8(kx + (size_t)(sub * 16 + li) * 64 + quad * 8); kq[r][1] = ld8(kx + (size_t)(sub * 16 + li) * 64 + 32 + quad * 8); } }
#pragma unroll
          for (int r = 0; r < 8; ++r) { const int sub = sb + 8 * r; if (sub < nsub) {
            const bf16x8 k0 = kq[r][0], k1 = kq[r][1];
#pragma unroll
            for (int ct = 0; ct < 2; ++ct) {
                f32x4 s = {0.f, 0.f, 0.f, 0.f};
                s = mfma16(k0, qfi[ct][0], s); s = mfma16(k1, qfi[ct][1], s);
                const int tq = t0 + ct * 4 + qi;
                f32x4 o;
#pragma unroll
                for (int e = 0; e < 4; ++e) { float x = fmaxf(s[e], 0.f) * wi[ct]; x += dpp_xor1(x); x += dpp_xor2(x); if (x == 0.f) x = 0.f;
                    o[e] = (sub * 16 + quad * 4 + e <= tq) ? x : -INFINITY; }
                if (ih == 0) *(LAS f32x4*)(scores + (ct * 4 + qi) * 4096 + sub * 16 + quad * 4) = o;
            }
          } }
        }
    }
    __syncthreads();
    const int t = t0 + w, n = t + 1;
    const size_t row = (size_t)b * SEQ + t;
    LAS int* idx = (LAS int*)(lds + DSA_IDX) + w * 256;
    bf16x8 qf[4];
#pragma unroll
    for (int kk = 0; kk < 4; ++kk) qf[kk] = ld8(Z + row * ZLD + ZCQ + (li & 3) * 128 + kk * 32 + quad * 8);
    int cnt;
    if (n <= 256) { for (int i = lane; i < 256; i += 64) idx[i] = i < n ? i : 0; cnt = n; }
    else { wave_topk256_fast(scores + w * 4096, n, (LAS unsigned*)(lds + DSA_HIST) + w * 256, idx, lane); cnt = 256;
#ifdef TOPK_SELFCHECK
        {
            long long s1 = 0, s2 = 0;
            for (int i = lane; i < 256; i += 64) { const long long e = idx[i]; s1 += e; s2 += e * e; }
            wave_topk256(scores + w * 4096, n, (LAS unsigned*)(lds + DSA_HIST) + w * 256, idx, lane);
            for (int i = lane; i < 256; i += 64) { const long long e = idx[i]; s1 -= e; s2 -= e * e; }
            for (int o = 1; o < 64; o <<= 1) { s1 += __shfl_xor(s1, o); s2 += __shfl_xor(s2, o); }
            if (s1 != 0 || s2 != 0) cnt = -1;
        }
#endif
    }
    {
        const int head = li & 3;
        LAS bf16_t* vst = (LAS bf16_t*)(lds + DSA_SC + w * 16384);
        const bf16_t* kvb = (const bf16_t*)(a->ws + WS_CKV) + (size_t)b * SEQ * 256;
        const float* bx = (const float*)(a->ws + WS_BIAS) + 1600;
        const float sh = softmax_shift(qf, ldu(bx + l * 4 + 3), ldu(bx + 9));
        AttnState st; attn_init(st);
        const int ntile = (cnt + 31) >> 5;
        bf16x8 kn[2][4]; u32x4 vn[8];
        auto request = [&](int tp) {
            if (tp < ntile) { const LAS int* ix = idx + tp * 32;
#pragma unroll
                for (int i = 0; i < 8; ++i) vn[i] = *(const u32x4*)(kvb + (size_t)ix[i * 4 + quad] * 256 + 128 + li * 8);
                const bf16_t* kr0 = kvb + (size_t)ix[li] * 256 + quad * 8; const bf16_t* kr1 = kvb + (size_t)ix[16 + li] * 256 + quad * 8;
#pragma unroll
                for (int kk = 0; kk < 4; ++kk) { kn[0][kk] = ld8(kr0 + kk * 32); kn[1][kk] = ld8(kr1 + kk * 32); } } };
        request(0);
#pragma unroll 1
        for (int tp = 0; tp < ntile; ++tp) {
            const LAS int* ix = idx + tp * 32;
            bf16x8 kc[2][4];
#pragma unroll
            for (int i = 0; i < 8; ++i) *(LAS u32x4*)(vst + (i * 4 + quad) * VP + li * 8) = vn[i];
#pragma unroll
            for (int kk = 0; kk < 4; ++kk) { kc[0][kk] = kn[0][kk]; kc[1][kk] = kn[1][kk]; }
            request(tp + 1);
            const u32x4 ip0 = *(const LAS u32x4*)(ix + quad * 4), ip1 = *(const LAS u32x4*)(ix + 16 + quad * 4);
            attn_tile32(st, qf,
                [&](int sub, int kk) { return kc[sub][kk]; },
                [&](int dt, int sub) { return lds_tr(vst + (sub * 16 + quad * 4 + (li >> 2)) * VP + dt * 16 + (li & 3) * 4); },
                [&](int sub, int e, float raw) { const int pos = tp * 32 + sub * 16 + quad * 4 + e; const int kp = (int)(sub ? ip1[e] : ip0[e]); const int rel = t - kp;
                    const float v = raw * QK_SCALE2 + biasC[(rel < 0 ? 0 : (rel < 128 ? rel : 128)) * 4 + head] - sh; return pos < cnt ? v : -INFINITY; });
        }
        attn_finish(st);
#ifdef TOPK_SELFCHECK
        if (cnt < 0) {
#pragma unroll
            for (int dt = 0; dt < 8; ++dt) st.o[dt] = (f32x4){NAN, NAN, NAN, NAN}; }
#endif
        if (li < 4) { bf16_t* mx = (bf16_t*)(a->ws + WS_MIXED) + row * DM + 1536 + head * 128; const bf16_t* sg = Z + row * ZLD + ZCS + head * 128;
#pragma unroll
            for (int dt = 0; dt < 8; ++dt) { const int d = dt * 16 + quad * 4; const u32x2 sw = *(const u32x2*)(sg + d);
                u32x2 o; o.x = pk2(st.o[dt][0] * siluf_(lo2f(sw.x)), st.o[dt][1] * siluf_(hi2f(sw.x))); o.y = pk2(st.o[dt][2] * siluf_(lo2f(sw.y)), st.o[dt][3] * siluf_(hi2f(sw.y)));
                *(u32x2*)(mx + d) = o; } }
    }
    __syncthreads();
}

struct RowSrc { const float* f; const bf16_t* h; };
DI bf16x8 row8(const RowSrc r, int off) {
    if (r.f) return cvt8(r.f + off);
    if (r.h) return ld8(r.h + off);
    return (bf16x8){0, 0, 0, 0, 0, 0, 0, 0};
}
template <class RS> DI void stage_v32(LAS bf16_t* vst, RS rs, int li, int quad) {
#pragma unroll
    for (int i = 0; i < 8; ++i) { const int rr = i * 4 + quad; *(LAS bf16x8*)(vst + rr * VP + li * 8) = row8(rs(rr), li * 8); }
}
DI float merge_part(const LAS float* ml, const LAS float* opart, int w0, int nw, int ncol, int col, int d) {
    float L = 0.f, o = 0.f;
    for (int w = w0; w < w0 + nw; ++w) { L += ml[(w * 16 + col) * 2 + 1]; o += opart[(size_t)(w * ncol + col) * 128 + d]; }
    return o / fmaxf(L, 1e-30f);
}
DI void put_part(const AttnState& st, LAS float* ml, LAS float* opart, int w, int ncol, int li, int quad) {
    float l = st.l; l += __shfl_xor(l, 16); l += __shfl_xor(l, 32);
    if (li < ncol) { if (quad == 0) ml[(w * 16 + li) * 2 + 1] = l;
#pragma unroll
        for (int dt = 0; dt < 8; ++dt) *(LAS f32x4*)(opart + (size_t)(w * ncol + li) * 128 + dt * 16 + quad * 4) = st.o[dt]; }
}

constexpr int SN_BIAS = 0, SN_ML = 2304, SN_PSUM = 4096, SN_PLD = 1040, SN_ST = 24576, SN_SEL = SN_ST + 8 * 32 * VP * 2;
DI void nsa_sample_unit(ArgsP a, LAS unsigned char* lds, int l, int u) {
    const int tid = ltid(), w = tid >> 6, lane = tid & 63, li = lane & 15, quad = lane >> 4;
    const int b = u >> 1, kvh = u & 1;
    const bf16_t* Z = (const bf16_t*)(a->ws + WS_Z); const float* Zs = (const float*)(a->ws + WS_ZS);
    LAS float* biasL = (LAS float*)(lds + SN_BIAS); LAS float* ml = (LAS float*)(lds + SN_ML); LAS float* psum = (LAS float*)(lds + SN_PSUM);
    LAS float* opart = (LAS float*)(lds + SN_ST); LAS bf16_t* vst = (LAS bf16_t*)(lds + SN_ST) + w * 32 * VP; LAS int* sel = (LAS int*)(lds + SN_SEL);
    { const float* bt = (const float*)(a->ws + WS_BIAS);
      for (int i = tid; i < 129 * 4; i += 512) biasL[i] = bt[(i >> 2) * 8 + kvh * 4 + (i & 3)];
      for (int i = tid; i < 4 * SN_PLD; i += 512) psum[i] = 0.f; }
    __syncthreads();
    const int tt = li >> 2, g = li & 3, h = kvh * 4 + g, t = PAST + tt;
    const size_t row = (size_t)NTP + b * DS + tt;
    const int fc = tid >> 5, fd = (tid & 31) * 4;
    f32x4 fin = {0.f, 0.f, 0.f, 0.f};
    const float* fzg = Zs + ((size_t)NTP + b * DS + (fc >> 2)) * ZSLD + ZS_GATE + kvh * 4 + (fc & 3);
    const float fg0 = sigmoidf_(fzg[0]), fg1 = sigmoidf_(fzg[8]), fg2 = sigmoidf_(fzg[16]);
    bf16x8 qf[4];
#pragma unroll
    for (int kk = 0; kk < 4; ++kk) qf[kk] = ld8(Z + row * ZLD + ZQ + h * 128 + kk * 32 + quad * 8);
    const float* bx = (const float*)(a->ws + WS_BIAS) + 1600;
    const float shC = softmax_shift(qf, ldu(bx + l * 4 + 0), ldu(bx + 8)), shW = softmax_shift(qf, ldu(bx + l * 4 + 2), ldu(bx + 8));
    {
        const bf16_t* Kc = (const bf16_t*)(a->ws + WS_KCS) + (size_t)((l * 16 + b * 2 + kvh) * 1024) * 128;
        const bf16_t* VcT = (const bf16_t*)(a->ws + WS_VCST) + (size_t)((l * 16 + b * 2 + kvh) * 128) * 1024;
        float sc[8][4];
#pragma unroll
        for (int sub = 0; sub < 8; ++sub) {
            f32x4 s = {0.f, 0.f, 0.f, 0.f};
            const int n0 = w * 128 + sub * 16;
#pragma unroll
            for (int kk = 0; kk < 4; ++kk) s = mfma16(ld8(Kc + (size_t)(n0 + li) * 128 + kk * 32 + quad * 8), qf[kk], s);
#pragma unroll
            for (int e = 0; e < 4; ++e) { const int n = n0 + quad * 4 + e; const int rel = t - (16 * n + 31);
                sc[sub][e] = (n < NC_S) ? s[e] * QK_SCALE2 + biasL[(rel < 128 ? rel : 128) * 4 + g] - shC : -INFINITY; }
        }
        float ls = 0.f;
#pragma unroll
        for (int sub = 0; sub < 8; ++sub)
#pragma unroll
            for (int e = 0; e < 4; ++e) { sc[sub][e] = fexp2(sc[sub][e]); ls += sc[sub][e]; }
        ls += __shfl_xor(ls, 16); ls += __shfl_xor(ls, 32);
        if (quad == 0) ml[(w * 16 + li) * 2 + 1] = ls;
        __syncthreads();
        float L = 0.f;
#pragma unroll
        for (int ww = 0; ww < 8; ++ww) L += ml[(ww * 16 + li) * 2 + 1];
        const float inv = 1.0f / fmaxf(L, 1e-30f);
#pragma unroll
        for (int sub = 0; sub < 8; ++sub) { f32x4 hs;
#pragma unroll
            for (int e = 0; e < 4; ++e) { sc[sub][e] *= inv; float x = sc[sub][e]; x += dpp_xor1(x); x += dpp_xor2(x); hs[e] = x; }
            if (g == 0) *(LAS f32x4*)(psum + tt * SN_PLD + w * 128 + sub * 16 + quad * 4) = hs; }
        f32x4 oc[8];
#pragma unroll
        for (int dt = 0; dt < 8; ++dt) oc[dt] = (f32x4){0.f, 0.f, 0.f, 0.f};
#pragma unroll
        for (int tp = 0; tp < 4; ++tp) {
            const bf16x8 pb = pack8(sc[2 * tp][0], sc[2 * tp][1], sc[2 * tp][2], sc[2 * tp][3], sc[2 * tp + 1][0], sc[2 * tp + 1][1], sc[2 * tp + 1][2], sc[2 * tp + 1][3]);
#pragma unroll
            for (int dt = 0; dt < 8; ++dt) { const bf16_t* vp = VcT + (size_t)(dt * 16 + li) * 1024 + w * 128 + tp * 32 + quad * 4;
                const s16x4 a0 = *(const s16x4*)vp, a1 = *(const s16x4*)(vp + 16);
                oc[dt] = mfma16(__builtin_shufflevector(a0, a1, 0, 1, 2, 3, 4, 5, 6, 7), pb, oc[dt]); }
        }
#pragma unroll
        for (int dt = 0; dt < 8; ++dt) *(LAS f32x4*)(opart + (size_t)(w * 16 + li) * 128 + dt * 16 + quad * 4) = oc[dt];
        __syncthreads();
#pragma unroll
        for (int ww = 0; ww < 8; ++ww) fin += *(const LAS f32x4*)(opart + (size_t)(ww * 16 + fc) * 128 + fd) * fg0;
    }
    if (w < 4) {
        const LAS float* ps = psum + w * SN_PLD;
        float val[4];
#pragma unroll
        for (int k = 0; k < 4; ++k) { const int j = lane + 64 * k;
            const f32x4 v4 = *(const LAS f32x4*)(ps + 4 * j); const float pm1 = j > 0 ? ps[4 * j - 1] : 0.f;
            val[k] = (j == 0 || j == 255) ? -INFINITY : pm1 + 2.0f * (v4[0] + v4[1] + v4[2]) + v4[3]; }
        if (lane == 0) { sel[w * 16 + 0] = 0; sel[w * 16 + 1] = 255; sel[w * 16 + 2] = 256; }
#pragma unroll 1
        for (int it = 0; it < 13; ++it) {
            float bv = val[0]; int bj = lane;
#pragma unroll
            for (int k = 1; k < 4; ++k) if (val[k] > bv) { bv = val[k]; bj = lane + 64 * k; }
#pragma unroll
            for (int o = 1; o < 64; o <<= 1) { const float ov = __shfl_xor(bv, o); const int oj = __shfl_xor(bj, o); if (ov > bv || (ov == bv && oj < bj)) { bv = ov; bj = oj; } }
            if (lane == 0) sel[w * 16 + 3 + it] = bj;
#pragma unroll
            for (int k = 0; k < 4; ++k) if (bj == lane + 64 * k) val[k] = -INFINITY;
        }
    }
    __syncthreads();
    {
        const int tq = w >> 1, tpos = PAST + tq;
        const size_t rq = (size_t)NTP + b * DS + tq;
        bf16x8 q2[4];
#pragma unroll
        for (int kk = 0; kk < 4; ++kk) q2[kk] = ld8(Z + rq * ZLD + ZQ + h * 128 + kk * 32 + quad * 8);
        const float shS = softmax_shift(q2, ldu(bx + l * 4 + 1), ldu(bx + 8));
        AttnState st; attn_init(st);
        const float* ca = a->in[I_CA];
#pragma unroll 1
        for (int bi = 0; bi < 8; ++bi) {
            const int j = sel[tq * 16 + (w & 1) * 8 + bi];
            const int ntile = (j == 256) ? 1 : 2;
            const size_t pbase = (j < 256) ? ((size_t)(l * NPOOL + a->page_table[b * NPAGES + (j >> 1)]) * PAGE + (j & 1) * 64) * 1024 : 0;
#pragma unroll 1
            for (int tl = 0; tl < ntile; ++tl) {
                auto src = [&](int i, int which) { RowSrc r; r.f = nullptr; r.h = nullptr; const int ii = tl * 32 + i;
                    if (j < 256) r.f = ca + pbase + (size_t)ii * 1024 + which * 256 + kvh * 128;
                    else if (ii < DS) r.h = Z + ((size_t)NTP + b * DS + ii) * ZLD + ZKV + which * 256 + kvh * 128;
                    return r; };
                stage_v32(vst, [&](int i) { return src(i, 3); }, li, quad);
                const RowSrc k0 = src(li, 2), k1 = src(16 + li, 2);
                attn_tile32(st, q2,
                    [&](int sub, int kk) { return row8(sub ? k1 : k0, kk * 32 + quad * 8); },
                    [&](int dt, int sub) { return lds_tr(vst + (sub * 16 + quad * 4 + (li >> 2)) * VP + dt * 16 + (li & 3) * 4); },
                    [&](int sub, int e, float raw) { const int rel = tpos - (j * 64 + tl * 32 + sub * 16 + quad * 4 + e);
                        return rel >= 0 ? raw * QK_SCALE2 + biasL[(rel < 128 ? rel : 128) * 4 + g] - shS : -INFINITY; });
            }
        }
        __syncthreads();
        put_part(st, ml, opart, w, 4, li, quad);
        __syncthreads();
        { const int ftq = fc >> 2, fgc = fc & 3;
#pragma unroll
          for (int e = 0; e < 4; ++e) fin[e] += fg1 * merge_part(ml, opart, 2 * ftq, 2, 4, fgc, fd + e); }
        __syncthreads();
    }
    {
        AttnState st; attn_init(st);
        const float* sw = a->in[I_SW] + (size_t)((l * DB + b) * 512) * 512;
#pragma unroll 1
        for (int tl = w; tl < 17; tl += 8) {
            auto src = [&](int i, int which) { RowSrc r; r.f = nullptr; r.h = nullptr; const int ii = tl * 32 + i;
                if (ii < 512) r.f = sw + (size_t)ii * 512 + which * 256 + kvh * 128;
                else if (ii < 512 + DS) r.h = Z + ((size_t)NTP + b * DS + ii - 512) * ZLD + ZKV + (4 + which) * 256 + kvh * 128;
                return r; };
            stage_v32(vst, [&](int i) { return src(i, 1); }, li, quad);
            const RowSrc k0 = src(li, 0), k1 = src(16 + li, 0);
            attn_tile32(st, qf,
                [&](int sub, int kk) { return row8(sub ? k1 : k0, kk * 32 + quad * 8); },
                [&](int dt, int sub) { return lds_tr(vst + (sub * 16 + quad * 4 + (li >> 2)) * VP + dt * 16 + (li & 3) * 4); },
                [&](int sub, int e, float raw) { const int rel = 512 + tt - (tl * 32 + sub * 16 + quad * 4 + e);
                    return (rel >= 0 && rel <= 512) ? raw * QK_SCALE2 + biasL[(rel < 128 ? rel : 128) * 4 + g] - shW : -INFINITY; });
        }
        __syncthreads();
        put_part(st, ml, opart, w, 16, li, quad);
        __syncthreads();
#pragma unroll
        for (int e = 0; e < 4; ++e) fin[e] += fg2 * merge_part(ml, opart, 0, 8, 16, fc, fd + e);
    }
    { const size_t frow = (size_t)NTP + b * DS + (fc >> 2); const int fh = kvh * 4 + (fc & 3);
      const u32x2 sw2 = *(const u32x2*)(Z + frow * ZLD + ZAS + fh * 128 + fd);
      u32x2 o; o.x = pk2(fin[0] * siluf_(lo2f(sw2.x)), fin[1] * siluf_(hi2f(sw2.x))); o.y = pk2(fin[2] * siluf_(lo2f(sw2.y)), fin[3] * siluf_(hi2f(sw2.y)));
      *(u32x2*)((bf16_t*)(a->ws + WS_MIXED) + frow * DM + fh * 128 + fd) = o; }
    __syncthreads();
}

constexpr int SD_SC = 0, SD_HIST = 65792, SD_IDX = SD_HIST + 1024, SD_BIAS = SD_IDX + 1024, SD_CTL = SD_BIAS + 2304, SD_ML = SD_CTL + 256, SD_ST = 71680, SD_OP = SD_ST + 8 * 32 * VP * 2;
DI void dsa_sample_unit(ArgsP a, LAS unsigned char* lds, int l, int q) {
    const int tid = ltid(), w = tid >> 6, lane = tid & 63, li = lane & 15, quad = lane >> 4;
    const int b = q >> 2, tt = q & 3, t = PAST + tt, n = t + 1;
    const bf16_t* Z = (const bf16_t*)(a->ws + WS_Z);
    LAS float* sc = (LAS float*)(lds + SD_SC); LAS unsigned* hist = (LAS unsigned*)(lds + SD_HIST); LAS int* idx = (LAS int*)(lds + SD_IDX);
    LAS float* biasC = (LAS float*)(lds + SD_BIAS); LAS int* ctl = (LAS int*)(lds + SD_CTL); LAS float* ml = (LAS float*)(lds + SD_ML);
    LAS bf16_t* vst = (LAS bf16_t*)(lds + SD_ST) + w * 32 * VP; LAS float* opart = (LAS float*)(lds + SD_OP);
    { const float* bt = (const float*)(a->ws + WS_BIAS) + 129 * 8;
      for (int i = tid; i < 129 * 4; i += 512) biasC[i] = bt[i];
      const float* gs = (const float*)(a->ws + WS_SCORES) + (size_t)q * SCORE_LD;
      for (int i = tid; i < n; i += 512) sc[i] = gs[i]; }
    unsigned prefix = 0u; int kth = 256;
#pragma unroll 1
    for (int pass = 3; pass >= 0; --pass) {
        const int shift = pass * 8;
        if (tid < 256) hist[tid] = 0u;
        __syncthreads();
        for (int i = tid; i < n; i += 512) { const unsigned uu = fkey(sc[i]);
            if (pass == 3 || (uu >> (shift + 8)) == prefix) (void)__hip_atomic_fetch_add(hist + ((uu >> shift) & 255u), 1u, __ATOMIC_RELAXED, __HIP_MEMORY_SCOPE_WORKGROUP); }
        __syncthreads();
        if (w == 0) {
            const u32x4 c = *(const LAS u32x4*)(hist + lane * 4);
            const int tot = (int)(c.x + c.y + c.z + c.w);
            int incl = tot;
#pragma unroll
            for (int o = 1; o < 64; o <<= 1) { const int t2 = __shfl_down(incl, o); if (lane + o < 64) incl += t2; }
            const int a3 = incl - tot, a2 = a3 + (int)c.w, a1 = a2 + (int)c.z, a0 = a1 + (int)c.y;
            int which = -1, ab = 0;
            if (a3 < kth && kth <= a3 + (int)c.w) { which = 3; ab = a3; }
            else if (a2 < kth && kth <= a2 + (int)c.z) { which = 2; ab = a2; }
            else if (a1 < kth && kth <= a1 + (int)c.y) { which = 1; ab = a1; }
            else if (a0 < kth && kth <= a0 + (int)c.x) { which = 0; ab = a0; }
            if (which >= 0) { ctl[0] = lane * 4 + which; ctl[1] = kth - ab; }
        }
        __syncthreads();
        prefix = (prefix << 8) | (unsigned)ctl[0]; kth = ctl[1];
    }
    {
        const int chunk = (((n + 7) >> 3) + 63) & ~63, lo = w * chunk, hi = (lo + chunk < n) ? lo + chunk : n;
        int cg = 0, ce = 0;
        for (int base = lo; base < hi; base += 64) { const int i = base + lane; const bool valid = i < hi; const unsigned uu = valid ? fkey(sc[i]) : 0u;
            cg += __builtin_popcountll(__ballot(valid && uu > prefix)); ce += __builtin_popcountll(__ballot(valid && uu == prefix)); }
        if (lane == 0) { ctl[8 + w * 2] = cg; ctl[9 + w * 2] = ce; }
        __syncthreads();
        int ebase = 0, tbase = 0;
        for (int ww = 0; ww < w; ++ww) { const int eg = ctl[8 + ww * 2], ee = ctl[9 + ww * 2]; const int room = kth - ebase; tbase += eg + (ee < room ? ee : (room > 0 ? room : 0)); ebase += ee; }
        int cnt = tbase, cee = ebase;
        for (int base = lo; base < hi; base += 64) {
            const int i = base + lane; const bool valid = i < hi; const unsigned uu = valid ? fkey(sc[i]) : 0u;
            const bool gt = valid && uu > prefix, eq = valid && uu == prefix;
            const unsigned long long eqb = __ballot(eq);
            const int eqrank = cee + __builtin_popcountll(eqb & ((1ull << lane) - 1ull));
            const bool take = gt || (eq && eqrank < kth);
            const unsigned long long tb = __ballot(take);
            if (take) idx[cnt + __builtin_popcountll(tb & ((1ull << lane) - 1ull))] = i;
            cnt += __builtin_popcountll(tb); cee += __builtin_popcountll(eqb);
        }
    }
    __syncthreads();
    {
        const int head = li & 3;
        const size_t row = (size_t)NTP + q;
        bf16x8 qf[4];
#pragma unroll
        for (int kk = 0; kk < 4; ++kk) qf[kk] = ld8(Z + row * ZLD + ZCQ + head * 128 + kk * 32 + quad * 8);
        const float* cc = a->in[I_CC];
        const float* bx = (const float*)(a->ws + WS_BIAS) + 1600;
        const float sh = softmax_shift(qf, ldu(bx + l * 4 + 3), ldu(bx + 9));
        const LAS int* ix = idx + w * 32;
        auto src = [&](int i, int which) { RowSrc r; r.f = nullptr; r.h = nullptr; const int s = ix[i];
            if (s < PAST) r.f = cc + ((size_t)(l * NPOOL + a->page_table[b * NPAGES + (s >> 7)]) * PAGE + (s & 127)) * 256 + which * 128;
            else r.h = Z + ((size_t)NTP + b * DS + (s - PAST)) * ZLD + ZCKV + which * 128;
            return r; };
        AttnState st; attn_init(st);
        stage_v32(vst, [&](int i) { return src(i, 1); }, li, quad);
        const RowSrc k0 = src(li, 0), k1 = src(16 + li, 0);
        const u32x4 ip0 = *(const LAS u32x4*)(ix + quad * 4), ip1 = *(const LAS u32x4*)(ix + 16 + quad * 4);
        attn_tile32(st, qf,
            [&](int sub, int kk) { return row8(sub ? k1 : k0, kk * 32 + quad * 8); },
            [&](int dt, int sub) { return lds_tr(vst + (sub * 16 + quad * 4 + (li >> 2)) * VP + dt * 16 + (li & 3) * 4); },
            [&](int sub, int e, float raw) { const int rel = t - (int)(sub ? ip1[e] : ip0[e]); return raw * QK_SCALE2 + biasC[(rel < 128 ? rel : 128) * 4 + head] - sh; });
        put_part(st, ml, opart, w, 4, li, quad);
        __syncthreads();
        { const int fh = tid >> 7, fd = tid & 127;
          const float o = merge_part(ml, opart, 0, 8, 4, fh, fd);
          ((bf16_t*)(a->ws + WS_MIXED))[row * DM + 1536 + fh * 128 + fd] = f2bf(o * siluf_(bf2f(Z[row * ZLD + ZCS + fh * 128 + fd]))); }
    }
    __syncthreads();
}

constexpr int L4_SN = 16, L4_SD = 32, L4_NSA = 512, L4_DSA = 1024, L4_TOTAL = L4_SN + L4_SD + L4_NSA + L4_DSA;
DI void l4_phase(ArgsP a, LAS unsigned char* lds, int lq) {
    const int l = lq & 1;
    unsigned* qhead = (unsigned*)(a->ws + WS_CTL) + 4096 + 64 * lq;
    LAS int* tk = (LAS int*)(lds + LDS_TICKET_OFF);
    for (;;) {
        if (threadIdx.x == 0) *tk = (int)__hip_atomic_fetch_add(qhead, 1u, __ATOMIC_RELAXED, __HIP_MEMORY_SCOPE_AGENT);
        __syncthreads();
        const int u = *tk;
        __syncthreads();
#ifndef DUP_NSA
#define DUP_NSA 0
#endif
#ifndef DUP_DSA
#define DUP_DSA 0
#endif
#ifndef DUP_SMP
#define DUP_SMP 0
#endif
        { const int qend = L4_TOTAL + DUP_NSA * L4_NSA + DUP_DSA * L4_DSA + DUP_SMP * (L4_SN + L4_SD);
          if (u >= qend) { if (lq == 0 && u - qend < PJ_DEF_TR) { deferred_tr_unit(a, lds, u - qend); continue; } break; } }
        if (u >= L4_TOTAL) { int m = u - L4_TOTAL;
            if (DUP_SMP && m < L4_SN + L4_SD) { if (m < L4_SN) nsa_sample_unit(a, lds, l, m); else dsa_sample_unit(a, lds, l, m - L4_SN); continue; }
            m -= DUP_SMP * (L4_SN + L4_SD);
            if (DUP_NSA && m < L4_NSA) { nsa_prompt_unit(a, lds, l, ((m & 3) << 7) | (127 - (m >> 2))); continue; }
            m -= DUP_NSA * L4_NSA;
            dsa_prompt_unit(a, lds, l, ((511 - (m >> 1)) << 1) | (m & 1)); continue; }
        if (u < L4_SN) nsa_sample_unit(a, lds, l, u);
        else if (u < L4_SN + L4_SD) dsa_sample_unit(a, lds, l, u - L4_SN);
        else if (u < L4_SN + L4_SD + L4_NSA) { const int m = u - L4_SN - L4_SD; nsa_prompt_unit(a, lds, l, ((m & 3) << 7) | (127 - (m >> 2))); }
        else { const int m = u - L4_SN - L4_SD - L4_NSA; dsa_prompt_unit(a, lds, l, ((511 - (m >> 1)) << 1) | (m & 1)); }
    }
}

constexpr int N_PHASES = 12;
#ifndef MK_LAUNCHES
#define MK_LAUNCHES 1
#endif

__global__ void __launch_bounds__(512, 2) fwd(Args a_) {
    extern __shared__ __attribute__((aligned(16))) unsigned char shm[];
    LAS unsigned char* lds = (LAS unsigned char*)shm;
    if (threadIdx.x == 0) *(LAS u32x4*)(lds + LDS_BAR_OFF) = (u32x4){0u, 0u, 0u, 0u};
    __syncthreads();
    unsigned* ctl = (unsigned*)(a_.ws + WS_CTL);
    XcdBarrier bar = xcd_barrier_post(ctl, (volatile LAS unsigned*)(lds + LDS_BAR_OFF));
    const int G = gridDim.x, bid = blockIdx.x;
#define IN(ph) ((ph) >= a_.ph_lo && (ph) < a_.ph_hi)
#define SEAM(ph) do { if (IN(ph) && IN((ph) + 1)) xcd_barrier(bar); } while (0)

#ifndef DUP_P0
#define DUP_P0 1
#endif
#ifndef DUP_P1
#define DUP_P1 1
#endif
#ifndef DUP_L2
#define DUP_L2 1
#endif
#ifndef DUP_L4
#define DUP_L4 1
#endif
#ifndef DUP_L5
#define DUP_L5 1
#endif
    if (IN(0)) { ArgsP a = largs();
        unsigned* qhead = (unsigned*)(a->ws + WS_CTL) + 4096 + 64 * 6;
        LAS int* tk = (LAS int*)(lds + LDS_TICKET_OFF);
        for (;;) {
            if (threadIdx.x == 0) *tk = (int)__hip_atomic_fetch_add(qhead, 1u, __ATOMIC_RELAXED, __HIP_MEMORY_SCOPE_AGENT);
            __syncthreads();
            const int q = *tk;
            __syncthreads();
            if (q >= PJ_NOW) break;
            prologue_unit(a, lds, pj_now_unit(q));
        }
    }
    SEAM(0);
    if (IN(1)) { for (int rep = 0; rep < DUP_P1; ++rep) { ArgsP a = largs();
#if CMP_DIRECT
        { const int per = (CG_UNITS + G - 1) / G;
          for (int u = bid; u < CG_UNITS; u += G) cmp_gemm_direct(a, lds, u);
          asm volatile("s_waitcnt vmcnt(0)" ::: "memory");
          __syncthreads();
          (void)per;
          for (int j0 = 0; bid + j0 * G < CG_UNITS; j0 += 4) { const int w = ltid() >> 6, u = bid + (j0 + (w >> 1)) * G; if (u < CG_UNITS) cmp2_sample_rows(a, cg_unit_row(u, w & 1)); } }
#else
        pg8::Gemm g{(const bf16_t*)(a->ws + WS_ACMPS), (const bf16_t*)(a->ws + WS_W1T), 65536, 256, 4096, 2048, 4096};
        pg8::OrderCmpS S{G, bid};
        pg8::EpiHid E{(bf16_t*)(a->ws + WS_HIDS), (const float*)(a->ws + WS_CBIAS)};
        pg8::gemm_phase<pg8::EpiHid, pg8::OrderCmpS, false>(lds, g, S, E, nullptr);
        asm volatile("s_waitcnt vmcnt(0)" ::: "memory");
        __syncthreads();
        for (int L = bid; L < 256; L += G) { cmp2_sample_unit(a, 2 * L); cmp2_sample_unit(a, 2 * L + 1); }
#endif
        l1_rows(a, 0);
        if (rep + 1 < DUP_P1) xcd_barrier(bar); }
    }
    SEAM(1);
#pragma unroll 1
    for (int l = 0; l < NL; ++l) {
        const int p0 = 2 + 5 * l;
        if (l > 0) {
            if (IN(p0)) { ArgsP a = largs(); l1_rows(a, l); }
            SEAM(p0);
        }
        if (IN(p0 + 1)) { for (int rep = 0; rep < DUP_L2; ++rep) { ArgsP a = largs();
#if CMP_DIRECT
            if (l == 0 && rep == 0) cmp2_sample_tail(a);
#endif
            pg8::Gemm g{(const bf16_t*)(a->ws + WS_H), (const bf16_t*)(a->ws + WS_WINT) + (size_t)l * WIN_ROWS * DM, NTP, ZLD, DM, DM, DM};
            pg8::StaticOrder S; S.init(NTP, ZLD, G, bid);
            pg8::EpiZ E{(bf16_t*)(a->ws + WS_Z), ZLD};
            pg8::gemm_phase<pg8::EpiZ, pg8::StaticOrder, false>(lds, g, S, E, nullptr);
            __syncthreads();
            for (int t = bid; t < L2_THIN_TASKS; t += G) l2_thin_task(a, lds, l, t);
            if (rep + 1 < DUP_L2) xcd_barrier(bar); }
        }
        SEAM(p0 + 1);
        if (IN(p0 + 2)) { ArgsP a = largs();
            unsigned* qhead = (unsigned*)(a->ws + WS_CTL) + 4096 + 64 * (4 + l);
            LAS int* tk = (LAS int*)(lds + LDS_TICKET_OFF);
            for (;;) {
                if (threadIdx.x == 0) *tk = (int)__hip_atomic_fetch_add(qhead, 1u, __ATOMIC_RELAXED, __HIP_MEMORY_SCOPE_AGENT);
                __syncthreads();
                const int u = *tk;
                __syncthreads();
                const int nd = l == 0 ? PJ_DEF_MOD : 0;
                if (u >= L3_TOTAL + nd) break;
                if (u >= L3_CMP && u < L3_CMP + nd) mod_unit(a, lds, 48 + (u - L3_CMP));
                else l3_unit(a, lds, l, u < L3_CMP ? u : u - nd);
            }
        }
        SEAM(p0 + 2);
        if (IN(p0 + 3)) { for (int rep = 0; rep < DUP_L4; ++rep) { ArgsP a = largs(); l4_phase(a, lds, l + 2 * rep); if (rep + 1 < DUP_L4) xcd_barrier(bar); } }
        SEAM(p0 + 3);
        if (IN(p0 + 4)) { for (int rep = 0; rep < DUP_L5; ++rep) { ArgsP a = largs();
            pg8::Gemm g{(const bf16_t*)(a->ws + WS_MIXED), (const bf16_t*)(a->ws + WS_WOUTT) + (size_t)l * DM * DM, NTP, DM, DM, DM, DM};
            pg8::StaticOrder S; S.init(NTP, DM, G, bid);
            pg8::EpiY E{l == 0 ? a->in[I_XP] : (const float*)(a->ws + WS_Y0), l == 0 ? (float*)(a->ws + WS_Y0) : a->out + O_YP, (const float*)(a->ws + WS_MOD) + (size_t)l * 10 * 6144};
            pg8::gemm_phase<pg8::EpiY, pg8::StaticOrder, false>(lds, g, S, E, nullptr);
            __syncthreads();
            for (int t = bid; t < 64; t += G) l5_thin_task(a, lds, l, t);
            if (rep + 1 < DUP_L5) xcd_barrier(bar); }
        }
        if (l + 1 < NL) SEAM(p0 + 4);
    }
#undef IN
#undef SEAM
}

extern "C" void kernel_launch(void* const* d_in, const int* in_sizes, int n_in, void* d_out, int out_size, void* d_ws, size_t ws_size, hipStream_t stream) {
    static int grid = 0;
    if (grid == 0) {
        if (n_in != 27 || (size_t)out_size != O_END || ws_size < WS_END2) { fprintf(stderr, "kernel_launch: unexpected shapes (n_in %d, out %d, ws %zu; need 27, %zu, >= %zu)\n", n_in, out_size, ws_size, (size_t)O_END, (size_t)WS_END2); grid = -1; return; }
        int dev = 0, cus = 0, per_cu = 0;
        if (hipGetDevice(&dev) != hipSuccess || hipDeviceGetAttribute(&cus, hipDeviceAttributeMultiprocessorCount, dev) != hipSuccess) { grid = -1; return; }
        if (hipFuncSetAttribute((const void*)fwd, hipFuncAttributeMaxDynamicSharedMemorySize, LDS_BYTES) != hipSuccess) { fprintf(stderr, "kernel_launch: hipFuncSetAttribute failed\n"); grid = -1; return; }
        if (hipOccupancyMaxActiveBlocksPerMultiprocessor(&per_cu, (const void*)fwd, 512, LDS_BYTES) != hipSuccess || per_cu < 1) { fprintf(stderr, "kernel_launch: occupancy query says %d blocks per CU\n", per_cu); per_cu = 1; }
        (void)hipGetLastError();
        grid = cus;
    }
    if (grid < 0) return;
    (void)hipMemsetAsync((char*)d_ws + WS_CTL, 0, CTL_BYTES, stream);
    Args a{};
    for (int i = 0; i < 27; ++i) a.in[i] = (const float*)d_in[i];
    a.page_table = (const int*)d_in[I_PT];
    a.out = (float*)d_out; a.ws = (unsigned char*)d_ws;
#if MK_LAUNCHES == 1
    a.ph_lo = 0; a.ph_hi = N_PHASES;
    hipLaunchKernelGGL(fwd, dim3(grid), dim3(512), LDS_BYTES, stream, a);
#else
    for (int ph = 0; ph < N_PHASES; ++ph) { a.ph_lo = ph; a.ph_hi = ph + 1; hipLaunchKernelGGL(fwd, dim3(grid), dim3(512), LDS_BYTES, stream, a); }
#endif
}
```
